# Optimizing an MI355X kernel written in HIP

```python
import jax, jax.numpy as jnp
from jax import lax
import numpy as np

D_MODEL = 4096
BATCH = 4
SEQ = 2048
DEPTH = 1
DEC_BATCH = 128
DEC_SEQ = 1
PAST_LEN = 16384
PAGE_SIZE = 128

N_META = 16
D_MIX = D_MODEL
D_GLA_V = D_MIX // 2
D_CONV = D_MIX - D_GLA_V
D_GLA_K = D_GLA_V // 2
N_GLA_HEADS = 4
DK = D_GLA_K // N_GLA_HEADS
DV = D_GLA_V // N_GLA_HEADS
GATE_RANK = 16
GATE_TAU = 16.0
GLA_CHUNK = 64
CONV_WIDTH = 3
D_FF = -(-8 * D_MODEL // (3 * 256)) * 256
ALPHA = (2 * DEPTH) ** 0.25
BETA = (8 * DEPTH) ** -0.25
LN_EPS = 1e-5
RMS_EPS = 1e-6
SPLIT_SIZES = [D_GLA_K, D_GLA_K, D_GLA_V, D_GLA_V, GATE_RANK, D_CONV, D_CONV, D_CONV]
SPLIT_IDX = np.cumsum(SPLIT_SIZES)[:-1].tolist()
D_IN = int(sum(SPLIT_SIZES))

kernel_name = "hymba_gla_shortconv_deepnorm_step"


def layer_norm(x, g, b):
    xf = x.astype(jnp.float32)
    mu = jnp.mean(xf, -1, keepdims=True)
    var = jnp.mean(jnp.square(xf - mu), -1, keepdims=True)
    return ((xf - mu) * lax.rsqrt(var + LN_EPS) * g.astype(jnp.float32) + b.astype(jnp.float32)).astype(x.dtype)


def gla_chunk(q, k, v, log_a, S0):
    L = q.shape[2]
    b = jnp.cumsum(log_a, axis=2)
    mask = jnp.tril(jnp.ones((L, L), dtype=bool))
    diff = b[:, :, :, None, :] - b[:, :, None, :, :]
    decay = jnp.exp(jnp.where(mask[None, None, :, :, None], diff, -jnp.inf))
    attn = jnp.einsum('bhid,bhjd,bhijd->bhij', q, k, decay)
    o = jnp.einsum('bhij,bhjv->bhiv', attn, v) + jnp.einsum('bhid,bhdv->bhiv', q * jnp.exp(b), S0)
    b_last = b[:, :, -1:, :]
    S = jnp.exp(b_last[:, :, 0, :])[..., None] * S0 + jnp.einsum('bhjd,bhjv->bhdv', k * jnp.exp(b_last - b), v)
    return o, S


def gla_scan(q, k, v, log_a, S0):
    B, H, L, _ = q.shape
    C = min(GLA_CHUNK, L)
    n = -(-L // C)
    pad = n * C - L

    def prep(t):
        t = jnp.pad(t, ((0, 0), (0, 0), (0, pad), (0, 0)))
        return t.reshape(B, H, n, C, t.shape[-1]).transpose(2, 0, 1, 3, 4)

    def step(S, inp):
        qc, kc, vc, ac = inp
        o, S = gla_chunk(qc, kc, vc, ac, S)
        return S, o

    S, o = lax.scan(step, S0, (prep(q), prep(k), prep(v), prep(log_a)))
    o = o.transpose(1, 2, 0, 3, 4).reshape(B, H, n * C, DV)[:, :, :L]
    return o, S


def mixer(h, S0, buf, n_lead, w_in, w_a2, b_a, gla_norm_g, conv_w, w_out):
    B, T, _ = h.shape
    f32 = jnp.float32
    proj = jnp.einsum('btd,de->bte', h, w_in)
    q, k, v, g, a_lr, cb, cc, ch = jnp.split(proj, SPLIT_IDX, axis=-1)

    def heads(t, d):
        return t.reshape(B, T, N_GLA_HEADS, d).transpose(0, 2, 1, 3).astype(f32)

    qh = heads(q, DK) * (DK ** -0.5)
    kh = heads(k, DK)
    vh = heads(v, DV)
    z = jnp.einsum('btr,rk->btk', a_lr, w_a2) + b_a
    log_a = heads(jax.nn.log_sigmoid(z.astype(f32)) / GATE_TAU, DK)
    S0 = S0.astype(f32)
    if n_lead > 0:
        o_lead, S = gla_chunk(qh[:, :, :n_lead], kh[:, :, :n_lead], vh[:, :, :n_lead], log_a[:, :, :n_lead], S0)
        o_rest, S = gla_scan(qh[:, :, n_lead:], kh[:, :, n_lead:], vh[:, :, n_lead:], log_a[:, :, n_lead:], S)
        o = jnp.concatenate([o_lead, o_rest], axis=2)
    else:
        o, S = gla_scan(qh, kh, vh, log_a, S0)
    o = o * lax.rsqrt(jnp.mean(o * o, -1, keepdims=True) + RMS_EPS) * gla_norm_g.astype(f32)
    o = o.transpose(0, 2, 1, 3).reshape(B, T, D_GLA_V).astype(h.dtype) * jax.nn.silu(g)

    u = cc * ch
    u_full = jnp.concatenate([buf.astype(u.dtype), u], axis=1)
    zc = conv_w[0] * u_full[:, 0:T]
    for i in range(1, CONV_WIDTH):
        zc = zc + conv_w[i] * u_full[:, i:i + T]
    yc = cb * zc
    new_buf = u_full[:, T:]

    y = jnp.einsum('btm,md->btd', jnp.concatenate([o, yc], axis=-1), w_out)
    return y, S, new_buf


def swiglu(h, w_gate, w_up, w_down):
    a = jnp.einsum('btd,df->btf', h, w_gate)
    u = jnp.einsum('btd,df->btf', h, w_up)
    return jnp.einsum('btf,fd->btd', jax.nn.silu(a) * u, w_down)


def setup_inputs(seed: int = 0) -> dict:
    key = jax.random.key(seed)
    ks = jax.random.split(key, 24)
    nrm = lambda k, s: jax.random.normal(k, s, dtype=jnp.float32)
    return {
        "x_prompt": nrm(ks[0], (BATCH, SEQ, D_MODEL)),
        "x_sample": nrm(ks[1], (DEC_BATCH, DEC_SEQ, D_MODEL)),
        "state_gla": nrm(ks[2], (DEPTH, DEC_BATCH, N_GLA_HEADS, DK, DV)),
        "state_conv": nrm(ks[3], (DEPTH, DEC_BATCH, CONV_WIDTH - 1, D_CONV)),
        "meta_tokens": nrm(ks[4], (N_META, D_MODEL)),
        "emb_ln_g": 1.0 + 0.02 * nrm(ks[5], (D_MODEL,)),
        "emb_ln_b": 0.02 * nrm(ks[6], (D_MODEL,)),
        "w_in": nrm(ks[7], (DEPTH, D_MODEL, D_IN)) * D_MODEL ** -0.5,
        "w_a2": nrm(ks[8], (DEPTH, GATE_RANK, D_GLA_K)) * GATE_RANK ** -0.5,
        "b_a": 0.1 * nrm(ks[9], (DEPTH, D_GLA_K)),
        "gla_norm_g": 1.0 + 0.02 * nrm(ks[10], (DEPTH, DV)),
        "conv_w": nrm(ks[11], (DEPTH, CONV_WIDTH, D_CONV)) * CONV_WIDTH ** -0.5,
        "w_out": nrm(ks[12], (DEPTH, D_MIX, D_MODEL)) * (D_MIX ** -0.5) * BETA,
        "ln1_g": 1.0 + 0.02 * nrm(ks[13], (DEPTH, D_MODEL)),
        "ln1_b": 0.02 * nrm(ks[14], (DEPTH, D_MODEL)),
        "w_ffn_gate": nrm(ks[15], (DEPTH, D_MODEL, D_FF)) * D_MODEL ** -0.5,
        "w_ffn_up": nrm(ks[16], (DEPTH, D_MODEL, D_FF)) * D_MODEL ** -0.5,
        "w_ffn_down": nrm(ks[17], (DEPTH, D_FF, D_MODEL)) * (D_FF ** -0.5) * BETA,
        "ln2_g": 1.0 + 0.02 * nrm(ks[18], (DEPTH, D_MODEL)),
        "ln2_b": 0.02 * nrm(ks[19], (DEPTH, D_MODEL)),
    }


def reference(x_prompt, x_sample, state_gla, state_conv, meta_tokens, emb_ln_g, emb_ln_b,
              w_in, w_a2, b_a, gla_norm_g, conv_w, w_out, ln1_g, ln1_b,
              w_ffn_gate, w_ffn_up, w_ffn_down, ln2_g, ln2_b):
    B = x_prompt.shape[0]
    meta = jnp.broadcast_to(meta_tokens[None].astype(x_prompt.dtype), (B, N_META, D_MODEL))
    hp = layer_norm(jnp.concatenate([meta, x_prompt], axis=1), emb_ln_g, emb_ln_b)
    hs = layer_norm(x_sample, emb_ln_g, emb_ln_b)

    gla_p, conv_p, gla_s, conv_s = [], [], [], []
    for l in range(DEPTH):
        lw = (w_in[l], w_a2[l], b_a[l], gla_norm_g[l], conv_w[l], w_out[l])
        S0p = jnp.zeros((B, N_GLA_HEADS, DK, DV), jnp.float32)
        buf0p = jnp.zeros((B, CONV_WIDTH - 1, D_CONV), hp.dtype)
        mp, Sp, bp = mixer(hp, S0p, buf0p, N_META, *lw)
        hp = layer_norm(ALPHA * hp + mp, ln1_g[l], ln1_b[l])
        hp = layer_norm(ALPHA * hp + swiglu(hp, w_ffn_gate[l], w_ffn_up[l], w_ffn_down[l]), ln2_g[l], ln2_b[l])
        ms, Ss, bs = mixer(hs, state_gla[l], state_conv[l], 0, *lw)
        hs = layer_norm(ALPHA * hs + ms, ln1_g[l], ln1_b[l])
        hs = layer_norm(ALPHA * hs + swiglu(hs, w_ffn_gate[l], w_ffn_up[l], w_ffn_down[l]), ln2_g[l], ln2_b[l])
        gla_p.append(Sp); conv_p.append(bp); gla_s.append(Ss); conv_s.append(bs)

    y_prompt = hp[:, N_META:]
    y_sample = hs
    return (y_prompt, y_sample, jnp.stack(gla_p), jnp.stack(conv_p), jnp.stack(gla_s), jnp.stack(conv_s))
```

```cpp
#include <hip/hip_runtime.h>
#include <cstdio>
#include <cstdint>
namespace pg8 {
#define PG8_LAS __attribute__((address_space(3)))
typedef unsigned short bf16_t;
typedef short bf16x8 __attribute__((ext_vector_type(8)));
typedef float f32x4 __attribute__((ext_vector_type(4)));
typedef unsigned u32x4 __attribute__((ext_vector_type(4)));
constexpr int BM = 256, BK = 64, HALF = 128, HTB = HALF * BK * 2  , STAGE_BYTES = 8 * HTB, NXCD = 8, WGM = 8;

__host__ __device__ __forceinline__ int lds_byte(int r, int c) { const int st = (r >> 4) * 2 + (c >> 5), rr = r & 15, cc = c & 31, ob = rr * 64 + cc * 2; return st * 1024 + (ob ^ (((ob >> 9) & 1) << 5)); }
__host__ __device__ __forceinline__ void stage_rc(int b, int& R, int& C) { const int st = b / 1024, sb = b % 1024, swz = sb ^ (((sb >> 9) & 1) << 5); R = (st >> 1) * 16 + swz / 64; C = (st & 1) * 32 + (swz % 64) / 2; }
__host__ __device__ __forceinline__ int perm32(int rho) { const int n = rho >> 4, i = rho & 15; return 8 * (i >> 2) + 4 * n + (i & 3); }

struct Unit { int pm, pn; };
struct Gemm { const bf16_t* A; const bf16_t* Bt; int M, N, K; };

struct StaticOrder {
    int nM, nN, nwg, G, c;
    __host__ __device__ void init(int M, int N, int G_, int c_) { nM = M / BM; nN = N / BM; nwg = nM * nN; G = G_; c = c_; }
    __host__ __device__ bool next(int i, Unit& u) const {
        const long L = (long)i * G + c; if (L >= nwg) return false;
        int wgid = (int)L; { const int q = nwg / NXCD, r = nwg % NXCD, xcd = wgid % NXCD, off = wgid / NXCD; wgid = (xcd < r ? xcd * (q + 1) : r * (q + 1) + (xcd - r) * q) + off; }
        const int nig = WGM * nN, gid = wgid / nig, fm = gid * WGM, gsz = (nM - fm) < WGM ? (nM - fm) : WGM;
        u.pm = fm + ((wgid % nig) % gsz); u.pn = (wgid % nig) / gsz; return true;
    }
    __device__ __forceinline__ void a_ready(const Unit&) const {}
    __device__ __forceinline__ void done(const Unit&) const {}
};


typedef unsigned u32x2 __attribute__((ext_vector_type(2)));
__device__ __forceinline__ unsigned cvt_pk_bf16(float lo, float hi) { unsigned r; asm volatile("v_cvt_pk_bf16_f32 %0, %1, %2" : "=v"(r) : "v"(lo), "v"(hi)); return r; }
__device__ __forceinline__ float bf_lo(unsigned w) { return __uint_as_float(w << 16); }
__device__ __forceinline__ float bf_hi(unsigned w) { return __uint_as_float(w & 0xffff0000u); }
__device__ __forceinline__ float silu_f(float a) { return a * __builtin_amdgcn_rcpf(1.0f + __builtin_amdgcn_exp2f(-1.44269504089f * a)); }

struct EpiBf16 {
    static constexpr bool PERM = true, AFTER_DRAIN = false;
    bf16_t* O; int ldc;
    __device__ __forceinline__ void operator()(const f32x4 (&acc)[2][2][4][2], const Unit& u, int wr, int wc, int fr, int fq) const {
        const int row0 = u.pm * BM + wr * 64 + fr, col0 = u.pn * BM + wc * 32 + 8 * fq;
#pragma unroll
        for (int ai = 0; ai < 2; ++ai)
#pragma unroll
            for (int m = 0; m < 4; ++m) { bf16_t* rowp = O + (size_t)(row0 + ai * HALF + m * 16) * ldc + col0;
#pragma unroll
                for (int bj = 0; bj < 2; ++bj) { const f32x4 v0 = acc[ai][bj][m][0], v1 = acc[ai][bj][m][1];
                    u32x4 w; w.x = cvt_pk_bf16(v0[0], v0[1]); w.y = cvt_pk_bf16(v0[2], v0[3]); w.z = cvt_pk_bf16(v1[0], v1[1]); w.w = cvt_pk_bf16(v1[2], v1[3]);
                    *(u32x4*)(rowp + bj * HALF) = w; } }
    }
};
struct EpiResF32 {
    static constexpr bool PERM = false, AFTER_DRAIN = false;
    float* C; int ldc; const bf16_t* R; int ldr; float alpha;
    __device__ __forceinline__ void operator()(const f32x4 (&acc)[2][2][4][2], const Unit& u, int wr, int wc, int fr, int fq) const {
        const int row0 = u.pm * BM + wr * 64 + fr, col0 = u.pn * BM + wc * 32 + 4 * fq;
#pragma unroll
        for (int ai = 0; ai < 2; ++ai)
#pragma unroll
            for (int m = 0; m < 4; ++m) { const size_t row = (size_t)(row0 + ai * HALF + m * 16); float* rowp = C + row * ldc + col0; const bf16_t* rp = R + row * ldr + col0;
#pragma unroll
                for (int bj = 0; bj < 2; ++bj)
#pragma unroll
                    for (int n = 0; n < 2; ++n) { const u32x2 rv = *(const u32x2*)(rp + bj * HALF + n * 16);
                        const f32x4 res = (f32x4){bf_lo(rv.x), bf_hi(rv.x), bf_lo(rv.y), bf_hi(rv.y)};
                        *(f32x4*)(rowp + bj * HALF + n * 16) = acc[ai][bj][m][n] + res * alpha; } }
    }
};
struct EpiSwiGLU {
    static constexpr bool PERM = true, AFTER_DRAIN = false;
    bf16_t* O; int ldc;
    __device__ __forceinline__ void operator()(const f32x4 (&acc)[2][2][4][2], const Unit& u, int wr, int wc, int fr, int fq) const {
        const int row0 = u.pm * BM + wr * 64 + fr, col0 = u.pn * HALF + wc * 32 + 8 * fq;
#pragma unroll
        for (int ai = 0; ai < 2; ++ai)
#pragma unroll
            for (int m = 0; m < 4; ++m) { bf16_t* rowp = O + (size_t)(row0 + ai * HALF + m * 16) * ldc + col0;
                const f32x4 g0 = acc[ai][0][m][0], g1 = acc[ai][0][m][1], u0 = acc[ai][1][m][0], u1 = acc[ai][1][m][1];
                u32x4 w; w.x = cvt_pk_bf16(silu_f(g0[0]) * u0[0], silu_f(g0[1]) * u0[1]); w.y = cvt_pk_bf16(silu_f(g0[2]) * u0[2], silu_f(g0[3]) * u0[3]);
                w.z = cvt_pk_bf16(silu_f(g1[0]) * u1[0], silu_f(g1[1]) * u1[1]); w.w = cvt_pk_bf16(silu_f(g1[2]) * u1[2], silu_f(g1[3]) * u1[3]);
                *(u32x4*)rowp = w; }
    }
};

template <class Epi, class Sched, bool ALIGN_EPI = false, bool SP2 = false>
__device__ __forceinline__ void gemm_phase(PG8_LAS unsigned char* lds, const Gemm g, const Sched& S, const Epi& E) {
    const int tid = threadIdx.x, wid = __builtin_amdgcn_readfirstlane(tid >> 6), lane = tid & 63, wr = wid >> 2, wc = wid & 3, fr = lane & 15, fq = lane >> 4;
    const int K = g.K, nt = K / BK;
    unsigned voffA[2], voffB[2];
#pragma unroll
    for (int i = 0; i < 2; ++i) { int R, C; stage_rc(tid * 16 + i * 8192, R, C); const int Rb = Epi::PERM ? ((R & ~31) + perm32(R & 31)) : R;
        voffA[i] = (unsigned)(R * K + C) * 2u; voffB[i] = (unsigned)(Rb * K + C) * 2u; }
    const size_t kstep = (size_t)(BK * 2);
    const size_t hstep = (size_t)HALF * K * 2;
    const size_t tstep = 2 * hstep;
    const unsigned ldsw = (unsigned)wid * 1024u;
    const int aoff = lds_byte(wr * 64 + fr, fq * 8), boff = lds_byte(wc * 32 + fr, fq * 8);
#define PG8_SA(b, h) (((b) * 2 + (h)) * HTB)
#define PG8_SB(b, h) ((4 + (b) * 2 + (h)) * HTB)
#define PG8_STAGE(bufoff, gbase, voff) do { _Pragma("unroll") for (int _i = 0; _i < 2; ++_i) \
        __builtin_amdgcn_global_load_lds((const unsigned*)((const char*)(gbase) + (voff)[_i]), (PG8_LAS unsigned*)(lds + (bufoff) + ldsw + _i * 8192), 16, 0, 0); } while (0)
#define PG8_LDA(dst, b, h) do { _Pragma("unroll") for (int m = 0; m < 4; ++m) _Pragma("unroll") for (int k = 0; k < 2; ++k) dst[m][k] = *(const PG8_LAS bf16x8*)(lds + PG8_SA(b, h) + aoff + m * 2048 + k * 1024); } while (0)
#define PG8_LDB(dst, b, h) do { _Pragma("unroll") for (int n = 0; n < 2; ++n) _Pragma("unroll") for (int k = 0; k < 2; ++k) dst[n][k] = *(const PG8_LAS bf16x8*)(lds + PG8_SB(b, h) + boff + n * 2048 + k * 1024); } while (0)
#define PG8_MMA(ai, bj, At, Bt) do { __builtin_amdgcn_s_setprio(1); _Pragma("unroll") for (int m = 0; m < 4; ++m) _Pragma("unroll") for (int n = 0; n < 2; ++n) _Pragma("unroll") for (int k = 0; k < 2; ++k) \
        acc[ai][bj][m][n] = __builtin_amdgcn_mfma_f32_16x16x32_bf16(Bt[n][k], At[m][k], acc[ai][bj][m][n], 0, 0, 0); __builtin_amdgcn_s_setprio(0); } while (0)
#define PG8_WAIT_V(n) asm volatile("s_waitcnt vmcnt(" #n ")" ::: "memory")
#define PG8_WAIT_L(n) asm volatile("s_waitcnt lgkmcnt(" #n ")" ::: "memory")
#define PG8_BAR __builtin_amdgcn_s_barrier()
#define PG8_SCHED __builtin_amdgcn_sched_barrier(0)
    Unit cur, nxt; int ui = 0;
    if (!S.next(0, cur)) return;
    f32x4 acc[2][2][4][2];
#pragma unroll
    for (int a = 0; a < 2; ++a)
#pragma unroll
        for (int b = 0; b < 2; ++b)
#pragma unroll
            for (int m = 0; m < 4; ++m)
#pragma unroll
                for (int n = 0; n < 2; ++n) acc[a][b][m][n] = (f32x4){0.f, 0.f, 0.f, 0.f};
    bf16x8 At[4][2], B0[2][2], B1[2][2];
    const char* cA = (const char*)g.A + (size_t)cur.pm * tstep; const char* cB = (const char*)g.Bt + (size_t)cur.pn * tstep;
    S.a_ready(cur);
    if constexpr (SP2) {
        PG8_STAGE(PG8_SB(0, 0), cB, voffB); PG8_STAGE(PG8_SB(0, 1), cB + hstep, voffB); PG8_STAGE(PG8_SA(0, 0), cA, voffA); PG8_STAGE(PG8_SA(0, 1), cA + hstep, voffA);
        if (wr == 1) PG8_BAR;
        PG8_WAIT_V(2); PG8_BAR;
        PG8_STAGE(PG8_SB(1, 0), cB + kstep, voffB); PG8_STAGE(PG8_SA(1, 0), cA + kstep, voffA); PG8_STAGE(PG8_SB(1, 1), cB + hstep + kstep, voffB);
        PG8_WAIT_V(6); PG8_BAR;
    } else {
        PG8_STAGE(PG8_SB(0, 0), cB, voffB); PG8_STAGE(PG8_SA(0, 0), cA, voffA); PG8_STAGE(PG8_SB(0, 1), cB + hstep, voffB); PG8_STAGE(PG8_SA(0, 1), cA + hstep, voffA);
        if (wr == 1) PG8_BAR;
        PG8_WAIT_V(4); PG8_BAR;
        PG8_STAGE(PG8_SB(1, 0), cB + kstep, voffB); PG8_STAGE(PG8_SA(1, 0), cA + kstep, voffA); PG8_STAGE(PG8_SB(1, 1), cB + hstep + kstep, voffB);
        PG8_WAIT_V(6); PG8_BAR;
    }
    for (;;) {
        const bool has_next = S.next(ui + 1, nxt);
        const char* nA = has_next ? (const char*)g.A + (size_t)nxt.pm * tstep : cA; const char* nB = has_next ? (const char*)g.Bt + (size_t)nxt.pn * tstep : cB;
        for (int t = 0; t < nt; t += 2) {
            const bool last = (t == nt - 2);
            const char* a1 = cA + (size_t)(t + 1) * kstep;
            const char* a2 = last ? nA : cA + (size_t)(t + 2) * kstep; const char* b2 = last ? nB : cB + (size_t)(t + 2) * kstep;
            const char* a3 = a2 + kstep; const char* b3 = b2 + kstep;
            if (last && has_next) S.a_ready(nxt);
            if constexpr (SP2) {
            PG8_LDB(B0, 0, 0); PG8_LDB(B1, 0, 1); PG8_SCHED; PG8_LDA(At, 0, 0); PG8_STAGE(PG8_SA(1, 1), a1 + hstep, voffA);
            PG8_WAIT_V(8); PG8_WAIT_L(0); PG8_BAR; PG8_MMA(0, 0, At, B0); PG8_MMA(0, 1, At, B1); PG8_BAR; PG8_SCHED;
            PG8_LDA(At, 0, 1); PG8_STAGE(PG8_SB(0, 0), b2, voffB); PG8_STAGE(PG8_SB(0, 1), b2 + hstep, voffB); PG8_STAGE(PG8_SA(0, 0), a2, voffA);
            PG8_WAIT_V(8); PG8_WAIT_L(0); PG8_BAR; PG8_MMA(1, 0, At, B0); PG8_MMA(1, 1, At, B1); PG8_BAR; PG8_SCHED;
            PG8_LDB(B0, 1, 0); PG8_LDB(B1, 1, 1); PG8_SCHED; PG8_LDA(At, 1, 0); PG8_STAGE(PG8_SA(0, 1), a2 + hstep, voffA);
            PG8_WAIT_V(8); PG8_WAIT_L(0); PG8_BAR; PG8_MMA(0, 0, At, B0); PG8_MMA(0, 1, At, B1); PG8_BAR; PG8_SCHED;
            PG8_LDA(At, 1, 1); PG8_STAGE(PG8_SB(1, 0), b3, voffB); PG8_STAGE(PG8_SB(1, 1), b3 + hstep, voffB); PG8_STAGE(PG8_SA(1, 0), a3, voffA);
            PG8_WAIT_V(8); PG8_WAIT_L(0); PG8_BAR; PG8_MMA(1, 0, At, B0); PG8_MMA(1, 1, At, B1); PG8_BAR; PG8_SCHED;
            } else {
            PG8_LDB(B0, 0, 0); PG8_SCHED; PG8_LDA(At, 0, 0); PG8_STAGE(PG8_SA(1, 1), a1 + hstep, voffA);
            PG8_WAIT_L(8); PG8_BAR; PG8_WAIT_L(0); PG8_MMA(0, 0, At, B0); PG8_BAR; PG8_SCHED;
            PG8_LDB(B1, 0, 1); PG8_STAGE(PG8_SB(0, 0), b2, voffB);
            PG8_BAR; PG8_WAIT_L(0); PG8_MMA(0, 1, At, B1); PG8_BAR;
            PG8_LDA(At, 0, 1); PG8_STAGE(PG8_SA(0, 0), a2, voffA);
            PG8_BAR; PG8_WAIT_L(0); PG8_MMA(1, 0, At, B0); PG8_BAR; PG8_SCHED;
            PG8_STAGE(PG8_SB(0, 1), b2 + hstep, voffB);
            PG8_WAIT_V(6); PG8_BAR; PG8_MMA(1, 1, At, B1); PG8_BAR;
            PG8_LDB(B0, 1, 0); PG8_SCHED; PG8_LDA(At, 1, 0); PG8_STAGE(PG8_SA(0, 1), a2 + hstep, voffA);
            PG8_WAIT_L(8); PG8_BAR; PG8_WAIT_L(0); PG8_MMA(0, 0, At, B0); PG8_BAR; PG8_SCHED;
            PG8_LDB(B1, 1, 1); PG8_STAGE(PG8_SB(1, 0), b3, voffB);
            PG8_BAR; PG8_WAIT_L(0); PG8_MMA(0, 1, At, B1); PG8_BAR;
            PG8_LDA(At, 1, 1); PG8_STAGE(PG8_SA(1, 0), a3, voffA);
            PG8_BAR; PG8_WAIT_L(0); PG8_MMA(1, 0, At, B0); PG8_BAR; PG8_SCHED;
            PG8_STAGE(PG8_SB(1, 1), b3 + hstep, voffB);
            PG8_WAIT_V(6); PG8_BAR; PG8_MMA(1, 1, At, B1); PG8_BAR;
            }
        }
        if constexpr (ALIGN_EPI) { if (wr == 0) PG8_BAR; }
        if constexpr (!Epi::AFTER_DRAIN) { E(acc, cur, wr, wc, fr, fq); S.done(cur); }
        if (!has_next) break;
#pragma unroll
        for (int a = 0; a < 2; ++a)
#pragma unroll
            for (int b = 0; b < 2; ++b)
#pragma unroll
                for (int m = 0; m < 4; ++m)
#pragma unroll
                    for (int n = 0; n < 2; ++n) acc[a][b][m][n] = (f32x4){0.f, 0.f, 0.f, 0.f};
        cur = nxt; cA = nA; cB = nB; ++ui;
        if constexpr (ALIGN_EPI) { if (wr == 1) PG8_BAR; }
    }
    PG8_WAIT_V(0);
    if constexpr (!ALIGN_EPI) { if (wr == 0) PG8_BAR; }
    PG8_BAR;
    if constexpr (Epi::AFTER_DRAIN) { E.fused(acc, cur, wr, wc, fr, fq, lds, wid, lane); S.done(cur); }
#undef PG8_SA
#undef PG8_SB
#undef PG8_STAGE
#undef PG8_LDA
#undef PG8_LDB
#undef PG8_MMA
#undef PG8_WAIT_V
#undef PG8_WAIT_L
#undef PG8_BAR
#undef PG8_SCHED
}
}

#ifndef PG8_SP2
#define PG8_SP2 true
#endif
#ifndef PG8_ALIGN
#define PG8_ALIGN true
#endif
#define GAS __attribute__((address_space(1)))
#define LAS __attribute__((address_space(3)))
typedef unsigned short bf16;
typedef unsigned v4u __attribute__((ext_vector_type(4)));
typedef float f32x4 __attribute__((ext_vector_type(4)));
typedef short bf16x8 __attribute__((ext_vector_type(8)));
typedef GAS unsigned gu32;
typedef GAS unsigned long long gu64;
#define RLX_AGENT __ATOMIC_RELAXED, __HIP_MEMORY_SCOPE_AGENT
#define LDS_WAIT() asm volatile("s_waitcnt lgkmcnt(0)" ::: "memory")
#define VM_WAIT() asm volatile("s_waitcnt vmcnt(0)" ::: "memory")
__device__ __forceinline__ unsigned long long rt() { return __builtin_amdgcn_s_memrealtime(); }
__device__ __forceinline__ unsigned f2bf(float f) { unsigned u = __builtin_bit_cast(unsigned, f); return (u + 0x7fffu + ((u >> 16) & 1u)) >> 16; }
__device__ __forceinline__ unsigned pk2(float lo, float hi) { return f2bf(lo) | (f2bf(hi) << 16); }

#define XB_TMO      128
#define XB_XCNT(j)  (256  + 64 * (j))
#define XB_XSUB(j)  (1280 + 64 * (j))
#define XB_XGEN(j)  (2304 + 64 * (j))
#define XB_TOP      3328
#define XB_TOPGEN   3392
#define XCD_BAR_WORDS 3456
#define XB_SPIN_CAP (1u << 18)

__device__ __forceinline__ unsigned xb_ld(unsigned* p)              { return __hip_atomic_load(p, __ATOMIC_RELAXED, __HIP_MEMORY_SCOPE_AGENT); }
__device__ __forceinline__ unsigned xb_add(unsigned* p, unsigned v) { return __hip_atomic_fetch_add(p, v, __ATOMIC_RELAXED, __HIP_MEMORY_SCOPE_AGENT); }
__device__ __forceinline__ unsigned xb_xcc_id() { return (unsigned)__builtin_amdgcn_s_getreg((3 << 11) | 20) & 0xFu; }
#define XB_SPIN(cond, bar) do { unsigned _sp = 0; while (cond) { __builtin_amdgcn_s_sleep(1); \
    if ((++_sp & 255u) == 0u) { if (xb_ld(&(bar)[XB_TMO])) break; if (_sp > XB_SPIN_CAP) { atomicAdd(&(bar)[XB_TMO], 1u); break; } } } } while (0)

struct XcdBarrier {
    unsigned* bar; unsigned x;
    volatile LAS unsigned* st;
};

__device__ __forceinline__ XcdBarrier xcd_barrier_post(unsigned* bar, volatile LAS unsigned* st) {
    XcdBarrier b; b.bar = bar; b.x = xb_xcc_id(); b.st = st;
    if (threadIdx.x == 0) (void)xb_add(&bar[XB_XCNT(b.x)], 1u);
    return b;
}
__device__ __forceinline__ void xcd_barrier_complete(unsigned* bar, unsigned x, unsigned& nloc, unsigned& nx) {
    const unsigned G = gridDim.x * gridDim.y * gridDim.z;
    unsigned sum, cnt, mine, sp = 0u;
    for (;;) {
        sum = 0u; cnt = 0u; mine = 0u;
#pragma unroll
        for (unsigned j = 0; j < 16; ++j) { const unsigned c = xb_ld(&bar[XB_XCNT(j)]); sum += c; cnt += (c > 0u) ? 1u : 0u; mine = (j == x) ? c : mine; }
        if (sum == G) break;
        __builtin_amdgcn_s_sleep(1);
        if ((++sp & 255u) == 0u) { if (xb_ld(&bar[XB_TMO])) break; if (sp > XB_SPIN_CAP) { atomicAdd(&bar[XB_TMO], 1u); break; } }
    }
    nloc = mine > 0u ? mine : 1u; nx = cnt > 0u ? cnt : 1u;
}

__device__ __forceinline__ void xcd_barrier(const XcdBarrier& b) {
    asm volatile("s_waitcnt vmcnt(0)" ::: "memory");
    __syncthreads();
    if (threadIdx.x == 0) {
        unsigned* bar = b.bar;
        __builtin_amdgcn_s_waitcnt(0);
        unsigned nloc = b.st[0], nx = b.st[1];
        if (nloc == 0u) { xcd_barrier_complete(bar, b.x, nloc, nx); b.st[0] = nloc; b.st[1] = nx; }
        const unsigned old = xb_add(&bar[XB_XSUB(b.x)], 1u);
        const unsigned gen = old / nloc;
        if (old + 1u == (gen + 1u) * nloc) {
            __builtin_amdgcn_fence(__ATOMIC_RELEASE, "agent");
            asm volatile("s_waitcnt vmcnt(0)" ::: "memory");
            const unsigned og = xb_add(&bar[XB_TOP], 1u);
            const unsigned tg = og / nx;
            if (og + 1u == (tg + 1u) * nx) xb_add(&bar[XB_TOPGEN], 1u);
            else XB_SPIN(xb_ld(&bar[XB_TOPGEN]) == tg, bar);
            __builtin_amdgcn_fence(__ATOMIC_ACQUIRE, "agent");
            xb_add(&bar[XB_XGEN(b.x)], 1u);
            asm volatile("s_waitcnt vmcnt(0)" ::: "memory");
        } else {
            XB_SPIN(xb_ld(&bar[XB_XGEN(b.x)]) == gen, bar);
            __builtin_amdgcn_fence(__ATOMIC_ACQUIRE, "agent");
            asm volatile("s_waitcnt vmcnt(0)" ::: "memory");
        }
    }
    __syncthreads();
}

constexpr int NWAVES = 8;
constexpr int D = 4096, NBATCH = 4, SEQ = 2048, NSAMP = 128, NMETA = 16;
constexpr int MPR = NBATCH * SEQ;
constexpr int ROW_S = MPR;
constexpr int ROW_META = MPR + NSAMP;
constexpr int MROWS = ROW_META + NMETA;
constexpr int MPAD = 8448;
constexpr int NIN = 12544;
constexpr int C_Q = 0, C_K = 1024, C_V = 2048, C_G = 4096, C_CB = 6144, C_CC = 8192, C_CH = 10240, C_AL = 12288;
constexpr int DFF = 11008, NGU = 2 * DFF;
constexpr int NH = 4, DK = 256, DV = 512, DGV = 2048, DCONV = 2048, RANK = 16, DGK = 1024;
constexpr float ALPHA = 1.18920711500272f;
constexpr float LN_EPS = 1e-5f, RMS_EPS = 1e-6f;
constexpr size_t O_YP = 0, O_YS = (size_t)MPR * D, O_GP = O_YS + (size_t)NSAMP * D, O_CP = O_GP + (size_t)NBATCH * NH * DK * DV,
                 O_GS = O_CP + (size_t)NBATCH * 2 * DCONV, O_CS = O_GS + (size_t)NSAMP * NH * DK * DV, O_END = O_CS + (size_t)NSAMP * 2 * DCONV;
constexpr size_t MiB = 1u << 20;
constexpr size_t WS_CTL = 0, CTL_ZERO_BYTES = 1 * MiB;
constexpr size_t WS_WIN = 1 * MiB;
constexpr size_t WS_WOUT = WS_WIN + 98 * MiB;
constexpr size_t WS_WGU = WS_WOUT + 32 * MiB;
constexpr size_t WS_WDN = WS_WGU + 172 * MiB;
constexpr size_t WS_H0 = WS_WDN + 86 * MiB;
constexpr size_t WS_PROJ = WS_H0 + 66 * MiB;
constexpr size_t WS_MIX = WS_PROJ + 203 * MiB;
constexpr size_t WS_OBUF = WS_MIX + 66 * MiB;
constexpr size_t WS_R = WS_OBUF + 33 * MiB;
constexpr size_t WS_END = WS_R + 132 * MiB;
static_assert((size_t)NIN * D * 2 <= 98 * MiB && (size_t)NGU * D * 2 <= 172 * MiB && (size_t)D * DFF * 2 <= 86 * MiB && (size_t)MPAD * D * 2 <= 66 * MiB && (size_t)MPAD * NIN * 2 <= 203 * MiB && (size_t)MPAD * D * 4 <= 132 * MiB, "ws map");
constexpr int CW_BAR = 4096;
constexpr int RING_OFF = 0, RING_BYTES = 131072;
constexpr int LDSCTL_OFF = RING_BYTES, MISC_OFF = LDSCTL_OFF + 320;
constexpr int LDS_BYTES = 147456;
static_assert(MISC_OFF + 128 <= LDS_BYTES, "LDS map");

struct Frame {
    LAS unsigned char* lds;
    volatile LAS unsigned* MISC;
    gu32* ctl;
    int tid, lane, wave;
    int vcu, G;
    const float *x_prompt, *x_sample, *state_gla, *state_conv, *meta, *emb_g, *emb_b, *w_in, *w_a2, *b_a, *gnorm, *conv_w, *w_out, *ln1_g, *ln1_b, *w_gate, *w_up, *w_down, *ln2_g, *ln2_b;
    float* out;
    bf16 *Wt_in, *Wt_out, *Wt_gu, *Wt_dn, *h0, *proj, *act, *mix, *h1, *obuf;
    float* R;
};
typedef unsigned u32x2v __attribute__((ext_vector_type(2)));
__device__ __forceinline__ float wave_sum(float v) {
#pragma unroll
    for (int o = 1; o < 64; o <<= 1) v += __shfl_xor(v, o);
    return v;
}
__device__ __forceinline__ float bflo(unsigned w) { return __uint_as_float(w << 16); }
__device__ __forceinline__ float bfhi(unsigned w) { return __uint_as_float(w & 0xffff0000u); }
__device__ __forceinline__ float bf2f(bf16 h) { return __uint_as_float(((unsigned)h) << 16); }
__device__ __forceinline__ float silu(float a) { return a * __builtin_amdgcn_rcpf(1.0f + __builtin_amdgcn_exp2f(-1.44269504089f * a)); }
__device__ __forceinline__ float logsigmoid(float z) { return fminf(z, 0.f) - __logf(1.0f + __expf(-fabsf(z))); }
__device__ __forceinline__ void unpack8(const v4u w, float (&f)[8]) { f[0] = bflo(w.x); f[1] = bfhi(w.x); f[2] = bflo(w.y); f[3] = bfhi(w.y); f[4] = bflo(w.z); f[5] = bfhi(w.z); f[6] = bflo(w.w); f[7] = bfhi(w.w); }
__device__ __forceinline__ v4u pack8(const float (&f)[8]) { v4u w; w.x = pk2(f[0], f[1]); w.y = pk2(f[2], f[3]); w.z = pk2(f[4], f[5]); w.w = pk2(f[6], f[7]); return w; }

__device__ __forceinline__ void p0_transpose_item(const float* W, int ldw, int src_col0, int nvalid, bf16* WT, int K, int dst_row0, int k0, LAS float* scr, int lane) {
    const int c = lane & 31;
#pragma unroll 8
    for (int i = 0; i < 32; ++i) { const int kk = 2 * i + (lane >> 5); float x = 0.f; if (c < nvalid) x = __builtin_nontemporal_load(W + (size_t)(k0 + kk) * ldw + src_col0 + c); scr[kk * 33 + c] = x; }
    LDS_WAIT(); asm volatile("" ::: "memory");
    const int c8 = lane & 7;
#pragma unroll
    for (int j = 0; j < 4; ++j) { const int n = (lane >> 3) + 8 * j; const LAS float* s = scr + (8 * c8) * 33 + n;
        v4u o; o.x = pk2(s[0 * 33], s[1 * 33]); o.y = pk2(s[2 * 33], s[3 * 33]); o.z = pk2(s[4 * 33], s[5 * 33]); o.w = pk2(s[6 * 33], s[7 * 33]);
        *(GAS v4u*)(WT + (size_t)(dst_row0 + n) * K + k0 + 8 * c8) = o; }
    LDS_WAIT(); asm volatile("" ::: "memory");
}
template <bool OUT_F32>
__device__ __forceinline__ void ln_row(const float* src, const float* g, const float* b, void* dst, int lane) {
    const GAS f32x4* xr = (const GAS f32x4*)src + lane;
    f32x4 v[16]; float s = 0.f;
#pragma unroll
    for (int j = 0; j < 16; ++j) { v[j] = xr[64 * j]; s += (v[j].x + v[j].y) + (v[j].z + v[j].w); }
    const float mean = wave_sum(s) * (1.f / D); float s2 = 0.f;
#pragma unroll
    for (int j = 0; j < 16; ++j) { v[j] = v[j] - mean; s2 += (v[j].x * v[j].x + v[j].y * v[j].y) + (v[j].z * v[j].z + v[j].w * v[j].w); }
    const float rstd = 1.f / sqrtf(wave_sum(s2) * (1.f / D) + LN_EPS);
    const GAS f32x4* gr = (const GAS f32x4*)g + lane; const GAS f32x4* br = (const GAS f32x4*)b + lane;
#pragma unroll
    for (int j = 0; j < 16; ++j) { const f32x4 o = v[j] * rstd * gr[64 * j] + br[64 * j];
        if (OUT_F32) ((GAS f32x4*)dst)[lane + 64 * j] = o;
        else { u32x2v w; w.x = pk2(o.x, o.y); w.y = pk2(o.z, o.w); ((GAS u32x2v*)dst)[lane + 64 * j] = w; } }
}
constexpr int NB_IN = 385, I_IN = 64 * NB_IN, NB_OUT = 128, I_OUT = 64 * NB_OUT, NB_GU = NGU / 32, I_GU = 64 * NB_GU, NB_DN = 128, I_DN = (DFF / 64) * NB_DN;
constexpr int P0_ITEMS = I_IN + I_OUT + I_GU + I_DN;
__device__ __forceinline__ void p0_prologue(Frame& F) {
    LAS float* scr = (LAS float*)(F.lds + RING_OFF + F.wave * 16384);
    const int gw = F.vcu * NWAVES + F.wave, NGW = F.G * NWAVES;
    for (int it = gw; it < P0_ITEMS; it += NGW) {
        int r = it;
        if (r < I_IN) { const int kb = r / NB_IN, nb = r % NB_IN, n0 = 32 * nb;
            int src = n0, nv = 32; if (nb >= 384) { src = 6144; nv = 16; } else if (nb >= 192) src = n0 + 16;
            p0_transpose_item(F.w_in, 12304, src, nv, F.Wt_in, D, n0, 64 * kb, scr, F.lane); continue; } r -= I_IN;
        if (r < I_OUT) { const int kb = r / NB_OUT, nb = r % NB_OUT; p0_transpose_item(F.w_out, D, 32 * nb, 32, F.Wt_out, D, 32 * nb, 64 * kb, scr, F.lane); continue; } r -= I_OUT;
        if (r < I_GU) { const int kb = r / NB_GU, nb = r % NB_GU, n0 = 32 * nb, pn = n0 >> 8, c = n0 & 255;
            p0_transpose_item(c < 128 ? F.w_gate : F.w_up, DFF, 128 * pn + (c & 127), 32, F.Wt_gu, D, n0, 64 * kb, scr, F.lane); continue; } r -= I_GU;
        { const int kb = r / NB_DN, nb = r % NB_DN; p0_transpose_item(F.w_down, D, 32 * nb, 32, F.Wt_dn, DFF, 32 * nb, 64 * kb, scr, F.lane); }
    }
    for (int m = gw; m < MROWS; m += NGW) {
        const float* src = m < ROW_S ? F.x_prompt + (size_t)m * D : (m < ROW_META ? F.x_sample + (size_t)(m - ROW_S) * D : F.meta + (size_t)(m - ROW_META) * D);
        ln_row<false>(src, F.emb_g, F.emb_b, F.h0 + (size_t)m * D, F.lane);
    }
}

__device__ __forceinline__ void gla_prompt_simple(Frame& F, int unit) {
    const int bh = unit >> 4, sl = unit & 15, b = bh >> 2, h = bh & 3;
    LAS float* Aa = (LAS float*)(F.lds);
    LAS float* Qq = Aa + 16 * 256;
    LAS float* Kk = Qq + 16 * 256;
    LAS float* Vv = Kk + 16 * 256;
    LAS float* Al = Vv + 16 * 32;
    LAS float* Part = Al + 256;
    const int t = F.tid, d = t & 255, half = t >> 8, vv = t & 31, dg = t >> 5;
    float w2[16];
#pragma unroll
    for (int r = 0; r < 16; ++r) w2[r] = F.w_a2[r * DGK + h * DK + d];
    const float ba = F.b_a[h * DK + d];
    float S[16];
#pragma unroll
    for (int i = 0; i < 16; ++i) S[i] = 0.f;
    for (int grp = 0; grp < 129; ++grp) {
        const int row0 = grp == 0 ? ROW_META : b * SEQ + (grp - 1) * 16;
        __syncthreads();
        if (t < 256) Al[t] = bf2f(F.proj[(size_t)(row0 + (t >> 4)) * NIN + C_AL + (t & 15)]);
#pragma unroll
        for (int j = 0; j < 8; ++j) { const int tok = half * 8 + j; const bf16* pr = F.proj + (size_t)(row0 + tok) * NIN + h * DK + d;
            Qq[tok * 256 + d] = bf2f(pr[C_Q]) * 0.0625f; Kk[tok * 256 + d] = bf2f(pr[C_K]); }
        Vv[t] = bf2f(F.proj[(size_t)(row0 + (t >> 5)) * NIN + C_V + h * DV + sl * 32 + (t & 31)]);
        __syncthreads();
#pragma unroll
        for (int j = 0; j < 8; ++j) { const int tok = half * 8 + j; float z = ba;
#pragma unroll
            for (int r = 0; r < 16; ++r) z += Al[tok * 16 + r] * w2[r];
            Aa[tok * 256 + d] = __expf(logsigmoid(z) * 0.0625f); }
        __syncthreads();
        for (int tok = 0; tok < 16; ++tok) {
            const float v = Vv[tok * 32 + vv]; float po = 0.f;
            const LAS f32x4* A4 = (const LAS f32x4*)(Aa + tok * 256 + dg * 16); const LAS f32x4* K4 = (const LAS f32x4*)(Kk + tok * 256 + dg * 16); const LAS f32x4* Q4 = (const LAS f32x4*)(Qq + tok * 256 + dg * 16);
#pragma unroll
            for (int i4 = 0; i4 < 4; ++i4) { const f32x4 a = A4[i4], k = K4[i4], q = Q4[i4];
                S[4 * i4 + 0] = a.x * S[4 * i4 + 0] + k.x * v; po += q.x * S[4 * i4 + 0];
                S[4 * i4 + 1] = a.y * S[4 * i4 + 1] + k.y * v; po += q.y * S[4 * i4 + 1];
                S[4 * i4 + 2] = a.z * S[4 * i4 + 2] + k.z * v; po += q.z * S[4 * i4 + 2];
                S[4 * i4 + 3] = a.w * S[4 * i4 + 3] + k.w * v; po += q.w * S[4 * i4 + 3]; }
            Part[(tok * 16 + dg) * 32 + vv] = po;
        }
        __syncthreads();
        if (grp > 0) { const int tok = t >> 5; float o = 0.f;
#pragma unroll
            for (int g = 0; g < 16; ++g) o += Part[(tok * 16 + g) * 32 + vv];
            F.obuf[(size_t)(row0 + tok) * DGV + h * DV + sl * 32 + vv] = (bf16)f2bf(o); }
    }
    float* gp = F.out + O_GP + ((size_t)(b * NH + h) * DK + dg * 16) * DV + sl * 32 + vv;
#pragma unroll
    for (int i = 0; i < 16; ++i) gp[(size_t)i * DV] = S[i];
    __syncthreads();
}
__device__ __forceinline__ void gla_sample_item(Frame& F, int it) {
    const int n = it >> 2, h = it & 3, row = ROW_S + n, t = F.tid;
    LAS float* Aa = (LAS float*)(F.lds); LAS float* Kk = Aa + 256; LAS float* Qq = Aa + 512; LAS float* Ored = Aa + 768;
    const bf16* prow = F.proj + (size_t)row * NIN;
    if (t < 256) { const int d = t; float z = F.b_a[h * DK + d];
#pragma unroll
        for (int r = 0; r < 16; ++r) z += bf2f(prow[C_AL + r]) * F.w_a2[r * DGK + h * DK + d];
        Aa[d] = __expf(logsigmoid(z) * 0.0625f); Kk[d] = bf2f(prow[C_K + h * DK + d]); Qq[d] = bf2f(prow[C_Q + h * DK + d]) * 0.0625f; }
    __syncthreads();
    const int cg = t & 127, rg = t >> 7;
    const u32x2v vw = *(const u32x2v*)(prow + C_V + h * DV + 4 * cg);
    const f32x4 v4 = (f32x4){bflo(vw.x), bfhi(vw.x), bflo(vw.y), bfhi(vw.y)};
    const f32x4* S0 = (const f32x4*)(F.state_gla + (size_t)(n * NH + h) * DK * DV) + cg;
    f32x4* S1 = (f32x4*)(F.out + O_GS + (size_t)(n * NH + h) * DK * DV) + cg;
    f32x4 o4 = (f32x4){0.f, 0.f, 0.f, 0.f};
#pragma unroll 8
    for (int i = 0; i < 64; ++i) { const int d = rg * 64 + i; f32x4 s = __builtin_nontemporal_load(S0 + (size_t)d * 128);
        s = s * Aa[d] + v4 * Kk[d]; __builtin_nontemporal_store(s, S1 + (size_t)d * 128); o4 += s * Qq[d]; }
    *(LAS f32x4*)(Ored + rg * 512 + 4 * cg) = o4;
    __syncthreads();
    { const float o = (Ored[t] + Ored[512 + t]) + (Ored[1024 + t] + Ored[1536 + t]); F.obuf[(size_t)row * DGV + h * DV + t] = (bf16)f2bf(o); }
    __syncthreads();
}
__device__ __forceinline__ void conv_row(Frame& F, int row, int lane) {
    const bool samp = row >= ROW_S; const int tq = row & (SEQ - 1), b = row >> 11, n = row - ROW_S;
    const int r1 = tq >= 1 ? row - 1 : ROW_META + 15, r2 = tq >= 2 ? row - 2 : ROW_META + 14 + tq;
    const bf16* p0 = F.proj + (size_t)row * NIN; const bf16* p1 = F.proj + (size_t)r1 * NIN; const bf16* p2 = F.proj + (size_t)r2 * NIN;
#pragma unroll
    for (int j = 0; j < 4; ++j) { const int c0 = 512 * j + 8 * lane;
        float cb[8], cc[8], ch[8], ut[8], u1[8], u2[8], w0[8], w1[8], w2[8], y[8];
        unpack8(*(const v4u*)(p0 + C_CB + c0), cb); unpack8(*(const v4u*)(p0 + C_CC + c0), cc); unpack8(*(const v4u*)(p0 + C_CH + c0), ch);
#pragma unroll
        for (int e = 0; e < 8; ++e) ut[e] = cc[e] * ch[e];
        if (!samp) { unpack8(*(const v4u*)(p1 + C_CC + c0), cc); unpack8(*(const v4u*)(p1 + C_CH + c0), ch);
#pragma unroll
            for (int e = 0; e < 8; ++e) u1[e] = cc[e] * ch[e];
            unpack8(*(const v4u*)(p2 + C_CC + c0), cc); unpack8(*(const v4u*)(p2 + C_CH + c0), ch);
#pragma unroll
            for (int e = 0; e < 8; ++e) u2[e] = cc[e] * ch[e]; }
        else { const f32x4* s1 = (const f32x4*)(F.state_conv + (size_t)(n * 2 + 1) * DCONV + c0); const f32x4* s0 = (const f32x4*)(F.state_conv + (size_t)(n * 2 + 0) * DCONV + c0);
            const f32x4 a0 = s1[0], a1 = s1[1], b0 = s0[0], b1 = s0[1];
            u1[0] = a0.x; u1[1] = a0.y; u1[2] = a0.z; u1[3] = a0.w; u1[4] = a1.x; u1[5] = a1.y; u1[6] = a1.z; u1[7] = a1.w;
            u2[0] = b0.x; u2[1] = b0.y; u2[2] = b0.z; u2[3] = b0.w; u2[4] = b1.x; u2[5] = b1.y; u2[6] = b1.z; u2[7] = b1.w; }
        { const f32x4* q0 = (const f32x4*)(F.conv_w + c0); const f32x4* q1 = (const f32x4*)(F.conv_w + DCONV + c0); const f32x4* q2 = (const f32x4*)(F.conv_w + 2 * DCONV + c0);
            const f32x4 a0 = q0[0], a1 = q0[1], b0 = q1[0], b1 = q1[1], e0 = q2[0], e1 = q2[1];
            w0[0] = a0.x; w0[1] = a0.y; w0[2] = a0.z; w0[3] = a0.w; w0[4] = a1.x; w0[5] = a1.y; w0[6] = a1.z; w0[7] = a1.w;
            w1[0] = b0.x; w1[1] = b0.y; w1[2] = b0.z; w1[3] = b0.w; w1[4] = b1.x; w1[5] = b1.y; w1[6] = b1.z; w1[7] = b1.w;
            w2[0] = e0.x; w2[1] = e0.y; w2[2] = e0.z; w2[3] = e0.w; w2[4] = e1.x; w2[5] = e1.y; w2[6] = e1.z; w2[7] = e1.w; }
#pragma unroll
        for (int e = 0; e < 8; ++e) y[e] = cb[e] * (w0[e] * u2[e] + w1[e] * u1[e] + w2[e] * ut[e]);
        *(v4u*)(F.mix + (size_t)row * D + DGV + c0) = pack8(y);
        if (!samp) { if (tq >= SEQ - 2) { f32x4* o = (f32x4*)(F.out + O_CP + (size_t)(b * 2 + (tq - (SEQ - 2))) * DCONV + c0); o[0] = (f32x4){ut[0], ut[1], ut[2], ut[3]}; o[1] = (f32x4){ut[4], ut[5], ut[6], ut[7]}; } }
        else { f32x4* o = (f32x4*)(F.out + O_CS + (size_t)(n * 2) * DCONV + c0); o[0] = (f32x4){u1[0], u1[1], u1[2], u1[3]}; o[1] = (f32x4){u1[4], u1[5], u1[6], u1[7]};
            f32x4* o2 = (f32x4*)(F.out + O_CS + (size_t)(n * 2 + 1) * DCONV + c0); o2[0] = (f32x4){ut[0], ut[1], ut[2], ut[3]}; o2[1] = (f32x4){ut[4], ut[5], ut[6], ut[7]}; }
    }
}
__device__ __forceinline__ void finish_row(Frame& F, int row, int lane) {
    const f32x4* gq = (const f32x4*)(F.gnorm + 8 * lane); const f32x4 g0 = gq[0], g1 = gq[1];
    const float gn[8] = {g0.x, g0.y, g0.z, g0.w, g1.x, g1.y, g1.z, g1.w};
#pragma unroll
    for (int hd = 0; hd < 4; ++hd) { const int c0 = hd * DV + 8 * lane; float o[8], g[8], y[8];
        unpack8(*(const v4u*)(F.obuf + (size_t)row * DGV + c0), o); unpack8(*(const v4u*)(F.proj + (size_t)row * NIN + C_G + c0), g);
        float ss = 0.f;
#pragma unroll
        for (int e = 0; e < 8; ++e) ss += o[e] * o[e];
        const float rs = 1.f / sqrtf(wave_sum(ss) * (1.f / DV) + RMS_EPS);
#pragma unroll
        for (int e = 0; e < 8; ++e) y[e] = o[e] * rs * gn[e] * silu(g[e]);
        *(v4u*)(F.mix + (size_t)row * D + c0) = pack8(y); }
}

struct Args { const float* in[20]; float* out; unsigned char* ws; };
__global__ void __launch_bounds__(NWAVES * 64, 2) hymba_fwd(Args args) {
    extern __shared__ __attribute__((aligned(16))) unsigned char lds[];
    Frame F;
    F.lds = (LAS unsigned char*)lds;
    F.MISC = (volatile LAS unsigned*)(F.lds + MISC_OFF);
    F.tid = threadIdx.x; F.lane = F.tid & 63; F.wave = __builtin_amdgcn_readfirstlane(F.tid >> 6);
    F.G = gridDim.x; { const int bx = blockIdx.x; F.vcu = (F.G % 8 == 0) ? (bx % 8) * (F.G / 8) + bx / 8 : bx; }
    unsigned char* ws = args.ws;
    F.ctl = (gu32*)(ws + WS_CTL);
    F.x_prompt = args.in[0]; F.x_sample = args.in[1]; F.state_gla = args.in[2]; F.state_conv = args.in[3]; F.meta = args.in[4]; F.emb_g = args.in[5]; F.emb_b = args.in[6];
    F.w_in = args.in[7]; F.w_a2 = args.in[8]; F.b_a = args.in[9]; F.gnorm = args.in[10]; F.conv_w = args.in[11]; F.w_out = args.in[12]; F.ln1_g = args.in[13]; F.ln1_b = args.in[14];
    F.w_gate = args.in[15]; F.w_up = args.in[16]; F.w_down = args.in[17]; F.ln2_g = args.in[18]; F.ln2_b = args.in[19]; F.out = args.out;
    F.Wt_in = (bf16*)(ws + WS_WIN); F.Wt_out = (bf16*)(ws + WS_WOUT); F.Wt_gu = (bf16*)(ws + WS_WGU); F.Wt_dn = (bf16*)(ws + WS_WDN);
    F.h0 = (bf16*)(ws + WS_H0); F.proj = (bf16*)(ws + WS_PROJ); F.act = (bf16*)(ws + WS_PROJ); F.mix = (bf16*)(ws + WS_MIX); F.h1 = (bf16*)(ws + WS_MIX); F.obuf = (bf16*)(ws + WS_OBUF);
    F.R = (float*)(ws + WS_R);
    for (int u = F.tid; u < (LDS_BYTES - LDSCTL_OFF) / 4; u += NWAVES * 64) ((LAS unsigned*)(F.lds + LDSCTL_OFF))[u] = 0u;
    __syncthreads();
    XcdBarrier bar = xcd_barrier_post((unsigned*)(F.ctl + CW_BAR), F.MISC + 8);
    const int gw = F.vcu * NWAVES + F.wave, NGW = F.G * NWAVES;

    p0_prologue(F);
    xcd_barrier(bar);
    { pg8::Gemm g{F.h0, F.Wt_in, MPAD, NIN, D}; pg8::StaticOrder S; S.init(MPAD, NIN, F.G, (int)blockIdx.x);
      pg8::EpiBf16 E{F.proj, NIN};
      pg8::gemm_phase<pg8::EpiBf16, pg8::StaticOrder, PG8_ALIGN, PG8_SP2>(F.lds + RING_OFF, g, S, E); }
    xcd_barrier(bar);
    for (int u = blockIdx.x; u < 256; u += F.G) gla_prompt_simple(F, u);
    for (int it = blockIdx.x; it < NSAMP * NH; it += F.G) gla_sample_item(F, it);
    for (int row = gw; row < ROW_META; row += NGW) conv_row(F, row, F.lane);
    xcd_barrier(bar);
    for (int row = gw; row < ROW_META; row += NGW) finish_row(F, row, F.lane);
    xcd_barrier(bar);
    { pg8::Gemm g{F.mix, F.Wt_out, MPAD, D, D}; pg8::StaticOrder S; S.init(MPAD, D, F.G, (int)blockIdx.x);
      pg8::EpiResF32 E{F.R, D, F.h0, D, ALPHA};
      pg8::gemm_phase<pg8::EpiResF32, pg8::StaticOrder, PG8_ALIGN, PG8_SP2>(F.lds + RING_OFF, g, S, E); }
    xcd_barrier(bar);
    for (int row = gw; row < ROW_META; row += NGW) ln_row<false>(F.R + (size_t)row * D, F.ln1_g, F.ln1_b, F.h1 + (size_t)row * D, F.lane);
    xcd_barrier(bar);
    { pg8::Gemm g{F.h1, F.Wt_gu, MPAD, NGU, D}; pg8::StaticOrder S; S.init(MPAD, NGU, F.G, (int)blockIdx.x);
      pg8::EpiSwiGLU E{F.act, DFF};
      pg8::gemm_phase<pg8::EpiSwiGLU, pg8::StaticOrder, PG8_ALIGN, PG8_SP2>(F.lds + RING_OFF, g, S, E); }
    xcd_barrier(bar);
    { pg8::Gemm g{F.act, F.Wt_dn, MPAD, D, DFF}; pg8::StaticOrder S; S.init(MPAD, D, F.G, (int)blockIdx.x);
      pg8::EpiResF32 E{F.R, D, F.h1, D, ALPHA};
      pg8::gemm_phase<pg8::EpiResF32, pg8::StaticOrder, PG8_ALIGN, PG8_SP2>(F.lds + RING_OFF, g, S, E); }
    xcd_barrier(bar);
    for (int row = gw; row < ROW_META; row += NGW) ln_row<true>(F.R + (size_t)row * D, F.ln2_g, F.ln2_b, F.out + (row < ROW_S ? O_YP + (size_t)row * D : O_YS + (size_t)(row - ROW_S) * D), F.lane);
}

extern "C" void kernel_launch(void* const* d_in, const int* in_sizes, int n_in, void* d_out, int out_size, void* d_ws, size_t ws_size, hipStream_t stream) {
    static int grid = 0;
    if (grid == 0) {
        if (n_in != 20 || (size_t)out_size != O_END || ws_size < WS_END) { fprintf(stderr, "kernel_launch: unexpected shapes (n_in %d out %d ws %zu)\n", n_in, out_size, ws_size); grid = -1; return; }
        int dev = 0, cus = 0, per_cu = 0;
        if (hipGetDevice(&dev) != hipSuccess || hipDeviceGetAttribute(&cus, hipDeviceAttributeMultiprocessorCount, dev) != hipSuccess) { grid = -1; return; }
        if (hipFuncSetAttribute((const void*)hymba_fwd, hipFuncAttributeMaxDynamicSharedMemorySize, LDS_BYTES) != hipSuccess) { fprintf(stderr, "kernel_launch: hipFuncSetAttribute failed\n"); grid = -1; return; }
        if (hipOccupancyMaxActiveBlocksPerMultiprocessor(&per_cu, (const void*)hymba_fwd, NWAVES * 64, LDS_BYTES) != hipSuccess || per_cu < 1) { fprintf(stderr, "kernel_launch: occupancy query says %d\n", per_cu); (void)hipGetLastError(); grid = -1; return; }
        grid = cus;
    }
    if (grid < 0) return;
    if (hipMemsetAsync((char*)d_ws + WS_CTL, 0, CTL_ZERO_BYTES, stream) != hipSuccess) return;
    Args a{};
    for (int i = 0; i < 20; ++i) a.in[i] = (const float*)d_in[i];
    a.out = (float*)d_out; a.ws = (unsigned char*)d_ws;
    hipLaunchKernelGGL(hymba_fwd, dim3(grid), dim3(NWAVES * 64), LDS_BYTES, stream, a);
}
```

```cpp
#include <hip/hip_runtime.h>
#include <cstdio>
#include <cstdint>
namespace pg8 {
#define PG8_LAS __attribute__((address_space(3)))
typedef unsigned short bf16_t;
typedef short bf16x8 __attribute__((ext_vector_type(8)));
typedef float f32x4 __attribute__((ext_vector_type(4)));
typedef unsigned u32x4 __attribute__((ext_vector_type(4)));
constexpr int BM = 256, BK = 64, HALF = 128, HTB = HALF * BK * 2  , STAGE_BYTES = 8 * HTB, NXCD = 8, WGM = 8;

__host__ __device__ __forceinline__ int lds_byte(int r, int c) { const int st = (r >> 4) * 2 + (c >> 5), rr = r & 15, cc = c & 31, ob = rr * 64 + cc * 2; return st * 1024 + (ob ^ (((ob >> 9) & 1) << 5)); }
__host__ __device__ __forceinline__ void stage_rc(int b, int& R, int& C) { const int st = b / 1024, sb = b % 1024, swz = sb ^ (((sb >> 9) & 1) << 5); R = (st >> 1) * 16 + swz / 64; C = (st & 1) * 32 + (swz % 64) / 2; }
__host__ __device__ __forceinline__ int perm32(int rho) { const int n = rho >> 4, i = rho & 15; return 8 * (i >> 2) + 4 * n + (i & 3); }

struct Unit { int a, b;
    __device__ __forceinline__ int pm() const { return a & 0xff; } __device__ __forceinline__ int pn() const { return (a >> 8) & 0xff; } __device__ __forceinline__ int kind() const { return (a >> 16) & 0xf; } __device__ __forceinline__ int sl() const { return (a >> 20) & 0xff; }
    __device__ __forceinline__ int k0() const { return b & 0xffff; } __device__ __forceinline__ int nt() const { return b >> 16; }
    __device__ __forceinline__ void set(int pm_, int pn_, int k0_, int nt_, int kind_, int sl_) { a = pm_ | (pn_ << 8) | (kind_ << 16) | (sl_ << 20); b = k0_ | (nt_ << 16); } };
struct Gemm { const bf16_t* A; const bf16_t* Bt; int M, N, K; int wave = 0; };

template <int MODE> struct PackedOrder {
    int nM, nN, nwg, G, c, ntfull, nmain, rank, nextra, nfirst, xstride, NX, nE;
    __device__ __forceinline__ void init(int nM_, int nN_, int G_, int c_, int ntfull_, int nE_ = 0) { nM = nM_; nN = nN_; nwg = nM * nN; G = G_; c = c_; ntfull = ntfull_; nE = nE_;
        const int rem = nwg % G; nmain = nwg / G + (c < rem ? 1 : 0); rank = c - rem; if (rank < 0) rank += G;
        NX = MODE == 0 ? 3 * (nE + 32) : (MODE == 4 ? 3 * nE : (MODE == 2 ? 344 : 256));
        if (MODE == 0 || MODE == 4) { const int nlight = rem ? G - rem : G; xstride = nlight; nextra = rank < nlight ? (NX - rank + nlight - 1) / nlight : 0; }
        else if (MODE == 2 && G == 256) { xstride = 1; nextra = rank < 64 ? 4 : (rank - 64 < NX - 256 ? 1 : 0); }
        else { xstride = G; nextra = rank < NX ? (NX - rank + G - 1) / G : 0; }
        if (nextra < 0) nextra = 0;
        nfirst = (MODE != 2 && (c & 7) < 4) ? nextra : 0;
    }
    __device__ __forceinline__ bool next(int i, Unit& u) const {
        int j = -1;
        int im = i - nfirst;
        if (i < nfirst) j = i; else if (im >= nmain) { j = nfirst + (im - nmain); if (j >= nextra) return false; }
        if (j < 0) { int wgid = im * G + c; { const int q = nwg / NXCD, r = nwg % NXCD, xcd = wgid % NXCD, off = wgid / NXCD; wgid = (xcd < r ? xcd * (q + 1) : r * (q + 1) + (xcd - r) * q) + off; }
            const int nig = WGM * nN, gid = wgid / nig, fm = gid * WGM, gsz = (nM - fm) < WGM ? (nM - fm) : WGM;
            u.set(fm + ((wgid % nig) % gsz), (wgid % nig) / gsz, 0, ntfull, 0, 0); return true; }
        int x;
        if (MODE == 2 && G == 256) x = rank < 64 ? rank * 4 + j : 256 + rank - 64; else x = rank + j * xstride;
        if (MODE == 0 || MODE == 4) { const int id = x / 3, s = x - 3 * id, pairs = ntfull / 2, base = pairs / 3, rem3 = pairs % 3;
            const int k0 = 2 * (s < rem3 ? (base + 1) * s : (base + 1) * rem3 + base * (s - rem3)), nt = 2 * (s < rem3 ? base + 1 : base);
            if (MODE == 4 || id < nE) u.set(32, id, k0, nt, 1, s); else u.set(id - nE, nE - 1, k0, nt, 2, s); }
        else if (MODE == 1) u.set(32, x >> 4, 4 * (x & 15), 4, 1, x & 15);
        else if (MODE == 2) u.set(32, x >> 2, (ntfull / 4) * (x & 3), ntfull / 4, 1, x & 3);
        else { const int s = x & 15, pairs = ntfull / 2, base = pairs / 16, rem = pairs % 16;
            u.set(32, x >> 4, 2 * (s < rem ? (base + 1) * s : (base + 1) * rem + base * (s - rem)), 2 * (s < rem ? base + 1 : base), 1, s); }
        return true;
    }
    __device__ __forceinline__ void a_ready(const Unit&) const {}
    __device__ __forceinline__ void done(const Unit&) const {}
};

typedef unsigned u32x2 __attribute__((ext_vector_type(2)));
__device__ __forceinline__ unsigned cvt_pk_bf16(float lo, float hi) { unsigned r; asm volatile("v_cvt_pk_bf16_f32 %0, %1, %2" : "=v"(r) : "v"(lo), "v"(hi)); return r; }
__device__ __forceinline__ float bf_lo(unsigned w) { return __uint_as_float(w << 16); }
__device__ __forceinline__ float bf_hi(unsigned w) { return __uint_as_float(w & 0xffff0000u); }
__device__ __forceinline__ float silu_f(float a) { return a * __builtin_amdgcn_rcpf(1.0f + __builtin_amdgcn_exp2f(-1.44269504089f * a)); }

constexpr int XROWS = 152;
struct EpiBf16 {
    static constexpr bool PERM = true, AFTER_DRAIN = false, I8 = false; typedef f32x4 acc_t;
    bf16_t* O; int ldc; float* slabX; float* slabA;
    __device__ __forceinline__ void operator()(const f32x4 (&acc)[2][2][4][2], const Unit& u, int wr, int wc, int fr, int fq) const {
        const int row0 = u.pm() * BM + wr * 64 + fr, col0 = u.pn() * BM + wc * 32 + 8 * fq;
        if (u.kind() == 1) { float* base = slabX + (size_t)u.sl() * XROWS * ldc + col0;
#pragma unroll
            for (int ai = 0; ai < 2; ++ai)
#pragma unroll
                for (int m = 0; m < 4; ++m) { const int r = ai * HALF + wr * 64 + m * 16 + fr; if (r < XROWS) { float* rowp = base + (size_t)r * ldc;
#pragma unroll
                    for (int bj = 0; bj < 2; ++bj) { *(f32x4*)(rowp + bj * HALF) = acc[ai][bj][m][0]; *(f32x4*)(rowp + bj * HALF + 4) = acc[ai][bj][m][1]; } } }
            return; }
        if (u.kind() == 2) { if (wc == 0 && fq < 2) { float* base = slabA + (size_t)u.sl() * 8192 * 16 + 8 * fq;
#pragma unroll
            for (int ai = 0; ai < 2; ++ai)
#pragma unroll
                for (int m = 0; m < 4; ++m) { float* p = base + (size_t)(row0 + ai * HALF + m * 16) * 16; *(f32x4*)p = acc[ai][0][m][0]; *(f32x4*)(p + 4) = acc[ai][0][m][1]; } }
            return; }
#pragma unroll
        for (int ai = 0; ai < 2; ++ai)
#pragma unroll
            for (int m = 0; m < 4; ++m) { bf16_t* rowp = O + (size_t)(row0 + ai * HALF + m * 16) * ldc + col0;
#pragma unroll
                for (int bj = 0; bj < 2; ++bj) { const f32x4 v0 = acc[ai][bj][m][0], v1 = acc[ai][bj][m][1];
                    u32x4 w; w.x = cvt_pk_bf16(v0[0], v0[1]); w.y = cvt_pk_bf16(v0[2], v0[3]); w.z = cvt_pk_bf16(v1[0], v1[1]); w.w = cvt_pk_bf16(v1[2], v1[3]);
                    *(u32x4*)(rowp + bj * HALF) = w; } }
    }
};
struct EpiResBf16 {
    static constexpr bool PERM = true, AFTER_DRAIN = false, I8 = false; typedef f32x4 acc_t;
    bf16_t* C; int ldc; const bf16_t* R; int ldr; float alpha; float* slab;
    __device__ __forceinline__ void operator()(const f32x4 (&acc)[2][2][4][2], const Unit& u, int wr, int wc, int fr, int fq) const {
        const int row0 = u.pm() * BM + wr * 64 + fr, col0 = u.pn() * BM + wc * 32 + 8 * fq;
        if (u.kind() != 0) {
#pragma unroll
            for (int m = 0; m < 4; ++m) { float* rowp = slab + ((size_t)u.sl() * 128 + wr * 64 + m * 16 + fr) * ldc + col0;
#pragma unroll
                for (int bj = 0; bj < 2; ++bj) { *(f32x4*)(rowp + bj * HALF) = acc[0][bj][m][0]; *(f32x4*)(rowp + bj * HALF + 4) = acc[0][bj][m][1]; } }
            return; }
#pragma unroll
        for (int ai = 0; ai < 2; ++ai) {
            u32x4 rvs[4][2];
#pragma unroll
            for (int m = 0; m < 4; ++m) { const bf16_t* rp = R + (size_t)(row0 + ai * HALF + m * 16) * ldr + col0; rvs[m][0] = __builtin_nontemporal_load((const u32x4*)rp); rvs[m][1] = __builtin_nontemporal_load((const u32x4*)(rp + HALF)); }
#pragma unroll
            for (int m = 0; m < 4; ++m) { const size_t row = (size_t)(row0 + ai * HALF + m * 16); bf16_t* rowp = C + row * ldc + col0;
#pragma unroll
                for (int bj = 0; bj < 2; ++bj) { const u32x4 rv = rvs[m][bj]; const f32x4 v0 = acc[ai][bj][m][0], v1 = acc[ai][bj][m][1];
                    u32x4 w; w.x = cvt_pk_bf16(v0[0] + alpha * bf_lo(rv.x), v0[1] + alpha * bf_hi(rv.x)); w.y = cvt_pk_bf16(v0[2] + alpha * bf_lo(rv.y), v0[3] + alpha * bf_hi(rv.y));
                    w.z = cvt_pk_bf16(v1[0] + alpha * bf_lo(rv.z), v1[1] + alpha * bf_hi(rv.z)); w.w = cvt_pk_bf16(v1[2] + alpha * bf_lo(rv.w), v1[3] + alpha * bf_hi(rv.w));
                    *(u32x4*)(rowp + bj * HALF) = w; } } }
    }
};
struct EpiSwiGLU {
    static constexpr bool PERM = true, AFTER_DRAIN = false, I8 = false; typedef f32x4 acc_t;
    bf16_t* O; int ldc; float* slab; int lds_;
    __device__ __forceinline__ void operator()(const f32x4 (&acc)[2][2][4][2], const Unit& u, int wr, int wc, int fr, int fq) const {
        const int row0 = u.pm() * BM + wr * 64 + fr, col0 = u.pn() * HALF + wc * 32 + 8 * fq;
        if (u.kind() != 0) {
#pragma unroll
            for (int m = 0; m < 4; ++m) { float* rowp = slab + ((size_t)u.sl() * 128 + wr * 64 + m * 16 + fr) * lds_ + u.pn() * BM + wc * 32 + 8 * fq;
#pragma unroll
                for (int bj = 0; bj < 2; ++bj) { *(f32x4*)(rowp + bj * HALF) = acc[0][bj][m][0]; *(f32x4*)(rowp + bj * HALF + 4) = acc[0][bj][m][1]; } }
            return; }
#pragma unroll
        for (int ai = 0; ai < 2; ++ai)
#pragma unroll
            for (int m = 0; m < 4; ++m) { bf16_t* rowp = O + (size_t)(row0 + ai * HALF + m * 16) * ldc + col0;
                const f32x4 g0 = acc[ai][0][m][0], g1 = acc[ai][0][m][1], u0 = acc[ai][1][m][0], u1 = acc[ai][1][m][1];
                u32x4 w; w.x = cvt_pk_bf16(silu_f(g0[0]) * u0[0], silu_f(g0[1]) * u0[1]); w.y = cvt_pk_bf16(silu_f(g0[2]) * u0[2], silu_f(g0[3]) * u0[3]);
                w.z = cvt_pk_bf16(silu_f(g1[0]) * u1[0], silu_f(g1[1]) * u1[1]); w.w = cvt_pk_bf16(silu_f(g1[2]) * u1[2], silu_f(g1[3]) * u1[3]);
                *(u32x4*)rowp = w; }
    }
};


typedef int i32x4e __attribute__((ext_vector_type(4)));
struct EpiSwiGLUi8 {
    static constexpr bool PERM = true, AFTER_DRAIN = false, I8 = true; typedef i32x4e acc_t;
    bf16_t* O; int ldc; float* slab; int lds_; const float* rs; const float* cm;
    __device__ __forceinline__ void operator()(const i32x4e (&acc)[2][2][4][2], const Unit& u, int wr, int wc, int fr, int fq) const {
        const int row0 = u.pm() * BM + wr * 64 + fr, col0 = u.pn() * HALF + wc * 32 + 8 * fq, gcol = u.pn() * BM + wc * 32 + 8 * fq;
        f32x4 cg0 = *(const f32x4*)(cm + gcol), cg1 = *(const f32x4*)(cm + gcol + 4), cu0 = *(const f32x4*)(cm + gcol + HALF), cu1 = *(const f32x4*)(cm + gcol + HALF + 4);
        cg0 *= (1.0f / 127.0f); cg1 *= (1.0f / 127.0f); cu0 *= (1.0f / 127.0f); cu1 *= (1.0f / 127.0f);
        if (u.kind() != 0) {
            float sx[4];
#pragma unroll
            for (int m = 0; m < 4; ++m) sx[m] = rs[u.pm() * BM + wr * 64 + m * 16 + fr];
#pragma unroll
            for (int m = 0; m < 4; ++m) { const int r = wr * 64 + m * 16 + fr; const float s = sx[m]; float* rowp = slab + ((size_t)u.sl() * 128 + r) * lds_ + gcol;
                const i32x4e a0 = acc[0][0][m][0], a1 = acc[0][0][m][1], b0 = acc[0][1][m][0], b1 = acc[0][1][m][1];
                *(f32x4*)(rowp) = (f32x4){(float)a0[0], (float)a0[1], (float)a0[2], (float)a0[3]} * cg0 * s; *(f32x4*)(rowp + 4) = (f32x4){(float)a1[0], (float)a1[1], (float)a1[2], (float)a1[3]} * cg1 * s;
                *(f32x4*)(rowp + HALF) = (f32x4){(float)b0[0], (float)b0[1], (float)b0[2], (float)b0[3]} * cu0 * s; *(f32x4*)(rowp + HALF + 4) = (f32x4){(float)b1[0], (float)b1[1], (float)b1[2], (float)b1[3]} * cu1 * s; }
            return; }
        float scs[2][4];
#pragma unroll
        for (int ai = 0; ai < 2; ++ai)
#pragma unroll
            for (int m = 0; m < 4; ++m) scs[ai][m] = rs[row0 + ai * HALF + m * 16];
#pragma unroll
        for (int ai = 0; ai < 2; ++ai)
#pragma unroll
            for (int m = 0; m < 4; ++m) { const int row = row0 + ai * HALF + m * 16; const float s = scs[ai][m]; bf16_t* rowp = O + (size_t)row * ldc + col0;
                const i32x4e a0 = acc[ai][0][m][0], a1 = acc[ai][0][m][1], b0 = acc[ai][1][m][0], b1 = acc[ai][1][m][1];
                const f32x4 g0 = (f32x4){(float)a0[0], (float)a0[1], (float)a0[2], (float)a0[3]} * cg0 * s, g1 = (f32x4){(float)a1[0], (float)a1[1], (float)a1[2], (float)a1[3]} * cg1 * s;
                const f32x4 u0 = (f32x4){(float)b0[0], (float)b0[1], (float)b0[2], (float)b0[3]} * cu0 * s, u1 = (f32x4){(float)b1[0], (float)b1[1], (float)b1[2], (float)b1[3]} * cu1 * s;
                const f32x4 y0 = (f32x4){silu_f(g0[0]) * u0[0], silu_f(g0[1]) * u0[1], silu_f(g0[2]) * u0[2], silu_f(g0[3]) * u0[3]}, y1 = (f32x4){silu_f(g1[0]) * u1[0], silu_f(g1[1]) * u1[1], silu_f(g1[2]) * u1[2], silu_f(g1[3]) * u1[3]};
                u32x4 w; w.x = cvt_pk_bf16(y0[0], y0[1]); w.y = cvt_pk_bf16(y0[2], y0[3]); w.z = cvt_pk_bf16(y1[0], y1[1]); w.w = cvt_pk_bf16(y1[2], y1[3]);
                *(u32x4*)rowp = w;
                }
    }
};
struct EpiResI8 {
    static constexpr bool PERM = true, AFTER_DRAIN = false, I8 = true; typedef i32x4e acc_t;
    bf16_t* C; int ldc; const bf16_t* R; int ldr; float alpha; float* slab; const float* amax; const float* cm;
    __device__ __forceinline__ void operator()(const i32x4e (&acc)[2][2][4][2], const Unit& u, int wr, int wc, int fr, int fq) const {
        const int row0 = u.pm() * BM + wr * 64 + fr, col0 = u.pn() * BM + wc * 32 + 8 * fq;
        f32x4 c00 = *(const f32x4*)(cm + col0), c01 = *(const f32x4*)(cm + col0 + 4), c10 = *(const f32x4*)(cm + col0 + HALF), c11 = *(const f32x4*)(cm + col0 + HALF + 4);
        const float k2 = 1.0f / (127.0f * 127.0f); c00 *= k2; c01 *= k2; c10 *= k2; c11 *= k2;
        if (u.kind() != 0) {
            float sx[4];
#pragma unroll
            for (int m = 0; m < 4; ++m) sx[m] = amax[u.pm() * BM + wr * 64 + m * 16 + fr];
#pragma unroll
            for (int m = 0; m < 4; ++m) { const int r = wr * 64 + m * 16 + fr; const float s = sx[m]; float* rowp = slab + ((size_t)u.sl() * 128 + r) * ldc + col0;
                const i32x4e a0 = acc[0][0][m][0], a1 = acc[0][0][m][1], b0 = acc[0][1][m][0], b1 = acc[0][1][m][1];
                *(f32x4*)(rowp) = (f32x4){(float)a0[0], (float)a0[1], (float)a0[2], (float)a0[3]} * c00 * s; *(f32x4*)(rowp + 4) = (f32x4){(float)a1[0], (float)a1[1], (float)a1[2], (float)a1[3]} * c01 * s;
                *(f32x4*)(rowp + HALF) = (f32x4){(float)b0[0], (float)b0[1], (float)b0[2], (float)b0[3]} * c10 * s; *(f32x4*)(rowp + HALF + 4) = (f32x4){(float)b1[0], (float)b1[1], (float)b1[2], (float)b1[3]} * c11 * s; }
            return; }
#pragma unroll
        for (int ai = 0; ai < 2; ++ai) {
            u32x4 rvs[4][2]; float scs[4];
#pragma unroll
            for (int m = 0; m < 4; ++m) { const size_t row = (size_t)(row0 + ai * HALF + m * 16); const bf16_t* rp = R + row * ldr + col0; scs[m] = amax[row]; rvs[m][0] = __builtin_nontemporal_load((const u32x4*)rp); rvs[m][1] = __builtin_nontemporal_load((const u32x4*)(rp + HALF)); }
#pragma unroll
            for (int m = 0; m < 4; ++m) { const size_t row = (size_t)(row0 + ai * HALF + m * 16); const float s = scs[m]; bf16_t* rowp = C + row * ldc + col0;
#pragma unroll
                for (int bj = 0; bj < 2; ++bj) { const u32x4 rv = rvs[m][bj]; const i32x4e a0 = acc[ai][bj][m][0], a1 = acc[ai][bj][m][1];
                    const f32x4 v0 = (f32x4){(float)a0[0], (float)a0[1], (float)a0[2], (float)a0[3]} * (bj ? c10 : c00) * s, v1 = (f32x4){(float)a1[0], (float)a1[1], (float)a1[2], (float)a1[3]} * (bj ? c11 : c01) * s;
                    u32x4 w; w.x = cvt_pk_bf16(v0[0] + alpha * bf_lo(rv.x), v0[1] + alpha * bf_hi(rv.x)); w.y = cvt_pk_bf16(v0[2] + alpha * bf_lo(rv.y), v0[3] + alpha * bf_hi(rv.y));
                    w.z = cvt_pk_bf16(v1[0] + alpha * bf_lo(rv.z), v1[1] + alpha * bf_hi(rv.z)); w.w = cvt_pk_bf16(v1[2] + alpha * bf_lo(rv.w), v1[3] + alpha * bf_hi(rv.w));
                    *(u32x4*)(rowp + bj * HALF) = w; } } }
    }
};

struct EpiBf16I8 {
    static constexpr bool PERM = true, AFTER_DRAIN = false, I8 = true; typedef i32x4e acc_t;
    bf16_t* O; int ldc; float* slabX; const float* rs; const float* cm; int nwrap, wrapoff;
    __device__ __forceinline__ void operator()(const i32x4e (&acc)[2][2][4][2], const Unit& u, int wr, int wc, int fr, int fq) const {
        const int row0 = u.pm() * BM + wr * 64 + fr, col0 = u.pn() * BM + wc * 32 + 8 * fq, ocol = u.pn() < nwrap ? col0 : col0 + wrapoff;
        f32x4 c00 = *(const f32x4*)(cm + col0), c01 = *(const f32x4*)(cm + col0 + 4), c10 = *(const f32x4*)(cm + col0 + HALF), c11 = *(const f32x4*)(cm + col0 + HALF + 4);
        c00 *= (1.0f / 127.0f); c01 *= (1.0f / 127.0f); c10 *= (1.0f / 127.0f); c11 *= (1.0f / 127.0f);
        if (u.kind() != 0) { float* base = slabX + (size_t)u.sl() * XROWS * ldc + col0;
            float sx[2][4];
#pragma unroll
            for (int ai = 0; ai < 2; ++ai)
#pragma unroll
                for (int m = 0; m < 4; ++m) sx[ai][m] = rs[u.pm() * BM + ai * HALF + wr * 64 + m * 16 + fr];
#pragma unroll
            for (int ai = 0; ai < 2; ++ai)
#pragma unroll
                for (int m = 0; m < 4; ++m) { const int r = ai * HALF + wr * 64 + m * 16 + fr; if (r < XROWS) { const float s = sx[ai][m]; float* rowp = base + (size_t)r * ldc;
                    const i32x4e a0 = acc[ai][0][m][0], a1 = acc[ai][0][m][1], b0 = acc[ai][1][m][0], b1 = acc[ai][1][m][1];
                    *(f32x4*)(rowp) = (f32x4){(float)a0[0], (float)a0[1], (float)a0[2], (float)a0[3]} * c00 * s; *(f32x4*)(rowp + 4) = (f32x4){(float)a1[0], (float)a1[1], (float)a1[2], (float)a1[3]} * c01 * s;
                    *(f32x4*)(rowp + HALF) = (f32x4){(float)b0[0], (float)b0[1], (float)b0[2], (float)b0[3]} * c10 * s; *(f32x4*)(rowp + HALF + 4) = (f32x4){(float)b1[0], (float)b1[1], (float)b1[2], (float)b1[3]} * c11 * s; } }
            return; }
        float scs[2][4];
#pragma unroll
        for (int ai = 0; ai < 2; ++ai)
#pragma unroll
            for (int m = 0; m < 4; ++m) scs[ai][m] = rs[row0 + ai * HALF + m * 16];
#pragma unroll
        for (int ai = 0; ai < 2; ++ai)
#pragma unroll
            for (int m = 0; m < 4; ++m) { const int row = row0 + ai * HALF + m * 16; const float s = scs[ai][m]; bf16_t* rowp = O + (size_t)row * ldc + ocol;
#pragma unroll
                for (int bj = 0; bj < 2; ++bj) { const i32x4e a0 = acc[ai][bj][m][0], a1 = acc[ai][bj][m][1];
                    const f32x4 v0 = (f32x4){(float)a0[0], (float)a0[1], (float)a0[2], (float)a0[3]} * (bj ? c10 : c00) * s, v1 = (f32x4){(float)a1[0], (float)a1[1], (float)a1[2], (float)a1[3]} * (bj ? c11 : c01) * s;
                    u32x4 w; w.x = cvt_pk_bf16(v0[0], v0[1]); w.y = cvt_pk_bf16(v0[2], v0[3]); w.z = cvt_pk_bf16(v1[0], v1[1]); w.w = cvt_pk_bf16(v1[2], v1[3]);
                    *(u32x4*)(rowp + bj * HALF) = w; } }
    }
};
typedef int i32x4 __attribute__((ext_vector_type(4)));
template <bool I8> struct Mma16;
template <> struct Mma16<false> { static __device__ __forceinline__ f32x4 run(bf16x8 a, bf16x8 b, f32x4 c) { return __builtin_amdgcn_mfma_f32_16x16x32_bf16(a, b, c, 0, 0, 0); } };
template <> struct Mma16<true> { static __device__ __forceinline__ i32x4 run(bf16x8 a, bf16x8 b, i32x4 c) { return __builtin_amdgcn_mfma_i32_16x16x64_i8(__builtin_bit_cast(i32x4, a), __builtin_bit_cast(i32x4, b), c, 0, 0, 0); } };
template <bool I8, class T> __device__ __forceinline__ T mma16(bf16x8 a, bf16x8 b, T c) { return Mma16<I8>::run(a, b, c); }
struct NoSide { static constexpr int NV = 0; __device__ __forceinline__ void step() {} __device__ __forceinline__ void consume() {} };
template <class Epi, class Sched, bool ALIGN_EPI, bool SP2, class Side>
__device__ __forceinline__ void gemm_phase(PG8_LAS unsigned char* lds, const Gemm g, const Sched& S, const Epi& E, Side& sd) {
    int tid_ = g.wave * 64 + (int)__builtin_amdgcn_mbcnt_hi(~0u, __builtin_amdgcn_mbcnt_lo(~0u, 0u)); asm volatile("" : "+v"(tid_));
    const int tid = tid_, wid = __builtin_amdgcn_readfirstlane(tid >> 6), lane = tid & 63, wr = wid >> 2, wc = wid & 3, fr = lane & 15, fq = lane >> 4;
    const int K = g.K;
    unsigned voffA[2], voffB[2];
#pragma unroll
    for (int i = 0; i < 2; ++i) { int R, C; stage_rc(tid * 16 + i * 8192, R, C); const int Rb = Epi::PERM ? ((R & ~31) + perm32(R & 31)) : R;
        voffA[i] = (unsigned)(R * K + C) * 2u; voffB[i] = (unsigned)(Rb * K + C) * 2u; }
    const size_t kstep = (size_t)(BK * 2);
    const size_t hstep = (size_t)HALF * K * 2;
    const size_t tstep = 2 * hstep;
    const unsigned ldsw = (unsigned)wid * 1024u;
    const int aoff = lds_byte(wr * 64 + fr, fq * 8), boff = lds_byte(wc * 32 + fr, fq * 8);
#define PG8_SA(b, h) (((b) * 2 + (h)) * HTB)
#define PG8_SB(b, h) ((4 + (b) * 2 + (h)) * HTB)
#define PG8_STAGE(bufoff, gbase, voff) do { _Pragma("unroll") for (int _i = 0; _i < 2; ++_i) \
        __builtin_amdgcn_global_load_lds((const unsigned*)((const char*)(gbase) + (voff)[_i]), (PG8_LAS unsigned*)(lds + (bufoff) + ldsw + _i * 8192), 16, 0, 0); } while (0)
#define PG8_LDA(dst, b, h) do { _Pragma("unroll") for (int m = 0; m < 4; ++m) _Pragma("unroll") for (int k = 0; k < 2; ++k) dst[m][k] = *(const PG8_LAS bf16x8*)(lds + PG8_SA(b, h) + aoff + m * 2048 + k * 1024); } while (0)
#define PG8_LDB(dst, b, h) do { _Pragma("unroll") for (int n = 0; n < 2; ++n) _Pragma("unroll") for (int k = 0; k < 2; ++k) dst[n][k] = *(const PG8_LAS bf16x8*)(lds + PG8_SB(b, h) + boff + n * 2048 + k * 1024); } while (0)
#define PG8_MMA(ai, bj, At, Bt) do { __builtin_amdgcn_s_setprio(1); _Pragma("unroll") for (int m = 0; m < 4; ++m) _Pragma("unroll") for (int n = 0; n < 2; ++n) _Pragma("unroll") for (int k = 0; k < 2; ++k) \
        acc[ai][bj][m][n] = mma16<Epi::I8>(Bt[n][k], At[m][k], acc[ai][bj][m][n]); __builtin_amdgcn_s_setprio(0); } while (0)
#define PG8_WAIT_V(n) asm volatile("s_waitcnt vmcnt(" #n ")" ::: "memory")
#define PG8_WAIT_VS() asm volatile("s_waitcnt vmcnt(%0)" :: "n"(8 + Side::NV) : "memory")
#define PG8_WAIT_L(n) asm volatile("s_waitcnt lgkmcnt(" #n ")" ::: "memory")
#define PG8_BAR __builtin_amdgcn_s_barrier()
#define PG8_SCHED __builtin_amdgcn_sched_barrier(0)
    Unit cur, nxt; int ui = 0;
    if (!S.next(0, cur)) return;
    typedef typename Epi::acc_t acc_t;
    acc_t acc[2][2][4][2];
#pragma unroll
    for (int a = 0; a < 2; ++a)
#pragma unroll
        for (int b = 0; b < 2; ++b)
#pragma unroll
            for (int m = 0; m < 4; ++m)
#pragma unroll
                for (int n = 0; n < 2; ++n) acc[a][b][m][n] = (acc_t){0, 0, 0, 0};
    bf16x8 At[4][2], B0[2][2], B1[2][2];
    const char* cA = (const char*)g.A + (size_t)cur.pm() * tstep + (size_t)cur.k0() * kstep; const char* cB = (const char*)g.Bt + (size_t)cur.pn() * tstep + (size_t)cur.k0() * kstep;
    S.a_ready(cur);
    if constexpr (SP2) {
        PG8_STAGE(PG8_SB(0, 0), cB, voffB); PG8_STAGE(PG8_SB(0, 1), cB + hstep, voffB); PG8_STAGE(PG8_SA(0, 0), cA, voffA); PG8_STAGE(PG8_SA(0, 1), cA + hstep, voffA);
        if (wr == 1) PG8_BAR;
        PG8_WAIT_V(2); PG8_BAR;
        PG8_STAGE(PG8_SB(1, 0), cB + kstep, voffB); PG8_STAGE(PG8_SA(1, 0), cA + kstep, voffA); PG8_STAGE(PG8_SB(1, 1), cB + hstep + kstep, voffB);
        PG8_WAIT_V(6); PG8_BAR;
    } else {
        PG8_STAGE(PG8_SB(0, 0), cB, voffB); PG8_STAGE(PG8_SA(0, 0), cA, voffA); PG8_STAGE(PG8_SB(0, 1), cB + hstep, voffB); PG8_STAGE(PG8_SA(0, 1), cA + hstep, voffA);
        if (wr == 1) PG8_BAR;
        PG8_WAIT_V(4); PG8_BAR;
        PG8_STAGE(PG8_SB(1, 0), cB + kstep, voffB); PG8_STAGE(PG8_SA(1, 0), cA + kstep, voffA); PG8_STAGE(PG8_SB(1, 1), cB + hstep + kstep, voffB);
        PG8_WAIT_V(6); PG8_BAR;
    }
    for (;;) {
        const bool has_next = S.next(ui + 1, nxt);
        const char* nA = has_next ? (const char*)g.A + (size_t)nxt.pm() * tstep + (size_t)nxt.k0() * kstep : cA; const char* nB = has_next ? (const char*)g.Bt + (size_t)nxt.pn() * tstep + (size_t)nxt.k0() * kstep : cB;
        const int nt = cur.nt();
        for (int t = 0; t < nt; t += 2) {
            const bool last = (t == nt - 2);
            const char* a1 = cA + (size_t)(t + 1) * kstep;
            const char* a2 = last ? nA : cA + (size_t)(t + 2) * kstep; const char* b2 = last ? nB : cB + (size_t)(t + 2) * kstep;
            const char* a3 = a2 + kstep; const char* b3 = b2 + kstep;
            if (last && has_next) S.a_ready(nxt);
            if constexpr (SP2) {
            sd.step(); PG8_SCHED;
            PG8_LDB(B0, 0, 0); PG8_LDB(B1, 0, 1); PG8_SCHED; PG8_LDA(At, 0, 0); PG8_STAGE(PG8_SA(1, 1), a1 + hstep, voffA);
            PG8_WAIT_VS(); PG8_WAIT_L(0); PG8_BAR; PG8_MMA(0, 0, At, B0); PG8_MMA(0, 1, At, B1); PG8_BAR; PG8_SCHED;
            PG8_LDA(At, 0, 1); PG8_STAGE(PG8_SB(0, 0), b2, voffB); PG8_STAGE(PG8_SB(0, 1), b2 + hstep, voffB); PG8_STAGE(PG8_SA(0, 0), a2, voffA);
            PG8_WAIT_VS(); PG8_WAIT_L(0); PG8_BAR; PG8_MMA(1, 0, At, B0); PG8_MMA(1, 1, At, B1); PG8_BAR; PG8_SCHED;
            PG8_LDB(B0, 1, 0); PG8_LDB(B1, 1, 1); PG8_SCHED; PG8_LDA(At, 1, 0); PG8_STAGE(PG8_SA(0, 1), a2 + hstep, voffA);
            PG8_WAIT_V(8); PG8_WAIT_L(0); PG8_BAR; if constexpr (Side::NV > 0) { PG8_SCHED; sd.consume(); PG8_SCHED; }
            PG8_MMA(0, 0, At, B0); PG8_MMA(0, 1, At, B1); PG8_BAR; PG8_SCHED;
            PG8_LDA(At, 1, 1); PG8_STAGE(PG8_SB(1, 0), b3, voffB); PG8_STAGE(PG8_SB(1, 1), b3 + hstep, voffB); PG8_STAGE(PG8_SA(1, 0), a3, voffA);
            PG8_WAIT_V(8); PG8_WAIT_L(0); PG8_BAR; PG8_MMA(1, 0, At, B0); PG8_MMA(1, 1, At, B1); PG8_BAR; PG8_SCHED;
            } else {
            PG8_LDB(B0, 0, 0); PG8_SCHED; PG8_LDA(At, 0, 0); PG8_STAGE(PG8_SA(1, 1), a1 + hstep, voffA);
            PG8_WAIT_L(8); PG8_BAR; PG8_WAIT_L(0); PG8_MMA(0, 0, At, B0); PG8_BAR; PG8_SCHED;
            PG8_LDB(B1, 0, 1); PG8_STAGE(PG8_SB(0, 0), b2, voffB);
            PG8_BAR; PG8_WAIT_L(0); PG8_MMA(0, 1, At, B1); PG8_BAR;
            PG8_LDA(At, 0, 1); PG8_STAGE(PG8_SA(0, 0), a2, voffA);
            PG8_BAR; PG8_WAIT_L(0); PG8_MMA(1, 0, At, B0); PG8_BAR; PG8_SCHED;
            PG8_STAGE(PG8_SB(0, 1), b2 + hstep, voffB);
            PG8_WAIT_V(6); PG8_BAR; PG8_MMA(1, 1, At, B1); PG8_BAR;
            PG8_LDB(B0, 1, 0); PG8_SCHED; PG8_LDA(At, 1, 0); PG8_STAGE(PG8_SA(0, 1), a2 + hstep, voffA);
            PG8_WAIT_L(8); PG8_BAR; PG8_WAIT_L(0); PG8_MMA(0, 0, At, B0); PG8_BAR; PG8_SCHED;
            PG8_LDB(B1, 1, 1); PG8_STAGE(PG8_SB(1, 0), b3, voffB);
            PG8_BAR; PG8_WAIT_L(0); PG8_MMA(0, 1, At, B1); PG8_BAR;
            PG8_LDA(At, 1, 1); PG8_STAGE(PG8_SA(1, 0), a3, voffA);
            PG8_BAR; PG8_WAIT_L(0); PG8_MMA(1, 0, At, B0); PG8_BAR; PG8_SCHED;
            PG8_STAGE(PG8_SB(1, 1), b3 + hstep, voffB);
            PG8_WAIT_V(6); PG8_BAR; PG8_MMA(1, 1, At, B1); PG8_BAR;
            }
        }
        if constexpr (ALIGN_EPI) { if (wr == 0) PG8_BAR; }
        if constexpr (!Epi::AFTER_DRAIN) { int fr_ = fr, fq_ = fq; asm volatile("" : "+v"(fr_), "+v"(fq_));
            E(acc, cur, wr, wc, fr_, fq_); S.done(cur); }
        if (!has_next) break;
#pragma unroll
        for (int a = 0; a < 2; ++a)
#pragma unroll
            for (int b = 0; b < 2; ++b)
#pragma unroll
                for (int m = 0; m < 4; ++m)
#pragma unroll
                    for (int n = 0; n < 2; ++n) acc[a][b][m][n] = (acc_t){0, 0, 0, 0};
        cur = nxt; cA = nA; cB = nB; ++ui;
        if constexpr (ALIGN_EPI) { if (wr == 1) PG8_BAR; }
    }
    PG8_WAIT_V(0);
    if constexpr (!ALIGN_EPI) { if (wr == 0) PG8_BAR; }
    PG8_BAR;
    if constexpr (Epi::AFTER_DRAIN) { E.fused(acc, cur, wr, wc, fr, fq, lds, wid, lane); S.done(cur); }
#undef PG8_SA
#undef PG8_SB
#undef PG8_STAGE
#undef PG8_LDA
#undef PG8_LDB
#undef PG8_MMA
#undef PG8_WAIT_V
#undef PG8_WAIT_L
#undef PG8_WAIT_VS
#undef PG8_BAR
#undef PG8_SCHED
}
template <class Epi, class Sched, bool ALIGN_EPI = false, bool SP2 = false>
__device__ __forceinline__ void gemm_phase(PG8_LAS unsigned char* lds, const Gemm g, const Sched& S, const Epi& E) { NoSide ns; gemm_phase<Epi, Sched, ALIGN_EPI, SP2, NoSide>(lds, g, S, E, ns); }
}

#ifndef PG8_SP2
#define PG8_SP2 true
#endif
#ifndef PG8_ALIGN
#define PG8_ALIGN true
#endif
#define GAS __attribute__((address_space(1)))
#define LAS __attribute__((address_space(3)))
typedef unsigned short bf16;
typedef unsigned v4u __attribute__((ext_vector_type(4)));
typedef float f32x4 __attribute__((ext_vector_type(4)));
typedef short bf16x8 __attribute__((ext_vector_type(8)));
typedef GAS unsigned gu32;
typedef GAS unsigned long long gu64;
#define RLX_AGENT __ATOMIC_RELAXED, __HIP_MEMORY_SCOPE_AGENT
#define LDS_WAIT() asm volatile("s_waitcnt lgkmcnt(0)" ::: "memory")
#define VM_WAIT() asm volatile("s_waitcnt vmcnt(0)" ::: "memory")
__device__ __forceinline__ unsigned long long rt() { return __builtin_amdgcn_s_memrealtime(); }
__device__ __forceinline__ unsigned f2bf(float f) { unsigned u = __builtin_bit_cast(unsigned, f); return (u + 0x7fffu + ((u >> 16) & 1u)) >> 16; }
__device__ __forceinline__ unsigned pk2(float lo, float hi) { return f2bf(lo) | (f2bf(hi) << 16); }

#define XB_TMO      128
#define XB_XCNT(j)  (256  + 64 * (j))
#define XB_XSUB(j)  (1280 + 64 * (j))
#define XB_XGEN(j)  (2304 + 64 * (j))
#define XB_TOP      3328
#define XB_TOPGEN   3392
#define XCD_BAR_WORDS 3456
#define XB_SPIN_CAP (1u << 18)

__device__ __forceinline__ unsigned xb_ld(unsigned* p)              { return __hip_atomic_load(p, __ATOMIC_RELAXED, __HIP_MEMORY_SCOPE_AGENT); }
__device__ __forceinline__ unsigned xb_add(unsigned* p, unsigned v) { return __hip_atomic_fetch_add(p, v, __ATOMIC_RELAXED, __HIP_MEMORY_SCOPE_AGENT); }
__device__ __forceinline__ unsigned xb_xcc_id() { return (unsigned)__builtin_amdgcn_s_getreg((3 << 11) | 20) & 0xFu; }
#define XB_SPIN(cond, bar) do { unsigned _sp = 0; while (cond) { __builtin_amdgcn_s_sleep(1); \
    if ((++_sp & 255u) == 0u) { if (xb_ld(&(bar)[XB_TMO])) break; if (_sp > XB_SPIN_CAP) { atomicAdd(&(bar)[XB_TMO], 1u); break; } } } } while (0)

struct XcdBarrier {
    unsigned* bar; unsigned x; unsigned w;
    volatile LAS unsigned* st;
};

__device__ __forceinline__ XcdBarrier xcd_barrier_post(unsigned* bar, volatile LAS unsigned* st) {
    XcdBarrier b; b.bar = bar; b.x = xb_xcc_id(); b.st = st; b.w = (unsigned)__builtin_amdgcn_readfirstlane((int)(threadIdx.x >> 6));
    if (threadIdx.x == 0) (void)xb_add(&bar[XB_XCNT(b.x)], 1u);
    return b;
}
__device__ __forceinline__ void xcd_barrier_complete(unsigned* bar, unsigned x, unsigned& nloc, unsigned& nx) {
    const unsigned G = gridDim.x * gridDim.y * gridDim.z;
    unsigned sum, cnt, mine, sp = 0u;
    for (;;) {
        sum = 0u; cnt = 0u; mine = 0u;
#pragma unroll
        for (unsigned j = 0; j < 16; ++j) { const unsigned c = xb_ld(&bar[XB_XCNT(j)]); sum += c; cnt += (c > 0u) ? 1u : 0u; mine = (j == x) ? c : mine; }
        if (sum == G) break;
        __builtin_amdgcn_s_sleep(1);
        if ((++sp & 255u) == 0u) { if (xb_ld(&bar[XB_TMO])) break; if (sp > XB_SPIN_CAP) { atomicAdd(&bar[XB_TMO], 1u); break; } }
    }
    nloc = mine > 0u ? mine : 1u; nx = cnt > 0u ? cnt : 1u;
}

__device__ __forceinline__ void xcd_barrier(const XcdBarrier& b) {
    asm volatile("s_waitcnt vmcnt(0)" ::: "memory");
    __syncthreads();
    if (b.w == 0u && __builtin_amdgcn_mbcnt_hi(~0u, __builtin_amdgcn_mbcnt_lo(~0u, 0u)) == 0u) {
        unsigned* bar = b.bar;
        __builtin_amdgcn_s_waitcnt(0);
        unsigned nloc = b.st[0], nx = b.st[1];
        if (nloc == 0u) { xcd_barrier_complete(bar, b.x, nloc, nx); b.st[0] = nloc; b.st[1] = nx; }
        const unsigned old = xb_add(&bar[XB_XSUB(b.x)], 1u);
        const unsigned gen = old / nloc;
        if (old + 1u == (gen + 1u) * nloc) {
            __builtin_amdgcn_fence(__ATOMIC_RELEASE, "agent");
            asm volatile("s_waitcnt vmcnt(0)" ::: "memory");
            const unsigned og = xb_add(&bar[XB_TOP], 1u);
            const unsigned tg = og / nx;
            if (og + 1u == (tg + 1u) * nx) xb_add(&bar[XB_TOPGEN], 1u);
            else XB_SPIN(xb_ld(&bar[XB_TOPGEN]) == tg, bar);
            __builtin_amdgcn_fence(__ATOMIC_ACQUIRE, "agent");
            xb_add(&bar[XB_XGEN(b.x)], 1u);
            asm volatile("s_waitcnt vmcnt(0)" ::: "memory");
        } else {
            XB_SPIN(xb_ld(&bar[XB_XGEN(b.x)]) == gen, bar);
            __builtin_amdgcn_fence(__ATOMIC_ACQUIRE, "agent");
            asm volatile("s_waitcnt vmcnt(0)" ::: "memory");
        }
    }
    __syncthreads();
}

constexpr int NWAVES = 8;
constexpr int NCONV_CU = 0;
constexpr int D = 4096, NBATCH = 4, SEQ = 2048, NSAMP = 128, NMETA = 16;
constexpr int MPR = NBATCH * SEQ;
constexpr int ROW_S = MPR;
constexpr int ROW_META = MPR + NSAMP;
constexpr int MROWS = ROW_META + NMETA;
constexpr int MPAD = 8448;
constexpr int NIN = 12544;
constexpr int C_K = 0, C_V = 1024, C_CC = 3072, C_CH = 5120, C_AL = 7168, NBF = 7424, C_Q = 7424, C_G = 8448, C_CB = 10496, NI8X = 5120, NI8 = 9216;
static_assert(NBF + NI8X == 12544, "in-proj width");
constexpr int XROWS = pg8::XROWS;
constexpr int DFF = 11008, NGU = 2 * DFF;
constexpr int NH = 4, DK = 256, DV = 512, DGV = 2048, DCONV = 2048, RANK = 16, DGK = 1024;
constexpr float ALPHA = 1.18920711500272f;
constexpr float LN_EPS = 1e-5f, RMS_EPS = 1e-6f;
constexpr size_t O_YP = 0, O_YS = (size_t)MPR * D, O_GP = O_YS + (size_t)NSAMP * D, O_CP = O_GP + (size_t)NBATCH * NH * DK * DV,
                 O_GS = O_CP + (size_t)NBATCH * 2 * DCONV, O_CS = O_GS + (size_t)NSAMP * NH * DK * DV, O_END = O_CS + (size_t)NSAMP * 2 * DCONV;
constexpr size_t MiB = 1u << 20;
constexpr size_t WS_CTL = 0, CTL_ZERO_BYTES = 1 * MiB;
constexpr size_t WS_WIN = 1 * MiB;
constexpr size_t WS_WOUT = WS_WIN + 98 * MiB;
constexpr size_t WS_WGU = WS_WOUT + 32 * MiB;
constexpr size_t WS_WDN = WS_WGU + 172 * MiB;
constexpr size_t WS_H0 = WS_WDN + 86 * MiB;
constexpr size_t WS_PROJ = WS_H0 + 66 * MiB;
constexpr size_t WS_MIX = WS_PROJ + 203 * MiB;
constexpr size_t WS_OBUF = WS_MIX + 66 * MiB;
constexpr size_t WS_R = WS_OBUF + 33 * MiB;
constexpr size_t WS_SLAB = WS_R + 132 * MiB;
constexpr size_t WS_H1Q = WS_SLAB + 48 * MiB;
constexpr size_t WS_END = WS_H1Q + 34 * MiB;
constexpr size_t CTL_RS0 = 800 * 1024, CTL_CMIN = 840 * 1024;
constexpr size_t CTL_AMAX = 704 * 1024, CTL_CMDN = 768 * 1024;
constexpr size_t CTL_CMAX = 512 * 1024, CTL_RSC = 640 * 1024;
constexpr size_t SLAB_A_OFF = 24 * MiB;
static_assert((size_t)NIN * D * 2 <= 98 * MiB && (size_t)NGU * D * 2 <= 172 * MiB && (size_t)D * DFF * 2 <= 86 * MiB && (size_t)MPAD * D * 2 <= 66 * MiB && (size_t)MPAD * NIN * 2 <= 203 * MiB && (size_t)MPAD * D * 4 <= 132 * MiB, "ws map");
constexpr int CW_BAR = 4096;
constexpr int RING_OFF = 0, RING_BYTES = 131072;
constexpr int LDSCTL_OFF = RING_BYTES, MISC_OFF = LDSCTL_OFF + 320;
constexpr int LDS_BYTES = 147456;
static_assert(MISC_OFF + 128 <= LDS_BYTES, "LDS map");

__device__ __forceinline__ unsigned long long karg(int i) {
    const unsigned long long ka = (unsigned long long)__builtin_amdgcn_kernarg_segment_ptr(); unsigned long long p;
    asm volatile("s_load_dwordx2 %0, %1, %2\n\ts_waitcnt lgkmcnt(0)" : "=s"(p) : "s"(ka), "n"(i * 8) : "memory");
    return p;
}
enum { A_XP = 0, A_XS, A_SGLA, A_SCONV, A_META, A_EMBG, A_EMBB, A_WIN, A_WA2, A_BA, A_GNORM, A_CONVW, A_WOUT, A_LN1G, A_LN1B, A_WGATE, A_WUP, A_WDOWN, A_LN2G, A_LN2B, A_OUT, A_WS };
struct Frame {
    LAS unsigned char* lds;
    volatile LAS unsigned* MISC;
    gu32* ctl;
    int tid, lane, wave;
    int vcu, G;
    __device__ __forceinline__ void refresh() { int l = (int)__builtin_amdgcn_mbcnt_hi(~0u, __builtin_amdgcn_mbcnt_lo(~0u, 0u)); asm volatile("" : "+v"(l)); lane = l; tid = wave * 64 + l;   int g = G; asm volatile("" : "+s"(g)); G = g; }
    unsigned char* ws;
    template <int I> __device__ __forceinline__ const float* in() const { return (const float*)(const GAS float*)karg(I); }
    __device__ __forceinline__ float* out() const { return (float*)(GAS float*)karg(A_OUT); }
    __device__ __forceinline__ bf16* Wt_in() const { return (bf16*)(ws + WS_WIN); }
    __device__ __forceinline__ bf16* Wt_out() const { return (bf16*)(ws + WS_WOUT); }
    __device__ __forceinline__ bf16* Wt_gu() const { return (bf16*)(ws + WS_WGU); }
    __device__ __forceinline__ bf16* Wt_dn() const { return (bf16*)(ws + WS_WDN); }
    __device__ __forceinline__ bf16* h0() const { return (bf16*)(ws + WS_H0); }
    __device__ __forceinline__ bf16* proj() const { return (bf16*)(ws + WS_PROJ); }
    __device__ __forceinline__ bf16* act() const { return (bf16*)(ws + WS_PROJ); }
    __device__ __forceinline__ bf16* mix() const { return (bf16*)(ws + WS_MIX); }
    __device__ __forceinline__ bf16* h1() const { return (bf16*)(ws + WS_MIX); }
    __device__ __forceinline__ bf16* obuf() const { return (bf16*)(ws + WS_OBUF); }
    __device__ __forceinline__ bf16* R() const { return (bf16*)(ws + WS_R); }
    __device__ __forceinline__ unsigned char* gscr() const { return ws + WS_R; }
    __device__ __forceinline__ float* slab() const { return (float*)(ws + WS_SLAB); }
    __device__ __forceinline__ signed char* h1q() const { return (signed char*)(ws + WS_H1Q); }
    __device__ __forceinline__ float* cmax() const { return (float*)(ws + WS_CTL + CTL_CMAX); }
    __device__ __forceinline__ float* rsc() const { return (float*)(ws + WS_CTL + CTL_RSC); }
    __device__ __forceinline__ float* amax() const { return (float*)(ws + WS_CTL + CTL_AMAX); }
    __device__ __forceinline__ float* rs0() const { return (float*)(ws + WS_CTL + CTL_RS0); }
    __device__ __forceinline__ float* cmin() const { return (float*)(ws + WS_CTL + CTL_CMIN); }
    __device__ __forceinline__ signed char* h0q() const { return (signed char*)(ws + WS_WGU); }
    __device__ __forceinline__ signed char* Wq_in() const { return (signed char*)(ws + WS_WDN); }
    __device__ __forceinline__ float* cmdn() const { return (float*)(ws + WS_CTL + CTL_CMDN); }
    __device__ __forceinline__ signed char* actq() const { return (signed char*)(ws + WS_WIN); }
};
typedef unsigned u32x2v __attribute__((ext_vector_type(2)));
__device__ __forceinline__ float wave_sum(float v) {
#pragma unroll
    for (int o = 1; o < 64; o <<= 1) v += __shfl_xor(v, o);
    return v;
}
__device__ __forceinline__ unsigned q4(float a, float b, float c, float d, float inv) {
    int x = __float2int_rn(a * inv), y = __float2int_rn(b * inv), z = __float2int_rn(c * inv), w = __float2int_rn(d * inv);
    x = min(max(x, -127), 127); y = min(max(y, -127), 127); z = min(max(z, -127), 127); w = min(max(w, -127), 127);
    return (unsigned)(x & 0xff) | ((unsigned)(y & 0xff) << 8) | ((unsigned)(z & 0xff) << 16) | ((unsigned)(w & 0xff) << 24);
}
__device__ __forceinline__ float wave_max(float v) {
#pragma unroll
    for (int o = 1; o < 64; o <<= 1) v = fmaxf(v, __shfl_xor(v, o));
    return v;
}
__device__ __forceinline__ float bflo(unsigned w) { return __uint_as_float(w << 16); }
__device__ __forceinline__ float bfhi(unsigned w) { return __uint_as_float(w & 0xffff0000u); }
__device__ __forceinline__ float bf2f(bf16 h) { return __uint_as_float(((unsigned)h) << 16); }
__device__ __forceinline__ float silu(float a) { return a * __builtin_amdgcn_rcpf(1.0f + __builtin_amdgcn_exp2f(-1.44269504089f * a)); }
__device__ __forceinline__ float logsigmoid(float z) { return fminf(z, 0.f) - __logf(1.0f + __expf(-fabsf(z))); }
__device__ __forceinline__ void unpack8(const v4u w, float (&f)[8]) { f[0] = bflo(w.x); f[1] = bfhi(w.x); f[2] = bflo(w.y); f[3] = bfhi(w.y); f[4] = bflo(w.z); f[5] = bfhi(w.z); f[6] = bflo(w.w); f[7] = bfhi(w.w); }
__device__ __forceinline__ v4u pack8(const float (&f)[8]) { v4u w; w.x = pk2(f[0], f[1]); w.y = pk2(f[2], f[3]); w.z = pk2(f[4], f[5]); w.w = pk2(f[6], f[7]); return w; }

__device__ __forceinline__ void p0_transpose_item(const float* W, int ldw, int src_col0, int nvalid, bf16* WT, int K, int dst_row0, int k0, int lane, unsigned* cm = nullptr) {
    const int ng = lane & 7, kg = lane >> 3;
    f32x4 x[8];
    const float* src = W + (size_t)(k0 + 8 * kg) * ldw + src_col0 + 4 * ng;
    if (4 * ng < nvalid) {
#pragma unroll
        for (int i = 0; i < 8; ++i) x[i] = __builtin_nontemporal_load((const f32x4*)(src + (size_t)i * ldw));
    } else {
#pragma unroll
        for (int i = 0; i < 8; ++i) x[i] = (f32x4){0.f, 0.f, 0.f, 0.f};
    }
    if (cm) { f32x4 m = (f32x4){0.f, 0.f, 0.f, 0.f};
#pragma unroll
        for (int i = 0; i < 8; ++i) { m.x = fmaxf(m.x, fabsf(x[i].x)); m.y = fmaxf(m.y, fabsf(x[i].y)); m.z = fmaxf(m.z, fabsf(x[i].z)); m.w = fmaxf(m.w, fabsf(x[i].w)); }
#pragma unroll
        for (int o = 8; o < 64; o <<= 1) { m.x = fmaxf(m.x, __shfl_xor(m.x, o)); m.y = fmaxf(m.y, __shfl_xor(m.y, o)); m.z = fmaxf(m.z, __shfl_xor(m.z, o)); m.w = fmaxf(m.w, __shfl_xor(m.w, o)); }
        if (kg == 0) { unsigned* c = cm + 4 * ng; __hip_atomic_fetch_max(c + 0, __float_as_uint(m.x), __ATOMIC_RELAXED, __HIP_MEMORY_SCOPE_AGENT); __hip_atomic_fetch_max(c + 1, __float_as_uint(m.y), __ATOMIC_RELAXED, __HIP_MEMORY_SCOPE_AGENT);
            __hip_atomic_fetch_max(c + 2, __float_as_uint(m.z), __ATOMIC_RELAXED, __HIP_MEMORY_SCOPE_AGENT); __hip_atomic_fetch_max(c + 3, __float_as_uint(m.w), __ATOMIC_RELAXED, __HIP_MEMORY_SCOPE_AGENT); } }
    bf16* dst = WT + (size_t)(dst_row0 + 4 * ng) * K + k0 + 8 * kg;
    { v4u o; o.x = pk2(x[0].x, x[1].x); o.y = pk2(x[2].x, x[3].x); o.z = pk2(x[4].x, x[5].x); o.w = pk2(x[6].x, x[7].x); *(GAS v4u*)(dst) = o; }
    { v4u o; o.x = pk2(x[0].y, x[1].y); o.y = pk2(x[2].y, x[3].y); o.z = pk2(x[4].y, x[5].y); o.w = pk2(x[6].y, x[7].y); *(GAS v4u*)(dst + (size_t)K) = o; }
    { v4u o; o.x = pk2(x[0].z, x[1].z); o.y = pk2(x[2].z, x[3].z); o.z = pk2(x[4].z, x[5].z); o.w = pk2(x[6].z, x[7].z); *(GAS v4u*)(dst + (size_t)2 * K) = o; }
    { v4u o; o.x = pk2(x[0].w, x[1].w); o.y = pk2(x[2].w, x[3].w); o.z = pk2(x[4].w, x[5].w); o.w = pk2(x[6].w, x[7].w); *(GAS v4u*)(dst + (size_t)3 * K) = o; }
}
template <bool OUT_F32>
__device__ __forceinline__ void ln_row(const float* src, const float* g, const float* b, void* dst, int lane) {
    const GAS f32x4* xr = (const GAS f32x4*)src + lane;
    f32x4 v[16]; float s = 0.f;
#pragma unroll
    for (int j = 0; j < 16; ++j) { v[j] = __builtin_nontemporal_load(xr + 64 * j); s += (v[j].x + v[j].y) + (v[j].z + v[j].w); }
    const float mean = wave_sum(s) * (1.f / D); float s2 = 0.f;
#pragma unroll
    for (int j = 0; j < 16; ++j) { v[j] = v[j] - mean; s2 += (v[j].x * v[j].x + v[j].y * v[j].y) + (v[j].z * v[j].z + v[j].w * v[j].w); }
    const float rstd = 1.f / sqrtf(wave_sum(s2) * (1.f / D) + LN_EPS);
    const GAS f32x4* gr = (const GAS f32x4*)g + lane; const GAS f32x4* br = (const GAS f32x4*)b + lane;
#pragma unroll
    for (int j = 0; j < 16; ++j) { const f32x4 o = v[j] * rstd * gr[64 * j] + br[64 * j];
        if (OUT_F32) ((GAS f32x4*)dst)[lane + 64 * j] = o;
        else { u32x2v w; w.x = pk2(o.x, o.y); w.y = pk2(o.z, o.w); ((GAS u32x2v*)dst)[lane + 64 * j] = w; } }
}
template <bool OUT_F32, int NSL>
__device__ __forceinline__ void ln_row_slab_block(Frame& F, const float* slab, int r, const bf16* res, const float* g, const float* b, void* dst, signed char* dq = nullptr, float* scale = nullptr) {
    LAS float* red = (LAS float*)(F.lds);
    const int t = F.tid; float v[8];
    unpack8(*(const v4u*)(res + 8 * t), v);
#pragma unroll
    for (int e = 0; e < 8; ++e) v[e] *= ALPHA;
#pragma unroll 4
    for (int s = 0; s < NSL; ++s) { const f32x4* p = (const f32x4*)(slab + ((size_t)s * 128 + r) * D + 8 * t); const f32x4 a = p[0], c = p[1];
        v[0] += a.x; v[1] += a.y; v[2] += a.z; v[3] += a.w; v[4] += c.x; v[5] += c.y; v[6] += c.z; v[7] += c.w; }
    float s1 = 0.f;
#pragma unroll
    for (int e = 0; e < 8; ++e) s1 += v[e];
    s1 = wave_sum(s1);
    __syncthreads();
    if (F.lane == 0) red[F.wave] = s1;
    __syncthreads();
    float tot = 0.f;
#pragma unroll
    for (int w = 0; w < 8; ++w) tot += red[w];
    const float mean = tot * (1.f / D); float s2 = 0.f;
#pragma unroll
    for (int e = 0; e < 8; ++e) { v[e] -= mean; s2 += v[e] * v[e]; }
    s2 = wave_sum(s2);
    if (F.lane == 0) red[8 + F.wave] = s2;
    __syncthreads();
    float tot2 = 0.f;
#pragma unroll
    for (int w = 0; w < 8; ++w) tot2 += red[8 + w];
    const float rstd = 1.f / sqrtf(tot2 * (1.f / D) + LN_EPS);
    const f32x4* gp = (const f32x4*)(g + 8 * t); const f32x4* bp = (const f32x4*)(b + 8 * t); const f32x4 g0 = gp[0], g1 = gp[1], b0 = bp[0], b1 = bp[1];
    float o[8]; o[0] = v[0] * rstd * g0.x + b0.x; o[1] = v[1] * rstd * g0.y + b0.y; o[2] = v[2] * rstd * g0.z + b0.z; o[3] = v[3] * rstd * g0.w + b0.w;
    o[4] = v[4] * rstd * g1.x + b1.x; o[5] = v[5] * rstd * g1.y + b1.y; o[6] = v[6] * rstd * g1.z + b1.z; o[7] = v[7] * rstd * g1.w + b1.w;
    if (OUT_F32) { f32x4* op = (f32x4*)((float*)dst + 8 * t); op[0] = (f32x4){o[0], o[1], o[2], o[3]}; op[1] = (f32x4){o[4], o[5], o[6], o[7]}; }
    else { *(v4u*)((bf16*)dst + 8 * t) = pack8(o);
        if (dq) {
            float mx = 0.f;
#pragma unroll
            for (int e = 0; e < 8; ++e) mx = fmaxf(mx, fabsf(o[e]));
            mx = wave_max(mx);
            __syncthreads();
            if (F.lane == 0) red[F.wave] = mx;
            __syncthreads();
            float tm = 0.f;
#pragma unroll
            for (int w = 0; w < 8; ++w) tm = fmaxf(tm, red[w]);
            const float inv = tm > 0.f ? 127.0f / tm : 0.f;
            if (t == 0) *scale = tm * (1.0f / 127.0f);
            u32x2v q; q.x = q4(o[0], o[1], o[2], o[3], inv); q.y = q4(o[4], o[5], o[6], o[7], inv); *(u32x2v*)(dq + 8 * t) = q; } }
}
constexpr int LDS_GB = 65536;
__device__ __forceinline__ void stage_gb(Frame& F, const float* g, const float* b) {
    LAS f32x4* Lg = (LAS f32x4*)(F.lds + LDS_GB); __syncthreads();
    for (int i = F.tid; i < D / 4; i += NWAVES * 64) { Lg[i] = ((const GAS f32x4*)(const GAS float*)g)[i]; Lg[D / 4 + i] = ((const GAS f32x4*)(const GAS float*)b)[i]; }
    __syncthreads(); }
template <bool OUT_F32>
__device__ __forceinline__ void ln_row_b16(const bf16* src, const LAS f32x4* Lg, void* dst, int lane) {
    const GAS v4u* xr = (const GAS v4u*)src + lane;
    float v[8][8]; float s = 0.f;
#pragma unroll
    for (int j = 0; j < 8; ++j) { unpack8(__builtin_nontemporal_load(xr + 64 * j), v[j]);
#pragma unroll
        for (int e = 0; e < 8; ++e) s += v[j][e]; }
    const float mean = wave_sum(s) * (1.f / D); float s2 = 0.f;
#pragma unroll
    for (int j = 0; j < 8; ++j)
#pragma unroll
        for (int e = 0; e < 8; ++e) { v[j][e] -= mean; s2 += v[j][e] * v[j][e]; }
    const float rstd = 1.f / sqrtf(wave_sum(s2) * (1.f / D) + LN_EPS);
#pragma unroll
    for (int j = 0; j < 8; ++j) { const int c0 = 8 * (lane + 64 * j); const LAS f32x4* gp = Lg + c0 / 4; const f32x4 g0 = gp[0], g1 = gp[1], b0 = gp[D / 4], b1 = gp[D / 4 + 1];
        float o[8]; o[0] = v[j][0] * rstd * g0.x + b0.x; o[1] = v[j][1] * rstd * g0.y + b0.y; o[2] = v[j][2] * rstd * g0.z + b0.z; o[3] = v[j][3] * rstd * g0.w + b0.w;
        o[4] = v[j][4] * rstd * g1.x + b1.x; o[5] = v[j][5] * rstd * g1.y + b1.y; o[6] = v[j][6] * rstd * g1.z + b1.z; o[7] = v[j][7] * rstd * g1.w + b1.w;
        if (OUT_F32) { GAS f32x4* op = (GAS f32x4*)((float*)dst + c0); op[0] = (f32x4){o[0], o[1], o[2], o[3]}; op[1] = (f32x4){o[4], o[5], o[6], o[7]}; }
        else *(GAS v4u*)((bf16*)dst + c0) = pack8(o); }
}
constexpr int NB_IN = NBF / 32 - 7, NB_ALL = NB_IN + NI8X / 32, I_IN = 64 * NB_IN, NB_OUT = 128, I_OUT = 64 * NB_OUT, NB_GU = NGU / 32, I_GU = 64 * NB_GU, NB_DN = 128, I_DN = (DFF / 64) * NB_DN;
__device__ __forceinline__ void ln0_row_quant(const float* src, const LAS f32x4* Lg, bf16* dst, signed char* dq, float* scale, int lane) {
    const GAS f32x4* xr = (const GAS f32x4*)src + lane;
    f32x4 v[16]; float s = 0.f;
#pragma unroll
    for (int j = 0; j < 16; ++j) { v[j] = __builtin_nontemporal_load(xr + 64 * j); s += (v[j].x + v[j].y) + (v[j].z + v[j].w); }
    const float mean = wave_sum(s) * (1.f / D); float s2 = 0.f;
#pragma unroll
    for (int j = 0; j < 16; ++j) { v[j] = v[j] - mean; s2 += (v[j].x * v[j].x + v[j].y * v[j].y) + (v[j].z * v[j].z + v[j].w * v[j].w); }
    const float rstd = 1.f / sqrtf(wave_sum(s2) * (1.f / D) + LN_EPS); float mx = 0.f;
    const LAS f32x4* gr = Lg + lane; const LAS f32x4* br = Lg + D / 4 + lane;
#pragma unroll
    for (int j = 0; j < 16; ++j) { v[j] = v[j] * rstd * gr[64 * j] + br[64 * j]; mx = fmaxf(mx, fmaxf(fmaxf(fabsf(v[j].x), fabsf(v[j].y)), fmaxf(fabsf(v[j].z), fabsf(v[j].w))));
        u32x2v w; w.x = pk2(v[j].x, v[j].y); w.y = pk2(v[j].z, v[j].w); ((GAS u32x2v*)dst)[lane + 64 * j] = w; }
    mx = wave_max(mx); const float inv = mx > 0.f ? 127.0f / mx : 0.f;
    if (lane == 0) *scale = mx * (1.0f / 127.0f);
#pragma unroll
    for (int j = 0; j < 16; ++j) ((GAS unsigned*)dq)[lane + 64 * j] = q4(v[j].x, v[j].y, v[j].z, v[j].w, inv);
}
__device__ __forceinline__ int src_col_i8(int lc) { return lc < 1024 ? lc : (lc < 3072 ? lc + 3072 : lc + 3088); }
constexpr int CI_ITEMS_X = (NI8X / 256) * (D / 64), CI_ITEMS = (NI8 / 256) * (D / 64), QI_NB = NI8 / 32, QI_ITEMS = QI_NB * (D / 128);
__device__ __forceinline__ void p0_prologue(Frame& F) {
    const int gw = F.vcu * NWAVES + F.wave, NGW = F.G * NWAVES;
    const float* w_in = F.in<A_WIN>();
    for (int r = gw; r < 64 * NB_ALL; r += NGW) { const int kb = r / NB_ALL, nb = r % NB_ALL, n0 = nb < NB_IN ? 32 * nb : NBF + 32 * (nb - NB_IN);
        int src = n0 < C_CC ? n0 + 1024 : (n0 < C_AL ? n0 + 5136 : src_col_i8(n0 - NBF)), nv = 32; if (nb == NB_IN - 1) { src = 6144; nv = 16; }
        unsigned* cm = n0 >= NBF ? (unsigned*)F.cmin() + (n0 - NBF) : ((n0 >= C_CC && n0 < C_AL) ? (unsigned*)F.cmin() + NI8X + (n0 - C_CC) : nullptr);
        p0_transpose_item(w_in, 12304, src, nv, F.Wt_in(), D, n0, 64 * kb, F.lane, cm); }
    const float *x_prompt = F.in<A_XP>(), *x_sample = F.in<A_XS>(), *meta = F.in<A_META>(), *emb_g = F.in<A_EMBG>(), *emb_b = F.in<A_EMBB>();
    stage_gb(F, emb_g, emb_b);
    for (int m = gw; m < MROWS + 2 * NBATCH; m += NGW) {
        const float* src = m < ROW_S ? x_prompt + (size_t)m * D : (m < ROW_META ? x_sample + (size_t)(m - ROW_S) * D : (m < MROWS ? meta + (size_t)(m - ROW_META) * D : x_prompt + (size_t)(((m - MROWS) >> 1) * SEQ + SEQ - 2 + ((m - MROWS) & 1)) * D));
        ln0_row_quant(src, (const LAS f32x4*)(F.lds + LDS_GB), F.h0() + (size_t)m * D, F.h0q() + (size_t)m * D, F.rs0() + m, F.lane);
    }
}
__device__ __forceinline__ void quant_in_pass(Frame& F, int gw, int ngw) {
    const float* cm = F.cmin(); signed char* Wq = F.Wq_in(); const bf16* Wt = F.Wt_in(); const int lane = F.lane;
    for (int p = gw; p < NI8 / 2; p += ngw) { v4u x[2][8]; float inv[2];
#pragma unroll
        for (int rr = 0; rr < 2; ++rr) { const int lc = 2 * p + rr, srow = lc < NI8X ? NBF + lc : C_CC + (lc - NI8X); const GAS v4u* sp = (const GAS v4u*)(const GAS bf16*)(Wt + (size_t)srow * D) + lane;
#pragma unroll
            for (int j = 0; j < 8; ++j) x[rr][j] = __builtin_nontemporal_load(sp + 64 * j);
            const float c = cm[lc]; inv[rr] = c > 0.f ? 127.0f / c : 0.f; }
#pragma unroll
        for (int rr = 0; rr < 2; ++rr) { GAS u32x2v* dp = (GAS u32x2v*)(GAS signed char*)(Wq + (size_t)(2 * p + rr) * D) + lane;
#pragma unroll
            for (int j = 0; j < 8; ++j) { float f[8]; unpack8(x[rr][j], f); u32x2v q; q.x = q4(f[0], f[1], f[2], f[3], inv[rr]); q.y = q4(f[4], f[5], f[6], f[7], inv[rr]); dp[64 * j] = q; } } }
}
struct CvItem { const float* src; bf16* dst; int ldw, K; };
__device__ __forceinline__ CvItem cv_decode(Frame& F, int it, const float* w_out, const float* w_gate, const float* w_up, const float* w_down, int lane) {
    const int ng = lane & 7, kg = lane >> 3; CvItem c; int r = it;
    if (r < I_OUT) { const int kb = r / NB_OUT, nb = r % NB_OUT; c.ldw = D; c.K = D; c.src = w_out + (size_t)(64 * kb + 8 * kg) * D + 32 * nb + 4 * ng; c.dst = F.Wt_out() + (size_t)(32 * nb + 4 * ng) * D + 64 * kb + 8 * kg; return c; } r -= I_OUT;
    if (r < I_GU) { const int kb = r / NB_GU, nb = r % NB_GU, n0 = 32 * nb, pn = n0 >> 8, cc = n0 & 255; c.ldw = DFF; c.K = D;
        c.src = (cc < 128 ? w_gate : w_up) + (size_t)(64 * kb + 8 * kg) * DFF + 128 * pn + (cc & 127) + 4 * ng; c.dst = F.Wt_gu() + (size_t)(n0 + 4 * ng) * D + 64 * kb + 8 * kg; return c; } r -= I_GU;
    { const int kb = r / NB_DN, nb = r % NB_DN; c.ldw = D; c.K = DFF; c.src = w_down + (size_t)(64 * kb + 8 * kg) * D + 32 * nb + 4 * ng; c.dst = F.Wt_dn() + (size_t)(32 * nb + 4 * ng) * DFF + 64 * kb + 8 * kg; return c; }
}
__device__ __forceinline__ void cv_store(const CvItem& c, const f32x4 (&x)[8]) {
    { v4u o; o.x = pk2(x[0].x, x[1].x); o.y = pk2(x[2].x, x[3].x); o.z = pk2(x[4].x, x[5].x); o.w = pk2(x[6].x, x[7].x); __builtin_nontemporal_store(o, (GAS v4u*)(c.dst)); }
    { v4u o; o.x = pk2(x[0].y, x[1].y); o.y = pk2(x[2].y, x[3].y); o.z = pk2(x[4].y, x[5].y); o.w = pk2(x[6].y, x[7].y); __builtin_nontemporal_store(o, (GAS v4u*)(c.dst + (size_t)c.K)); }
    { v4u o; o.x = pk2(x[0].z, x[1].z); o.y = pk2(x[2].z, x[3].z); o.z = pk2(x[4].z, x[5].z); o.w = pk2(x[6].z, x[7].z); __builtin_nontemporal_store(o, (GAS v4u*)(c.dst + (size_t)2 * c.K)); }
    { v4u o; o.x = pk2(x[0].w, x[1].w); o.y = pk2(x[2].w, x[3].w); o.z = pk2(x[4].w, x[5].w); o.w = pk2(x[6].w, x[7].w); __builtin_nontemporal_store(o, (GAS v4u*)(c.dst + (size_t)3 * c.K)); }
}
__device__ __forceinline__ void convert_rest(Frame& F, int gw, int ngw, int it_lo, int it_hi) {
    const float *w_out = F.in<A_WOUT>(), *w_gate = F.in<A_WGATE>(), *w_up = F.in<A_WUP>(), *w_down = F.in<A_WDOWN>();
    const int NIT = it_hi;
    for (int it = it_lo + gw; it < NIT; it += 2 * ngw) {
        const CvItem a = cv_decode(F, it, w_out, w_gate, w_up, w_down, F.lane); const bool two = it + ngw < NIT;
        const CvItem b = cv_decode(F, two ? it + ngw : it, w_out, w_gate, w_up, w_down, F.lane);
        f32x4 xa[8], xb[8];
#pragma unroll
        for (int i = 0; i < 8; ++i) xa[i] = __builtin_nontemporal_load((const f32x4*)(a.src + (size_t)i * a.ldw));
#pragma unroll
        for (int i = 0; i < 8; ++i) xb[i] = __builtin_nontemporal_load((const f32x4*)(b.src + (size_t)i * b.ldw));
        cv_store(a, xa);
        if (two) cv_store(b, xb);
    }
}

constexpr int CM_STRIPS = DFF / 256, CM_KR = D / 64, CM_ITEMS = 2 * CM_STRIPS * CM_KR;
__device__ __forceinline__ void colmax_pass(Frame& F, int gw, int ngw) {
    const float *w_gate = F.in<A_WGATE>(), *w_up = F.in<A_WUP>(); unsigned* cm = (unsigned*)F.cmax();
    for (int it = gw; it < CM_ITEMS; it += ngw) { const int kr = it % CM_KR, sm = it / CM_KR, strip = sm % CM_STRIPS, mat = sm / CM_STRIPS, c0 = 256 * strip + 4 * F.lane;
        const float* src = (mat ? w_up : w_gate) + (size_t)(64 * kr) * DFF + c0; f32x4 m = (f32x4){0.f, 0.f, 0.f, 0.f};
#pragma unroll
        for (int b = 0; b < 4; ++b) { f32x4 x[16];
#pragma unroll
            for (int i = 0; i < 16; ++i) x[i] = *(const f32x4*)(src + (size_t)(16 * b + i) * DFF);
#pragma unroll
            for (int i = 0; i < 16; ++i) { m.x = fmaxf(m.x, fabsf(x[i].x)); m.y = fmaxf(m.y, fabsf(x[i].y)); m.z = fmaxf(m.z, fabsf(x[i].z)); m.w = fmaxf(m.w, fabsf(x[i].w)); } }
        const int gc = 256 * (c0 >> 7) + (mat ? 128 : 0) + (c0 & 127);
        __hip_atomic_fetch_max(cm + gc + 0, __float_as_uint(m.x), __ATOMIC_RELAXED, __HIP_MEMORY_SCOPE_AGENT); __hip_atomic_fetch_max(cm + gc + 1, __float_as_uint(m.y), __ATOMIC_RELAXED, __HIP_MEMORY_SCOPE_AGENT);
        __hip_atomic_fetch_max(cm + gc + 2, __float_as_uint(m.z), __ATOMIC_RELAXED, __HIP_MEMORY_SCOPE_AGENT); __hip_atomic_fetch_max(cm + gc + 3, __float_as_uint(m.w), __ATOMIC_RELAXED, __HIP_MEMORY_SCOPE_AGENT); }
}
constexpr int WQ_NB = NGU / 32, WQ_KB = D / 128, WQ_ITEMS = WQ_NB * WQ_KB;
__device__ __forceinline__ void quant_gu_pass(Frame& F, int gw, int ngw) {
    const float *w_gate = F.in<A_WGATE>(), *w_up = F.in<A_WUP>(); const float* cm = F.cmax(); signed char* Wq = (signed char*)F.Wt_gu();
    const int ng = F.lane & 7, kg = F.lane >> 3;
    for (int it = gw; it < WQ_ITEMS; it += ngw) { const int kb = it / WQ_NB, nb = it % WQ_NB, n0 = 32 * nb, pn = n0 >> 8, cc = n0 & 255, k0 = 128 * kb;
        const float* src = (cc < 128 ? w_gate : w_up) + (size_t)(k0 + 16 * kg) * DFF + 128 * pn + (cc & 127) + 4 * ng;
        f32x4 x[16];
#pragma unroll
        for (int i = 0; i < 16; ++i) x[i] = __builtin_nontemporal_load((const f32x4*)(src + (size_t)i * DFF));
        const f32x4 c4 = *(const f32x4*)(cm + n0 + 4 * ng);
        const float i0 = c4.x > 0.f ? 127.0f / c4.x : 0.f, i1 = c4.y > 0.f ? 127.0f / c4.y : 0.f, i2 = c4.z > 0.f ? 127.0f / c4.z : 0.f, i3 = c4.w > 0.f ? 127.0f / c4.w : 0.f;
        signed char* dst = Wq + (size_t)(n0 + 4 * ng) * D + k0 + 16 * kg;
        { v4u o; o.x = q4(x[0].x, x[1].x, x[2].x, x[3].x, i0); o.y = q4(x[4].x, x[5].x, x[6].x, x[7].x, i0); o.z = q4(x[8].x, x[9].x, x[10].x, x[11].x, i0); o.w = q4(x[12].x, x[13].x, x[14].x, x[15].x, i0); *(GAS v4u*)(dst) = o; }
        { v4u o; o.x = q4(x[0].y, x[1].y, x[2].y, x[3].y, i1); o.y = q4(x[4].y, x[5].y, x[6].y, x[7].y, i1); o.z = q4(x[8].y, x[9].y, x[10].y, x[11].y, i1); o.w = q4(x[12].y, x[13].y, x[14].y, x[15].y, i1); *(GAS v4u*)(dst + (size_t)D) = o; }
        { v4u o; o.x = q4(x[0].z, x[1].z, x[2].z, x[3].z, i2); o.y = q4(x[4].z, x[5].z, x[6].z, x[7].z, i2); o.z = q4(x[8].z, x[9].z, x[10].z, x[11].z, i2); o.w = q4(x[12].z, x[13].z, x[14].z, x[15].z, i2); *(GAS v4u*)(dst + (size_t)2 * D) = o; }
        { v4u o; o.x = q4(x[0].w, x[1].w, x[2].w, x[3].w, i3); o.y = q4(x[4].w, x[5].w, x[6].w, x[7].w, i3); o.z = q4(x[8].w, x[9].w, x[10].w, x[11].w, i3); o.w = q4(x[12].w, x[13].w, x[14].w, x[15].w, i3); *(GAS v4u*)(dst + (size_t)3 * D) = o; } }
}
constexpr int CD_STRIPS = D / 256, CD_KR = DFF / 64, CD_ITEMS = CD_STRIPS * CD_KR;
__device__ __forceinline__ void colmax_dn_pass(Frame& F, int gw, int ngw) {
    const float* w_down = F.in<A_WDOWN>(); unsigned* cm = (unsigned*)F.cmdn();
    for (int it = gw; it < CD_ITEMS; it += ngw) { const int kr = it % CD_KR, strip = it / CD_KR, c0 = 256 * strip + 4 * F.lane;
        const float* src = w_down + (size_t)(64 * kr) * D + c0; f32x4 m = (f32x4){0.f, 0.f, 0.f, 0.f};
#pragma unroll
        for (int b = 0; b < 4; ++b) { f32x4 x[16];
#pragma unroll
            for (int i = 0; i < 16; ++i) x[i] = *(const f32x4*)(src + (size_t)(16 * b + i) * D);
#pragma unroll
            for (int i = 0; i < 16; ++i) { m.x = fmaxf(m.x, fabsf(x[i].x)); m.y = fmaxf(m.y, fabsf(x[i].y)); m.z = fmaxf(m.z, fabsf(x[i].z)); m.w = fmaxf(m.w, fabsf(x[i].w)); } }
        __hip_atomic_fetch_max(cm + c0 + 0, __float_as_uint(m.x), __ATOMIC_RELAXED, __HIP_MEMORY_SCOPE_AGENT); __hip_atomic_fetch_max(cm + c0 + 1, __float_as_uint(m.y), __ATOMIC_RELAXED, __HIP_MEMORY_SCOPE_AGENT);
        __hip_atomic_fetch_max(cm + c0 + 2, __float_as_uint(m.z), __ATOMIC_RELAXED, __HIP_MEMORY_SCOPE_AGENT); __hip_atomic_fetch_max(cm + c0 + 3, __float_as_uint(m.w), __ATOMIC_RELAXED, __HIP_MEMORY_SCOPE_AGENT); }
}
constexpr int WD_NB = D / 32, WD_KB = DFF / 128, WD_ITEMS = WD_NB * WD_KB;
__device__ __forceinline__ void quant_dn_pass(Frame& F, int gw, int ngw) {
    const float* w_down = F.in<A_WDOWN>(); const float* cm = F.cmdn(); signed char* Wq = (signed char*)F.Wt_dn();
    const int ng = F.lane & 7, kg = F.lane >> 3;
    for (int it = gw; it < WD_ITEMS; it += ngw) { const int kb = it / WD_NB, nb = it % WD_NB, n0 = 32 * nb, k0 = 128 * kb;
        const float* src = w_down + (size_t)(k0 + 16 * kg) * D + n0 + 4 * ng;
        f32x4 x[16];
#pragma unroll
        for (int i = 0; i < 16; ++i) x[i] = __builtin_nontemporal_load((const f32x4*)(src + (size_t)i * D));
        const f32x4 c4 = *(const f32x4*)(cm + n0 + 4 * ng);
        const float i0 = c4.x > 0.f ? 127.0f / c4.x : 0.f, i1 = c4.y > 0.f ? 127.0f / c4.y : 0.f, i2 = c4.z > 0.f ? 127.0f / c4.z : 0.f, i3 = c4.w > 0.f ? 127.0f / c4.w : 0.f;
        signed char* dst = Wq + (size_t)(n0 + 4 * ng) * DFF + k0 + 16 * kg;
        { v4u o; o.x = q4(x[0].x, x[1].x, x[2].x, x[3].x, i0); o.y = q4(x[4].x, x[5].x, x[6].x, x[7].x, i0); o.z = q4(x[8].x, x[9].x, x[10].x, x[11].x, i0); o.w = q4(x[12].x, x[13].x, x[14].x, x[15].x, i0); *(GAS v4u*)(dst) = o; }
        { v4u o; o.x = q4(x[0].y, x[1].y, x[2].y, x[3].y, i1); o.y = q4(x[4].y, x[5].y, x[6].y, x[7].y, i1); o.z = q4(x[8].y, x[9].y, x[10].y, x[11].y, i1); o.w = q4(x[12].y, x[13].y, x[14].y, x[15].y, i1); *(GAS v4u*)(dst + (size_t)DFF) = o; }
        { v4u o; o.x = q4(x[0].z, x[1].z, x[2].z, x[3].z, i2); o.y = q4(x[4].z, x[5].z, x[6].z, x[7].z, i2); o.z = q4(x[8].z, x[9].z, x[10].z, x[11].z, i2); o.w = q4(x[12].z, x[13].z, x[14].z, x[15].z, i2); *(GAS v4u*)(dst + (size_t)2 * DFF) = o; }
        { v4u o; o.x = q4(x[0].w, x[1].w, x[2].w, x[3].w, i3); o.y = q4(x[4].w, x[5].w, x[6].w, x[7].w, i3); o.z = q4(x[8].w, x[9].w, x[10].w, x[11].w, i3); o.w = q4(x[12].w, x[13].w, x[14].w, x[15].w, i3); *(GAS v4u*)(dst + (size_t)3 * DFF) = o; } }
}
__device__ __forceinline__ void act_row_quant(Frame& F, int row, int lane) {
    const GAS v4u* src = (const GAS v4u*)(F.act() + (size_t)row * DFF) + lane; GAS u32x2v* dst = (GAS u32x2v*)(F.actq() + (size_t)row * DFF) + lane;
    v4u x[22]; float mx = 0.f;
#pragma unroll
    for (int i = 0; i < 21; ++i) x[i] = __builtin_nontemporal_load(src + 64 * i);
    x[21] = (lane + 64 * 21 < DFF / 8) ? __builtin_nontemporal_load(src + 64 * 21) : (v4u){0u, 0u, 0u, 0u};
#pragma unroll
    for (int i = 0; i < 22; ++i) { mx = fmaxf(mx, fmaxf(fmaxf(fabsf(bflo(x[i].x)), fabsf(bfhi(x[i].x))), fmaxf(fabsf(bflo(x[i].y)), fabsf(bfhi(x[i].y)))));
        mx = fmaxf(mx, fmaxf(fmaxf(fabsf(bflo(x[i].z)), fabsf(bfhi(x[i].z))), fmaxf(fabsf(bflo(x[i].w)), fabsf(bfhi(x[i].w))))); }
    mx = wave_max(mx); const float inv = mx > 0.f ? 127.0f / mx : 0.f;
    if (lane == 0) F.amax()[row] = mx;
#pragma unroll
    for (int i = 0; i < 22; ++i) if (lane + 64 * i < DFF / 8) { u32x2v q; q.x = q4(bflo(x[i].x), bfhi(x[i].x), bflo(x[i].y), bfhi(x[i].y), inv); q.y = q4(bflo(x[i].z), bfhi(x[i].z), bflo(x[i].w), bfhi(x[i].w), inv); dst[64 * i] = q; }
}
__device__ __forceinline__ void ln1_row_quant(const bf16* src, const LAS f32x4* Lg, bf16* dst, signed char* dq, float* scale, int lane) {
    const GAS v4u* xr = (const GAS v4u*)src + lane;
    float v[8][8]; float s = 0.f;
#pragma unroll
    for (int j = 0; j < 8; ++j) { unpack8(__builtin_nontemporal_load(xr + 64 * j), v[j]);
#pragma unroll
        for (int e = 0; e < 8; ++e) s += v[j][e]; }
    const float mean = wave_sum(s) * (1.f / D); float s2 = 0.f;
#pragma unroll
    for (int j = 0; j < 8; ++j)
#pragma unroll
        for (int e = 0; e < 8; ++e) { v[j][e] -= mean; s2 += v[j][e] * v[j][e]; }
    const float rstd = 1.f / sqrtf(wave_sum(s2) * (1.f / D) + LN_EPS); float mx = 0.f;
#pragma unroll
    for (int j = 0; j < 8; ++j) { const int c0 = 8 * (lane + 64 * j); const LAS f32x4* gp = Lg + c0 / 4; const f32x4 g0 = gp[0], g1 = gp[1], b0 = gp[D / 4], b1 = gp[D / 4 + 1];
        v[j][0] = v[j][0] * rstd * g0.x + b0.x; v[j][1] = v[j][1] * rstd * g0.y + b0.y; v[j][2] = v[j][2] * rstd * g0.z + b0.z; v[j][3] = v[j][3] * rstd * g0.w + b0.w;
        v[j][4] = v[j][4] * rstd * g1.x + b1.x; v[j][5] = v[j][5] * rstd * g1.y + b1.y; v[j][6] = v[j][6] * rstd * g1.z + b1.z; v[j][7] = v[j][7] * rstd * g1.w + b1.w;
#pragma unroll
        for (int e = 0; e < 8; ++e) mx = fmaxf(mx, fabsf(v[j][e]));
        __builtin_nontemporal_store(pack8(v[j]), (GAS v4u*)(dst + c0)); }
    mx = wave_max(mx); const float inv = mx > 0.f ? 127.0f / mx : 0.f;
    if (lane == 0) *scale = mx * (1.0f / 127.0f);
#pragma unroll
    for (int j = 0; j < 8; ++j) { u32x2v q; q.x = q4(v[j][0], v[j][1], v[j][2], v[j][3], inv); q.y = q4(v[j][4], v[j][5], v[j][6], v[j][7], inv); *(GAS u32x2v*)(dq + 8 * (lane + 64 * j)) = q; }
}

__device__ __forceinline__ void gla_sample_item(Frame& F, int it, const float* w_a2, const float* b_a, const float* state_gla, float* out) {
    const int n = it >> 2, h = it & 3, row = ROW_S + n, t = F.tid;
    LAS float* Aa = (LAS float*)(F.lds); LAS float* Kk = Aa + 256; LAS float* Qq = Aa + 512; LAS float* Ored = Aa + 768;
    const bf16* prow = F.proj() + (size_t)row * NIN;
    __syncthreads();
    if (t < 256) { const int d = t; float z = b_a[h * DK + d];
#pragma unroll
        for (int r = 0; r < 16; ++r) z += bf2f(prow[C_AL + r]) * w_a2[r * DGK + h * DK + d];
        Aa[d] = __expf(logsigmoid(z) * 0.0625f); Kk[d] = bf2f(prow[C_K + h * DK + d]); Qq[d] = bf2f(prow[C_Q + h * DK + d]) * 0.0625f; }
    __syncthreads();
    const int cg = t & 127, rg = t >> 7;
    const u32x2v vw = *(const u32x2v*)(prow + C_V + h * DV + 4 * cg);
    const f32x4 v4 = (f32x4){bflo(vw.x), bfhi(vw.x), bflo(vw.y), bfhi(vw.y)};
    const f32x4* S0 = (const f32x4*)(state_gla + (size_t)(n * NH + h) * DK * DV) + cg;
    f32x4* S1 = (f32x4*)(out + O_GS + (size_t)(n * NH + h) * DK * DV) + cg;
    f32x4 o4 = (f32x4){0.f, 0.f, 0.f, 0.f};
    for (int i0 = 0; i0 < 64; i0 += 16) {
        f32x4 s[16];
#pragma unroll
        for (int k = 0; k < 16; ++k) s[k] = __builtin_nontemporal_load(S0 + (size_t)(rg * 64 + i0 + k) * 128);
#pragma unroll
        for (int k = 0; k < 16; ++k) { const int d = rg * 64 + i0 + k; s[k] = s[k] * Aa[d] + v4 * Kk[d]; __builtin_nontemporal_store(s[k], S1 + (size_t)d * 128); o4 += s[k] * Qq[d]; }
    }
    *(LAS f32x4*)(Ored + rg * 512 + 4 * cg) = o4;
    __syncthreads();
    { const float o = (Ored[t] + Ored[512 + t]) + (Ored[1024 + t] + Ored[1536 + t]); F.obuf()[(size_t)row * DGV + h * DV + t] = (bf16)f2bf(o); }
    __syncthreads();
}
__device__ __forceinline__ void conv_row(Frame& F, int row, int lane, const float* state_conv, const float* conv_w, float* out) {
    const bool samp = row >= ROW_S; const int tq = row & (SEQ - 1), b = row >> 11, n = row - ROW_S;
    const int r1 = tq >= 1 ? row - 1 : ROW_META + 15, r2 = tq >= 2 ? row - 2 : ROW_META + 14 + tq;
    const bf16* p0 = F.proj() + (size_t)row * NIN; const bf16* p1 = F.proj() + (size_t)r1 * NIN; const bf16* p2 = F.proj() + (size_t)r2 * NIN;
#pragma unroll
    for (int jp = 0; jp < 2; ++jp) {
        v4u vcb[2], vcc[2], vch[2], vc1[2], vh1[2], vc2[2], vh2[2]; f32x4 s1[2][2], s0[2][2], wq[2][3][2];
#pragma unroll
        for (int jj = 0; jj < 2; ++jj) { const int c0 = 512 * (2 * jp + jj) + 8 * lane;
            vcb[jj] = *(const v4u*)(p0 + C_CB + c0); vcc[jj] = *(const v4u*)(p0 + C_CC + c0); vch[jj] = *(const v4u*)(p0 + C_CH + c0);
            if (!samp) { vc1[jj] = *(const v4u*)(p1 + C_CC + c0); vh1[jj] = *(const v4u*)(p1 + C_CH + c0); vc2[jj] = *(const v4u*)(p2 + C_CC + c0); vh2[jj] = *(const v4u*)(p2 + C_CH + c0); }
            else { const f32x4* q1 = (const f32x4*)(state_conv + (size_t)(n * 2 + 1) * DCONV + c0); const f32x4* q0 = (const f32x4*)(state_conv + (size_t)(n * 2 + 0) * DCONV + c0);
                s1[jj][0] = q1[0]; s1[jj][1] = q1[1]; s0[jj][0] = q0[0]; s0[jj][1] = q0[1]; }
#pragma unroll
            for (int k = 0; k < 3; ++k) { const f32x4* q = (const f32x4*)(conv_w + k * DCONV + c0); wq[jj][k][0] = q[0]; wq[jj][k][1] = q[1]; } }
#pragma unroll
        for (int jj = 0; jj < 2; ++jj) { const int c0 = 512 * (2 * jp + jj) + 8 * lane;
            float cb[8], cc[8], ch[8], ut[8], u1[8], u2[8], y[8];
            unpack8(vcb[jj], cb); unpack8(vcc[jj], cc); unpack8(vch[jj], ch);
#pragma unroll
            for (int e = 0; e < 8; ++e) ut[e] = cc[e] * ch[e];
            if (!samp) { unpack8(vc1[jj], cc); unpack8(vh1[jj], ch);
#pragma unroll
                for (int e = 0; e < 8; ++e) u1[e] = cc[e] * ch[e];
                unpack8(vc2[jj], cc); unpack8(vh2[jj], ch);
#pragma unroll
                for (int e = 0; e < 8; ++e) u2[e] = cc[e] * ch[e]; }
            else { const f32x4 a0 = s1[jj][0], a1 = s1[jj][1], b0 = s0[jj][0], b1 = s0[jj][1];
                u1[0] = a0.x; u1[1] = a0.y; u1[2] = a0.z; u1[3] = a0.w; u1[4] = a1.x; u1[5] = a1.y; u1[6] = a1.z; u1[7] = a1.w;
                u2[0] = b0.x; u2[1] = b0.y; u2[2] = b0.z; u2[3] = b0.w; u2[4] = b1.x; u2[5] = b1.y; u2[6] = b1.z; u2[7] = b1.w; }
            const float w0[8] = {wq[jj][0][0].x, wq[jj][0][0].y, wq[jj][0][0].z, wq[jj][0][0].w, wq[jj][0][1].x, wq[jj][0][1].y, wq[jj][0][1].z, wq[jj][0][1].w};
            const float w1[8] = {wq[jj][1][0].x, wq[jj][1][0].y, wq[jj][1][0].z, wq[jj][1][0].w, wq[jj][1][1].x, wq[jj][1][1].y, wq[jj][1][1].z, wq[jj][1][1].w};
            const float w2[8] = {wq[jj][2][0].x, wq[jj][2][0].y, wq[jj][2][0].z, wq[jj][2][0].w, wq[jj][2][1].x, wq[jj][2][1].y, wq[jj][2][1].z, wq[jj][2][1].w};
#pragma unroll
            for (int e = 0; e < 8; ++e) y[e] = cb[e] * (w0[e] * u2[e] + w1[e] * u1[e] + w2[e] * ut[e]);
            *(v4u*)(F.mix() + (size_t)row * D + DGV + c0) = pack8(y);
            if (!samp) { if (tq >= SEQ - 2) { f32x4* o = (f32x4*)(out + O_CP + (size_t)(b * 2 + (tq - (SEQ - 2))) * DCONV + c0); o[0] = (f32x4){ut[0], ut[1], ut[2], ut[3]}; o[1] = (f32x4){ut[4], ut[5], ut[6], ut[7]}; } }
            else { f32x4* o = (f32x4*)(out + O_CS + (size_t)(n * 2) * DCONV + c0); o[0] = (f32x4){u1[0], u1[1], u1[2], u1[3]}; o[1] = (f32x4){u1[4], u1[5], u1[6], u1[7]};
                f32x4* o2 = (f32x4*)(out + O_CS + (size_t)(n * 2 + 1) * DCONV + c0); o2[0] = (f32x4){ut[0], ut[1], ut[2], ut[3]}; o2[1] = (f32x4){ut[4], ut[5], ut[6], ut[7]}; } }
    }
}
typedef float f32x16 __attribute__((ext_vector_type(16)));
constexpr int NCH = 33, NBH = NBATCH * NH;
constexpr size_t GS_QF = 0, GS_KF = GS_QF + (size_t)NBH * NCH * 32768, GS_AF = GS_KF + (size_t)NBH * NCH * 32768, GS_VF = GS_AF + (size_t)NBH * NCH * 8192,
                 GS_EL = GS_VF + (size_t)NBH * NCH * 65536, GS_END = GS_EL + (size_t)NBH * NCH * 1024;
static_assert(GS_END <= 132 * MiB, "GLA scratch aliases the R region");
constexpr int L_QS = 0, L_KS = 33792, L_KKT = 67584, L_AT = 101376, L_AL = 110592, L_BT = 114688;
__device__ __forceinline__ int crow32(int i, int h) { return (i & 3) + 8 * (i >> 2) + 4 * h; }

__device__ __forceinline__ void conv_rows4(Frame& F, int row0, int lane, const float* conv_w, float* out) {
    const int tq0 = row0 & (SEQ - 1), b = row0 >> 11;
    const bf16* pm2 = F.proj() + (size_t)(tq0 ? row0 - 2 : ROW_META + 14) * NIN; const bf16* pm1 = F.proj() + (size_t)(tq0 ? row0 - 1 : ROW_META + 15) * NIN; const bf16* p0 = F.proj() + (size_t)row0 * NIN;
#pragma unroll 1
    for (int g = 0; g < 4; ++g) { const int c0 = 512 * g + 8 * lane;
        v4u vcc[6], vch[6], vcb[4]; f32x4 wq[3][2];
        vcc[0] = __builtin_nontemporal_load((const v4u*)(pm2 + C_CC + c0)); vch[0] = __builtin_nontemporal_load((const v4u*)(pm2 + C_CH + c0)); vcc[1] = __builtin_nontemporal_load((const v4u*)(pm1 + C_CC + c0)); vch[1] = __builtin_nontemporal_load((const v4u*)(pm1 + C_CH + c0));
#pragma unroll
        for (int i = 0; i < 4; ++i) { vcc[2 + i] = __builtin_nontemporal_load((const v4u*)(p0 + (size_t)i * NIN + C_CC + c0)); vch[2 + i] = __builtin_nontemporal_load((const v4u*)(p0 + (size_t)i * NIN + C_CH + c0)); vcb[i] = __builtin_nontemporal_load((const v4u*)(p0 + (size_t)i * NIN + C_CB + c0)); }
#pragma unroll
        for (int k = 0; k < 3; ++k) { const f32x4* q = (const f32x4*)(conv_w + k * DCONV + c0); wq[k][0] = q[0]; wq[k][1] = q[1]; }
        float u[6][8];
#pragma unroll
        for (int j = 0; j < 6; ++j) { float cc[8], ch[8]; unpack8(vcc[j], cc); unpack8(vch[j], ch);
#pragma unroll
            for (int e = 0; e < 8; ++e) u[j][e] = cc[e] * ch[e]; }
        const float w0[8] = {wq[0][0].x, wq[0][0].y, wq[0][0].z, wq[0][0].w, wq[0][1].x, wq[0][1].y, wq[0][1].z, wq[0][1].w};
        const float w1[8] = {wq[1][0].x, wq[1][0].y, wq[1][0].z, wq[1][0].w, wq[1][1].x, wq[1][1].y, wq[1][1].z, wq[1][1].w};
        const float w2[8] = {wq[2][0].x, wq[2][0].y, wq[2][0].z, wq[2][0].w, wq[2][1].x, wq[2][1].y, wq[2][1].z, wq[2][1].w};
#pragma unroll
        for (int i = 0; i < 4; ++i) { float cb[8], y[8]; unpack8(vcb[i], cb);
#pragma unroll
            for (int e = 0; e < 8; ++e) y[e] = cb[e] * (w0[e] * u[i][e] + w1[e] * u[i + 1][e] + w2[e] * u[i + 2][e]);
            *(v4u*)(F.mix() + (size_t)(row0 + i) * D + DGV + c0) = pack8(y); }
        if (tq0 == SEQ - 4) {
#pragma unroll
            for (int i = 0; i < 2; ++i) { const bf16* px = F.proj() + (size_t)(MROWS + 2 * b + i) * NIN; float cc[8], ch[8]; unpack8(*(const v4u*)(px + C_CC + c0), cc); unpack8(*(const v4u*)(px + C_CH + c0), ch);
                f32x4* o = (f32x4*)(out + O_CP + (size_t)(b * 2 + i) * DCONV + c0); o[0] = (f32x4){cc[0] * ch[0], cc[1] * ch[1], cc[2] * ch[2], cc[3] * ch[3]}; o[1] = (f32x4){cc[4] * ch[4], cc[5] * ch[5], cc[6] * ch[6], cc[7] * ch[7]}; } }
    }
}
__device__ __forceinline__ void gla_prep_qk(Frame& F, int item, const float* w_a2, const float* b_a) {
    const int bh = item / NCH, c = item - bh * NCH, b = bh >> 2, hd = bh & 3, t = F.tid, lane = F.lane, w = F.wave;
    const int nreal = c == 0 ? NMETA : 64, row0 = c == 0 ? ROW_META : b * SEQ + (c - 1) * 64;
    LAS bf16* Qs = (LAS bf16*)(F.lds + L_QS); LAS bf16* Ks = (LAS bf16*)(F.lds + L_KS); LAS unsigned* KKt = (LAS unsigned*)(F.lds + L_KKT);
    LAS bf16* At = (LAS bf16*)(F.lds + L_AT); LAS float* Al = (LAS float*)(F.lds + L_AL); LAS float* Bt = (LAS float*)(F.lds + L_BT);
    unsigned char* gs = F.gscr();
    const int d = t & 255, half = t >> 8;
    __syncthreads();
#pragma unroll
    for (int x = 0; x < 2; ++x) { const int idx = t + 512 * x, j = idx >> 4, rr = idx & 15; Al[idx] = j < nreal ? bf2f(F.proj()[(size_t)(row0 + j) * NIN + C_AL + rr]) : 0.f; }
    float w2[16];
#pragma unroll
    for (int rr = 0; rr < 16; ++rr) w2[rr] = w_a2[rr * DGK + hd * DK + d];
    const float ba = b_a[hd * DK + d];
    unsigned qv[32], kv[32];
    { const GAS unsigned char* bq = (const GAS unsigned char*)(const GAS bf16*)F.proj() + (size_t)C_Q * 2; const GAS unsigned char* bk = (const GAS unsigned char*)(const GAS bf16*)F.proj() + (size_t)C_K * 2;
      unsigned off = (unsigned)(((size_t)(row0 + half * 32) * NIN + hd * DK + d) * 2);
#pragma unroll
      for (int jj = 0; jj < 32; ++jj) { asm volatile("global_load_ushort %0, %1, %2 nt" : "=v"(qv[jj]) : "v"(off), "s"(bq) : "memory"); asm volatile("global_load_ushort %0, %1, %2 nt" : "=v"(kv[jj]) : "v"(off), "s"(bk) : "memory"); off += NIN * 2; } }
    __syncthreads();
    float bc[32]; float run = 0.f;
    const LAS float* Alh = Al + half * 512;
    LAS bf16* Qsh = Qs + half * (32 * 264) + d; LAS bf16* Ksh = Ks + half * (32 * 264) + d; LAS unsigned* KKh = KKt + d * 33 + half * 16;
#pragma unroll
    for (int jj = 0; jj < 32; ++jj) { const int j = half * 32 + jj; float z = ba;
#pragma unroll
        for (int rr = 0; rr < 16; ++rr) z += Alh[jj * 16 + rr] * w2[rr];
        float la = logsigmoid(z) * 0.0625f; if (j >= nreal) la = 0.f; run += la; bc[jj] = run; if ((jj & 3) == 3) __builtin_amdgcn_sched_barrier(0); }
    Bt[half * 256 + d] = run;
    __syncthreads();
    asm volatile("s_waitcnt vmcnt(0)" ::: "memory");
#pragma unroll
    for (int jj = 0; jj < 32; ++jj) asm volatile("" : "+v"(qv[jj]), "+v"(kv[jj]));
    const float off = half ? Bt[d] : 0.f, blast = Bt[d] + Bt[256 + d];
    if (half == 0) ((float*)(gs + GS_EL))[(size_t)(bh * NCH + c) * 256 + d] = __expf(blast);
#pragma unroll
    for (int jj = 0; jj < 32; jj += 2) { const int j = half * 32 + jj; float q0 = 0.f, k0 = 0.f, q1 = 0.f, k1 = 0.f;
        if (j < nreal) { q0 = __uint_as_float(qv[jj] << 16); k0 = __uint_as_float(kv[jj] << 16); } if (j + 1 < nreal) { q1 = __uint_as_float(qv[jj + 1] << 16); k1 = __uint_as_float(kv[jj + 1] << 16); }
        const float b0 = bc[jj] + off, b1 = bc[jj + 1] + off;
        Qsh[jj * 264] = (bf16)f2bf(q0 * __expf(b0) * 0.0625f); Qsh[(jj + 1) * 264] = (bf16)f2bf(q1 * __expf(b1) * 0.0625f);
        Ksh[jj * 264] = (bf16)f2bf(k0 * __expf(-b0)); Ksh[(jj + 1) * 264] = (bf16)f2bf(k1 * __expf(-b1));
        KKh[jj >> 1] = pk2(k0 * __expf(blast - b0), k1 * __expf(blast - b1)); __builtin_amdgcn_sched_barrier(0); }
    __syncthreads();
    { const int fr = lane & 15, fq = lane >> 4, ti = w & 3;
#pragma unroll
      for (int tt = 0; tt < 2; ++tt) { const int tj = 2 * (w >> 2) + tt; f32x4 acc = (f32x4){0.f, 0.f, 0.f, 0.f};
        if (tj <= ti) {
#pragma unroll
            for (int ks = 0; ks < 8; ++ks) { const bf16x8 A = *(const LAS bf16x8*)(Ks + (16 * tj + fr) * 264 + 32 * ks + 8 * fq); const bf16x8 B = *(const LAS bf16x8*)(Qs + (16 * ti + fr) * 264 + 32 * ks + 8 * fq);
                acc = __builtin_amdgcn_mfma_f32_16x16x32_bf16(A, B, acc, 0, 0, 0); } }
        const int i = 16 * ti + fr, j0 = 16 * tj + 4 * fq;
        u32x2v o; o.x = pk2(j0 + 0 <= i ? acc[0] : 0.f, j0 + 1 <= i ? acc[1] : 0.f); o.y = pk2(j0 + 2 <= i ? acc[2] : 0.f, j0 + 3 <= i ? acc[3] : 0.f);
        *(LAS u32x2v*)(At + i * 72 + j0) = o; } }
    __syncthreads();
    { const int r = lane & 31, h = lane >> 5;
      GAS v4u* QFg = (GAS v4u*)(gs + GS_QF) + (size_t)(bh * NCH + c) * 2048; GAS v4u* KFg = (GAS v4u*)(gs + GS_KF) + (size_t)(bh * NCH + c) * 2048; GAS v4u* AFg = (GAS v4u*)(gs + GS_AF) + (size_t)(bh * NCH + c) * 512;
#pragma unroll
      for (int ff = 0; ff < 4; ++ff) { const int f = w * 4 + ff, rt = f >> 4, kt = f & 15, i = 32 * rt + r, d0 = 16 * kt + 4 * h;
          const u32x2v lo = *(const LAS u32x2v*)(Qs + i * 264 + d0), hi = *(const LAS u32x2v*)(Qs + i * 264 + d0 + 8);
          v4u o; o.x = lo.x; o.y = lo.y; o.z = hi.x; o.w = hi.y; QFg[f * 64 + lane] = o; }
#pragma unroll
      for (int ff = 0; ff < 4; ++ff) { const int f = w * 4 + ff, dt = f >> 2, ks = f & 3, dd = 32 * dt + r; const LAS unsigned* p = KKt + dd * 33 + 8 * ks + 4 * h;
          v4u o; o.x = p[0]; o.y = p[1]; o.z = p[2]; o.w = p[3]; KFg[f * 64 + lane] = o; }
      { const int f = w, rt = f >> 2, ks = f & 3, i = 32 * rt + r, j0 = 16 * ks + 8 * h; AFg[f * 64 + lane] = *(const LAS v4u*)(At + i * 72 + j0); } }
}
__device__ __forceinline__ void gla_prep_v(Frame& F, int item) {
    const int bh = item / NCH, c = item - bh * NCH, b = bh >> 2, hd = bh & 3, t = F.tid, lane = F.lane, w = F.wave;
    const int nreal = c == 0 ? NMETA : 64, row0 = c == 0 ? ROW_META : b * SEQ + (c - 1) * 64;
    LAS bf16* Vs = (LAS bf16*)(F.lds);
    unsigned char* gs = F.gscr();
    __syncthreads();
    v4u vv[8];
#pragma unroll
    for (int x = 0; x < 8; ++x) { const int p = t + 512 * x, j = p >> 6, cc = (p & 63) * 8; vv[x] = __builtin_nontemporal_load((const v4u*)(F.proj() + (size_t)(row0 + j) * NIN + C_V + hd * DV + cc)); }
#pragma unroll
    for (int x = 0; x < 8; ++x) { const int p = t + 512 * x, j = p >> 6, cc = (p & 63) * 8; *(LAS v4u*)(Vs + j * 520 + cc) = j < nreal ? vv[x] : (v4u){0u, 0u, 0u, 0u}; }
    __syncthreads();
    const int r = lane & 31, h = lane >> 5;
    GAS v4u* VFg = (GAS v4u*)(gs + GS_VF) + (size_t)(bh * NCH + c) * 4096;
#pragma unroll
    for (int ff = 0; ff < 8; ++ff) { const int f = w * 8 + ff, vt = f >> 2, ks = f & 3, col = 32 * vt + r, j0 = 16 * ks + 8 * h; const LAS bf16* p = Vs + j0 * 520 + col;
        v4u o; o.x = (unsigned)p[0] | ((unsigned)p[520] << 16); o.y = (unsigned)p[2 * 520] | ((unsigned)p[3 * 520] << 16); o.z = (unsigned)p[4 * 520] | ((unsigned)p[5 * 520] << 16); o.w = (unsigned)p[6 * 520] | ((unsigned)p[7 * 520] << 16);
        VFg[f * 64 + lane] = o; }
}
#define MFMA32(a, b, c) __builtin_amdgcn_mfma_f32_32x32x16_bf16(__builtin_bit_cast(bf16x8, (a)), __builtin_bit_cast(bf16x8, (b)), (c), 0, 0, 0)
__device__ __forceinline__ void gla_scan(Frame& F, int unit, float* out) {
    const int bh = unit >> 4, sl = unit & 15, b = bh >> 2, hd = bh & 3, e = F.wave, lane = F.lane, r = lane & 31, h = lane >> 5;
    const GAS unsigned char* gs = (const GAS unsigned char*)F.gscr();
    const unsigned lo = (unsigned)lane * 16u, loe = (unsigned)h * 16u;
    const GAS unsigned char* QFb = gs + GS_QF + ((size_t)bh * NCH * 2048 + (2 * e) * 64) * 16;
    const GAS unsigned char* KFb = gs + GS_KF + ((size_t)bh * NCH * 2048 + (4 * e) * 64) * 16;
    const GAS unsigned char* AFb = gs + GS_AF + ((size_t)bh * NCH * 512 + ((e & 1) * 4 + (e >> 1)) * 64) * 16;
    const GAS unsigned char* VFb = gs + GS_VF + ((size_t)bh * NCH * 4096 + (sl * 4) * 64) * 16;
    const GAS unsigned char* ELb = gs + GS_EL + ((size_t)bh * NCH * 256 + 32 * e) * 4;
    LAS float* Part = (LAS float*)F.lds;
    LAS v4u* VS = (LAS v4u*)(F.lds + LDSCTL_OFF + 512);
    bf16* orow = F.obuf() + (size_t)(b * SEQ) * DGV + hd * DV + 32 * sl + r;
    const int ksel = e >> 1;
    f32x16 S;
#pragma unroll
    for (int i = 0; i < 16; ++i) S[i] = 0.f;
    v4u q00, q01, q10, q11, at, k0, k1, k2, k3, v0, v1, v2, v3, vtA = (v4u){0u, 0u, 0u, 0u}, vtB = (v4u){0u, 0u, 0u, 0u}; f32x4 e0, e1, e2, e3;
#define LDV(p) (*(const GAS v4u*)(p))
#define GLA_LOADQ(c_) do { const GAS unsigned char* qp = QFb + (size_t)(c_) * 32768; q00 = LDV(qp + lo); q01 = LDV(qp + 1024 + lo); q10 = LDV(qp + 16384 + lo); q11 = LDV(qp + 17408 + lo); \
        at = LDV(AFb + (size_t)(c_) * 8192 + lo); } while (0)
#define GLA_LOADV(c_) do { const GAS unsigned char* vp = VFb + (size_t)(c_) * 65536; v0 = LDV(vp + lo); v1 = LDV(vp + 1024 + lo); v2 = LDV(vp + 2048 + lo); v3 = LDV(vp + 3072 + lo); } while (0)
#define GLA_LOADK(c_) do { const GAS unsigned char* kp = KFb + (size_t)(c_) * 32768; k0 = LDV(kp + lo); k1 = LDV(kp + 1024 + lo); k2 = LDV(kp + 2048 + lo); k3 = LDV(kp + 3072 + lo); \
        const GAS unsigned char* ep = ELb + (size_t)(c_) * 1024; e0 = *(const GAS f32x4*)(ep + loe); e1 = *(const GAS f32x4*)(ep + 32 + loe); e2 = *(const GAS f32x4*)(ep + 64 + loe); e3 = *(const GAS f32x4*)(ep + 96 + loe); } while (0)
#define GLA_STATE() do { S[0] *= e0.x; S[1] *= e0.y; S[2] *= e0.z; S[3] *= e0.w; S[4] *= e1.x; S[5] *= e1.y; S[6] *= e1.z; S[7] *= e1.w; \
        S[8] *= e2.x; S[9] *= e2.y; S[10] *= e2.z; S[11] *= e2.w; S[12] *= e3.x; S[13] *= e3.y; S[14] *= e3.z; S[15] *= e3.w; \
        S = MFMA32(k0, v0, S); S = MFMA32(k1, v1, S); S = MFMA32(k2, v2, S); S = MFMA32(k3, v3, S); } while (0)
#define GLA_ATTN(o) do { if (ksel == 0) o = MFMA32(at, v0, o); else if (ksel == 1) o = MFMA32(at, v1, o); else if (ksel == 2) o = MFMA32(at, v2, o); else o = MFMA32(at, v3, o); } while (0)
#define GLA_STEP(VT, VN, c_) do { const int cc_ = (c_); LAS float* P = Part + (cc_ & 1) * 16384; \
        if (cc_ >= 3) { const LAS v4u* vs = VS + (cc_ % 3) * 256 + lane; v0 = vs[0]; v1 = vs[64]; v2 = vs[128]; v3 = vs[192]; } \
        { v4u s0, s1; s0.x = pk2(S[0], S[1]); s0.y = pk2(S[2], S[3]); s0.z = pk2(S[4], S[5]); s0.w = pk2(S[6], S[7]); s1.x = pk2(S[8], S[9]); s1.y = pk2(S[10], S[11]); s1.z = pk2(S[12], S[13]); s1.w = pk2(S[14], S[15]); \
          f32x16 o; _Pragma("unroll") for (int i = 0; i < 16; ++i) o[i] = 0.f; \
          o = MFMA32(q00, s0, o); o = MFMA32(q01, s1, o); if (!(e & 1)) GLA_ATTN(o); \
          _Pragma("unroll") for (int i = 0; i < 16; ++i) P[((e * 2 + 0) * 16 + i) * 64 + lane] = o[i]; \
          _Pragma("unroll") for (int i = 0; i < 16; ++i) o[i] = 0.f; \
          o = MFMA32(q10, s0, o); o = MFMA32(q11, s1, o); if (e & 1) GLA_ATTN(o); \
          _Pragma("unroll") for (int i = 0; i < 16; ++i) P[((e * 2 + 1) * 16 + i) * 64 + lane] = o[i]; } \
        if (cc_ + 1 < NCH) GLA_LOADQ(cc_ + 1); \
        GLA_STATE(); \
        if (cc_ + 1 < NCH) GLA_LOADK(cc_ + 1); \
        if (cc_ + 1 < NCH && cc_ + 1 < 3) GLA_LOADV(cc_ + 1);                       \
        if (e < 4 && cc_ + 2 < NCH) VT = __builtin_nontemporal_load((const GAS v4u*)(VFb + (size_t)(cc_ + 2) * 65536 + e * 1024 + lo)); \
        if (e < 4 && cc_ + 1 < NCH && cc_ + 1 >= 3) VS[((cc_ + 1) % 3) * 256 + e * 64 + lane] = VN; \
        __syncthreads(); \
        _Pragma("unroll") for (int pp = 0; pp < 4; ++pp) { const int p = 4 * e + pp, rt = p >> 4, reg = p & 15; float s = 0.f; \
            _Pragma("unroll") for (int w2 = 0; w2 < 8; ++w2) s += P[((w2 * 2 + rt) * 16 + reg) * 64 + lane]; \
            const int i = 32 * rt + crow32(reg, h); orow[(size_t)((cc_ - 1) * 64 + i) * DGV] = (bf16)f2bf(s); } } while (0)
    __syncthreads();
    GLA_LOADK(0); GLA_LOADV(0); GLA_LOADQ(1);
    GLA_STATE();
    GLA_LOADK(1); GLA_LOADV(1);
    for (int c = 1; c < NCH; c += 2) { GLA_STEP(vtB, vtA, c); GLA_STEP(vtA, vtB, c + 1); }
#undef LDV
#undef GLA_LOADQ
#undef GLA_LOADV
#undef GLA_LOADK
#undef GLA_STATE
#undef GLA_ATTN
#undef GLA_STEP
    float* gp = out + O_GP + ((size_t)(b * NH + hd) * DK + 32 * e) * DV + 32 * sl + r;
#pragma unroll
    for (int i = 0; i < 16; ++i) gp[(size_t)crow32(i, h) * DV] = S[i];
    __syncthreads();
}

__device__ __forceinline__ void finish_rows(Frame& F, int row, int lane, const float* gnorm) {
    const f32x4* gq = (const f32x4*)(gnorm + 8 * lane); const f32x4 g0 = gq[0], g1 = gq[1];
    const float gn[8] = {g0.x, g0.y, g0.z, g0.w, g1.x, g1.y, g1.z, g1.w};
    const bf16* op = F.obuf() + (size_t)row * DGV + 8 * lane; const bf16* gp = F.proj() + (size_t)row * NIN + C_G + 8 * lane;
    v4u ov[4], gv[4];
#pragma unroll
    for (int hd = 0; hd < 4; ++hd) { ov[hd] = __builtin_nontemporal_load((const v4u*)(op + hd * DV)); gv[hd] = __builtin_nontemporal_load((const v4u*)(gp + hd * DV)); }
    float ss[4];
#pragma unroll
    for (int hd = 0; hd < 4; ++hd) { float o[8]; unpack8(ov[hd], o); float s = 0.f;
#pragma unroll
        for (int e = 0; e < 8; ++e) s += o[e] * o[e];
        ss[hd] = s; }
#pragma unroll
    for (int o = 1; o < 64; o <<= 1) { ss[0] += __shfl_xor(ss[0], o); ss[1] += __shfl_xor(ss[1], o); ss[2] += __shfl_xor(ss[2], o); ss[3] += __shfl_xor(ss[3], o); }
#pragma unroll
    for (int hd = 0; hd < 4; ++hd) { float o[8], g[8], y[8]; unpack8(ov[hd], o); unpack8(gv[hd], g); const float rs = 1.f / sqrtf(ss[hd] * (1.f / DV) + RMS_EPS);
#pragma unroll
        for (int e = 0; e < 8; ++e) y[e] = o[e] * rs * gn[e] * silu(g[e]);
        *(v4u*)(F.mix() + (size_t)row * D + hd * DV + 8 * lane) = pack8(y); }
}

struct Args { const float* in[20]; float* out; unsigned char* ws; };
constexpr int SC_GU = 2 * CM_STRIPS * D, SC_TOTAL = SC_GU + CD_STRIPS * DFF;
struct SideColMax {
    static constexpr int NV = 2;
    const Frame* F; const GAS unsigned char* base; int cg, cur, left; unsigned voff;
    f32x4 m, x0, x1;
    __device__ __forceinline__ int K() const { return cg < 2 * CM_STRIPS ? D : DFF; }
    __device__ __forceinline__ unsigned pitch() const { return cg < 2 * CM_STRIPS ? DFF * 4u : D * 4u; }
    __device__ __forceinline__ void setcg() {
        if (cg < 2 * CM_STRIPS) { const int mt = cg >= CM_STRIPS ? 1 : 0, strip = cg - mt * CM_STRIPS; base = (const GAS unsigned char*)(const GAS float*)(mt ? F->in<A_WUP>() : F->in<A_WGATE>()) + (size_t)strip * 1024; }
        else base = (const GAS unsigned char*)(const GAS float*)F->in<A_WDOWN>() + (size_t)(cg - 2 * CM_STRIPS) * 1024; }
    __device__ __forceinline__ void init(const Frame& F_, int gw, int ngw, int lo, int hi) { F = &F_; voff = 16u * (unsigned)F_.lane;
        int share = (hi - lo + ngw - 1) / ngw; share += share & 1; const int i0 = lo + gw * share; left = hi - i0; left = left < 0 ? 0 : (left > share ? share : left);
        if (left == 0) { cg = 0; cur = 1; } else if (i0 < SC_GU) { cg = i0 / D; cur = i0 - cg * D; } else { const int j = i0 - SC_GU; cg = j / DFF; cur = j - cg * DFF; cg += 2 * CM_STRIPS; }
        setcg(); m = x0 = x1 = (f32x4){0.f, 0.f, 0.f, 0.f}; }
    __device__ __forceinline__ void consume() {
        m.x = fmaxf(fmaxf(m.x, fabsf(x0.x)), fabsf(x1.x)); m.y = fmaxf(fmaxf(m.y, fabsf(x0.y)), fabsf(x1.y)); m.z = fmaxf(fmaxf(m.z, fabsf(x0.z)), fabsf(x1.z)); m.w = fmaxf(fmaxf(m.w, fabsf(x0.w)), fabsf(x1.w)); }
    __device__ __forceinline__ void flush() {
        unsigned* cm;
        if (cg < 2 * CM_STRIPS) { const int mt = cg >= CM_STRIPS ? 1 : 0, c0 = 256 * (cg - mt * CM_STRIPS) + 4 * F->lane; cm = (unsigned*)F->cmax() + 256 * (c0 >> 7) + (mt ? 128 : 0) + (c0 & 127); }
        else cm = (unsigned*)F->cmdn() + 256 * (cg - 2 * CM_STRIPS) + 4 * F->lane;
        __hip_atomic_fetch_max(cm + 0, __float_as_uint(m.x), __ATOMIC_RELAXED, __HIP_MEMORY_SCOPE_AGENT); __hip_atomic_fetch_max(cm + 1, __float_as_uint(m.y), __ATOMIC_RELAXED, __HIP_MEMORY_SCOPE_AGENT);
        __hip_atomic_fetch_max(cm + 2, __float_as_uint(m.z), __ATOMIC_RELAXED, __HIP_MEMORY_SCOPE_AGENT); __hip_atomic_fetch_max(cm + 3, __float_as_uint(m.w), __ATOMIC_RELAXED, __HIP_MEMORY_SCOPE_AGENT);
        m = (f32x4){0.f, 0.f, 0.f, 0.f}; }
    __device__ __forceinline__ void step() {
        if (left > 0 && cur == K()) { flush(); ++cg; setcg(); cur = 0; }
        int n = K() - cur; n = n < left ? n : left; n = n < 2 ? n : 2;
        const int last = n > 0 ? cur + n - 1 : cur - 1, r0 = cur < last ? cur : last;
        const GAS unsigned char* p0 = base + (size_t)r0 * pitch(); const GAS unsigned char* p1 = base + (size_t)last * pitch();
        asm volatile("global_load_dwordx4 %0, %1, %2 nt" : "=v"(x0) : "v"(voff), "s"(p0) : "memory");
        asm volatile("global_load_dwordx4 %0, %1, %2 nt" : "=v"(x1) : "v"(voff), "s"(p1) : "memory");
        cur += n; left -= n; }
    __device__ __forceinline__ void finish() { while (left > 0) { step(); asm volatile("s_waitcnt vmcnt(0)" ::: "memory"); consume(); } flush(); }
};
__global__ void __launch_bounds__(NWAVES * 64, 2) hymba_fwd(Args args) {
    extern __shared__ __attribute__((aligned(16))) unsigned char lds[];
    Frame F;
    F.lds = (LAS unsigned char*)lds;
    F.MISC = (volatile LAS unsigned*)(F.lds + MISC_OFF);
    F.tid = threadIdx.x; F.lane = F.tid & 63; F.wave = __builtin_amdgcn_readfirstlane(F.tid >> 6);
    F.G = gridDim.x; { const int bx = blockIdx.x; F.vcu = (F.G % 8 == 0) ? (bx % 8) * (F.G / 8) + bx / 8 : bx; }
    unsigned char* ws = args.ws;
    F.ctl = (gu32*)(ws + WS_CTL);
    F.ws = ws;
    for (int u = F.tid; u < (LDS_BYTES - LDSCTL_OFF) / 4; u += NWAVES * 64) ((LAS unsigned*)(F.lds + LDSCTL_OFF))[u] = 0u;
    __syncthreads();
    XcdBarrier bar = xcd_barrier_post((unsigned*)(F.ctl + CW_BAR), F.MISC + 8);
    const int gw = F.vcu * NWAVES + F.wave, NGW = F.G * NWAVES;

    p0_prologue(F);
    if (NCONV_CU == 0 || F.G != 256) convert_rest(F, F.vcu * NWAVES + F.wave, F.G * NWAVES, 0, I_OUT);
    xcd_barrier(bar); F.refresh();
    quant_in_pass(F, gw, NGW);
    xcd_barrier(bar); F.refresh();
    { SideColMax sd; sd.init(F, gw, NGW, 0, SC_GU);
      { pg8::Gemm g{F.h0(), F.Wt_in(), MPAD, NBF, D}; g.wave = F.wave; pg8::PackedOrder<0> S; S.init(MPR / 256, C_CC / 256, F.G, (int)blockIdx.x, D / 64, NBF / 256);
        pg8::EpiBf16 E{F.proj(), NIN, F.slab(), (float*)((unsigned char*)F.slab() + SLAB_A_OFF)};
        pg8::gemm_phase<pg8::EpiBf16, pg8::PackedOrder<0>, PG8_ALIGN, PG8_SP2, SideColMax>(F.lds + RING_OFF, g, S, E, sd); }
      { const int c2 = (F.G == 256) ? (((int)blockIdx.x + 128) & 255) : (int)blockIdx.x;
        pg8::Gemm g{(const bf16*)F.h0q(), (const bf16*)F.Wq_in(), MPAD, NI8, D / 2}; g.wave = F.wave; pg8::PackedOrder<4> S; S.init(MPR / 256, NI8 / 256, F.G, c2, D / 128, NI8X / 256);
        pg8::EpiBf16I8 E{F.proj() + NBF, NIN, F.slab() + NBF, F.rs0(), F.cmin(), NI8X / 256, C_CC - NBF - NI8X};
        pg8::gemm_phase<pg8::EpiBf16I8, pg8::PackedOrder<4>, PG8_ALIGN, PG8_SP2, SideColMax>(F.lds + RING_OFF, g, S, E, sd); }
      sd.finish(); }
    xcd_barrier(bar); F.refresh();
    { const int gt = blockIdx.x * (NWAVES * 64) + F.tid, NT = F.G * NWAVES * 64; const float* sx = F.slab(); const float* sa = (const float*)((const unsigned char*)F.slab() + SLAB_A_OFF);
      for (int idx = gt; idx < XROWS * (NIN / 8); idx += NT) { const int r = idx / (NIN / 8), cg = idx - r * (NIN / 8); const float* p = sx + (size_t)r * NIN + 8 * cg; float v[8];
          { const f32x4 a = __builtin_nontemporal_load((const f32x4*)p), c = __builtin_nontemporal_load((const f32x4*)p + 1); v[0] = a.x; v[1] = a.y; v[2] = a.z; v[3] = a.w; v[4] = c.x; v[5] = c.y; v[6] = c.z; v[7] = c.w; }
#pragma unroll
          for (int s = 1; s < 3; ++s) { const f32x4 a = __builtin_nontemporal_load((const f32x4*)(p + (size_t)s * XROWS * NIN)), c = __builtin_nontemporal_load((const f32x4*)(p + (size_t)s * XROWS * NIN) + 1); v[0] += a.x; v[1] += a.y; v[2] += a.z; v[3] += a.w; v[4] += c.x; v[5] += c.y; v[6] += c.z; v[7] += c.w; }
          *(v4u*)(F.proj() + (size_t)(MPR + r) * NIN + 8 * cg) = pack8(v); }
      for (int idx = gt; idx < MPR * 2; idx += NT) { const int row = idx >> 1, hf = idx & 1; const float* p = sa + (size_t)row * 16 + 8 * hf; float v[8];
          { const f32x4 a = ((const f32x4*)p)[0], c = ((const f32x4*)p)[1]; v[0] = a.x; v[1] = a.y; v[2] = a.z; v[3] = a.w; v[4] = c.x; v[5] = c.y; v[6] = c.z; v[7] = c.w; }
#pragma unroll
          for (int s = 1; s < 3; ++s) { const f32x4 a = ((const f32x4*)(p + (size_t)s * MPR * 16))[0], c = ((const f32x4*)(p + (size_t)s * MPR * 16))[1]; v[0] += a.x; v[1] += a.y; v[2] += a.z; v[3] += a.w; v[4] += c.x; v[5] += c.y; v[6] += c.z; v[7] += c.w; }
          *(v4u*)(F.proj() + (size_t)row * NIN + C_AL + 8 * hf) = pack8(v); } }
    xcd_barrier(bar); F.refresh();
    { const float *w_a2 = F.in<A_WA2>(), *b_a = F.in<A_BA>(), *state_conv = F.in<A_SCONV>(), *conv_w = F.in<A_CONVW>(), *state_gla = F.in<A_SGLA>(); float* out = F.out();
      const int nsa = F.G == 256 ? 256 : 0;
      if (blockIdx.x & 1) for (int it = blockIdx.x; it < nsa; it += F.G) gla_sample_item(F, it, w_a2, b_a, state_gla, out);
      if (F.G == 256) { const int c = blockIdx.x;
          gla_prep_qk(F, c, w_a2, b_a); gla_prep_qk(F, c + 256, w_a2, b_a);
          if (c < 16) gla_prep_qk(F, c + 512, w_a2, b_a);
          else { gla_prep_v(F, c - 16); gla_prep_v(F, c - 16 + 240); if (c - 16 < 48) gla_prep_v(F, c - 16 + 480); } }
      else for (int it = blockIdx.x; it < 2 * NBH * NCH; it += F.G) { if (it < NBH * NCH) gla_prep_qk(F, it, w_a2, b_a); else gla_prep_v(F, it - NBH * NCH); }
      for (int r4 = gw; r4 < MPR / 4; r4 += NGW) conv_rows4(F, 4 * r4, F.lane, conv_w, out);
      for (int row = ROW_S + gw; row < ROW_META; row += NGW) conv_row(F, row, F.lane, state_conv, conv_w, out);
      if (!(blockIdx.x & 1)) for (int it = blockIdx.x; it < nsa; it += F.G) gla_sample_item(F, it, w_a2, b_a, state_gla, out); }
    xcd_barrier(bar); F.refresh();
    { const float *w_a2 = F.in<A_WA2>(), *b_a = F.in<A_BA>(), *state_gla = F.in<A_SGLA>(); float* out = F.out();
      const int nsa = F.G == 256 ? 256 : 0;
      if (!(blockIdx.x & 1)) for (int it = nsa + blockIdx.x; it < NSAMP * NH; it += F.G) gla_sample_item(F, it, w_a2, b_a, state_gla, out);
      for (int u0 = blockIdx.x; u0 < 256; u0 += F.G) { const int i = u0 >> 3, u = F.G == 256 ? (2 * (u0 & 7) + (i >> 4)) * 16 + (i & 15) : u0; gla_scan(F, u, out); }
      if (blockIdx.x & 1) for (int it = nsa + blockIdx.x; it < NSAMP * NH; it += F.G) gla_sample_item(F, it, w_a2, b_a, state_gla, out); }
    xcd_barrier(bar); F.refresh();
    { const float* gnorm = F.in<A_GNORM>(); for (int row = gw; row < ROW_META; row += NGW) finish_rows(F, row, F.lane, gnorm); }
    xcd_barrier(bar); F.refresh();
    { pg8::Gemm g{F.mix(), F.Wt_out(), MPAD, D, D}; g.wave = F.wave; pg8::PackedOrder<1> S; S.init(MPR / 256, D / 256, F.G, (int)blockIdx.x, D / 64);
      pg8::EpiResBf16 E{F.R(), D, F.h0(), D, ALPHA, F.slab()};
      SideColMax sd; sd.init(F, gw, NGW, SC_GU, SC_TOTAL);
      pg8::gemm_phase<pg8::EpiResBf16, pg8::PackedOrder<1>, PG8_ALIGN, PG8_SP2, SideColMax>(F.lds + RING_OFF, g, S, E, sd);
      sd.finish(); }
    xcd_barrier(bar); F.refresh();
    { const float *ln_g = F.in<A_LN1G>(), *ln_b = F.in<A_LN1B>();
      for (int r = blockIdx.x; r < NSAMP; r += F.G) ln_row_slab_block<false, 16>(F, F.slab(), r, F.h0() + (size_t)(ROW_S + r) * D, ln_g, ln_b, F.h1() + (size_t)(ROW_S + r) * D, F.h1q() + (size_t)(ROW_S + r) * D, F.rsc() + ROW_S + r);
      stage_gb(F, ln_g, ln_b);
      for (int row = gw; row < MPR; row += NGW) ln1_row_quant(F.R() + (size_t)row * D, (const LAS f32x4*)(F.lds + LDS_GB), F.h1() + (size_t)row * D, F.h1q() + (size_t)row * D, F.rsc() + row, F.lane); }
    quant_gu_pass(F, gw, NGW);
    xcd_barrier(bar); F.refresh();
    { pg8::Gemm g{(const bf16*)F.h1q(), F.Wt_gu(), MPAD, NGU, D / 2}; g.wave = F.wave; pg8::PackedOrder<2> S; S.init(MPR / 256, NGU / 256, F.G, (int)blockIdx.x, D / 128);
      pg8::EpiSwiGLUi8 E{F.act(), DFF, F.slab(), NGU, F.rsc(), F.cmax()};
      pg8::gemm_phase<pg8::EpiSwiGLUi8, pg8::PackedOrder<2>, PG8_ALIGN, PG8_SP2>(F.lds + RING_OFF, g, S, E); }
    xcd_barrier(bar); F.refresh();
    for (int r = blockIdx.x; r < NSAMP; r += F.G) { LAS float* red = (LAS float*)F.lds; const int t = F.tid; float y[3][8]; float mx = 0.f;
#pragma unroll
        for (int gi = 0; gi < 3; ++gi) { const int cg = t + 512 * gi;
#pragma unroll
            for (int e = 0; e < 8; ++e) y[gi][e] = 0.f;
            if (cg < DFF / 8) { const int col0 = 8 * cg, pn = col0 >> 7, cc = col0 & 127; const float* pg = F.slab() + (size_t)r * NGU + 256 * pn + cc; float gv[8], uv[8];
#pragma unroll
                for (int e = 0; e < 8; ++e) { gv[e] = 0.f; uv[e] = 0.f; }
#pragma unroll
                for (int s = 0; s < 4; ++s) { const f32x4* q = (const f32x4*)(pg + (size_t)s * 128 * NGU); const f32x4 a = q[0], c = q[1], d0 = q[32], d1 = q[33];
                    gv[0] += a.x; gv[1] += a.y; gv[2] += a.z; gv[3] += a.w; gv[4] += c.x; gv[5] += c.y; gv[6] += c.z; gv[7] += c.w;
                    uv[0] += d0.x; uv[1] += d0.y; uv[2] += d0.z; uv[3] += d0.w; uv[4] += d1.x; uv[5] += d1.y; uv[6] += d1.z; uv[7] += d1.w; }
#pragma unroll
                for (int e = 0; e < 8; ++e) { y[gi][e] = silu(gv[e]) * uv[e]; mx = fmaxf(mx, fabsf(y[gi][e])); } } }
        mx = wave_max(mx);
        __syncthreads();
        if (F.lane == 0) red[F.wave] = mx;
        __syncthreads();
        float tm = 0.f;
#pragma unroll
        for (int w = 0; w < 8; ++w) tm = fmaxf(tm, red[w]);
        const float inv = tm > 0.f ? 127.0f / tm : 0.f;
        if (t == 0) F.amax()[ROW_S + r] = tm;
#pragma unroll
        for (int gi = 0; gi < 3; ++gi) { const int cg = t + 512 * gi; if (cg < DFF / 8) { u32x2v q; q.x = q4(y[gi][0], y[gi][1], y[gi][2], y[gi][3], inv); q.y = q4(y[gi][4], y[gi][5], y[gi][6], y[gi][7], inv);
            *(u32x2v*)(F.actq() + (size_t)(ROW_S + r) * DFF + 8 * cg) = q; } } }
    for (int row = gw; row < MPR; row += NGW) act_row_quant(F, row, F.lane);
    quant_dn_pass(F, gw, NGW);
    xcd_barrier(bar); F.refresh();
    { pg8::Gemm g{(const bf16*)F.actq(), F.Wt_dn(), MPAD, D, DFF / 2}; g.wave = F.wave; pg8::PackedOrder<3> S; S.init(MPR / 256, D / 256, F.G, (int)blockIdx.x, DFF / 128);
      pg8::EpiResI8 E{F.R(), D, F.h1(), D, ALPHA, F.slab(), F.amax(), F.cmdn()};
      pg8::gemm_phase<pg8::EpiResI8, pg8::PackedOrder<3>, PG8_ALIGN, PG8_SP2>(F.lds + RING_OFF, g, S, E); }
    xcd_barrier(bar); F.refresh();
    { const float *ln_g = F.in<A_LN2G>(), *ln_b = F.in<A_LN2B>(); float* out = F.out();
      for (int r = blockIdx.x; r < NSAMP; r += F.G) ln_row_slab_block<true, 16>(F, F.slab(), r, F.h1() + (size_t)(ROW_S + r) * D, ln_g, ln_b, out + O_YS + (size_t)r * D);
      stage_gb(F, ln_g, ln_b);
      for (int row = gw; row < MPR; row += NGW) { int l = F.lane; asm volatile("" : "+v"(l));
          ln_row_b16<true>(F.R() + (size_t)row * D, (const LAS f32x4*)(F.lds + LDS_GB), out + O_YP + (size_t)row * D, l); } }
}

extern "C" void kernel_launch(void* const* d_in, const int* in_sizes, int n_in, void* d_out, int out_size, void* d_ws, size_t ws_size, hipStream_t stream) {
    static int grid = 0;
    if (grid == 0) {
        if (n_in != 20 || (size_t)out_size != O_END || ws_size < WS_END) { fprintf(stderr, "kernel_launch: unexpected shapes (n_in %d out %d ws %zu)\n", n_in, out_size, ws_size); grid = -1; return; }
        int dev = 0, cus = 0, per_cu = 0;
        if (hipGetDevice(&dev) != hipSuccess || hipDeviceGetAttribute(&cus, hipDeviceAttributeMultiprocessorCount, dev) != hipSuccess) { grid = -1; return; }
        if (hipFuncSetAttribute((const void*)hymba_fwd, hipFuncAttributeMaxDynamicSharedMemorySize, LDS_BYTES) != hipSuccess) { fprintf(stderr, "kernel_launch: hipFuncSetAttribute failed\n"); grid = -1; return; }
        if (hipOccupancyMaxActiveBlocksPerMultiprocessor(&per_cu, (const void*)hymba_fwd, NWAVES * 64, LDS_BYTES) != hipSuccess || per_cu < 1) { fprintf(stderr, "kernel_launch: occupancy query says %d\n", per_cu); (void)hipGetLastError(); grid = -1; return; }
        grid = cus;
    }
    if (grid < 0) return;
    if (hipMemsetAsync((char*)d_ws + WS_CTL, 0, CTL_ZERO_BYTES, stream) != hipSuccess) return;
    Args a{};
    for (int i = 0; i < 20; ++i) a.in[i] = (const float*)d_in[i];
    a.out = (float*)d_out; a.ws = (unsigned char*)d_ws;
    hipLaunchKernelGGL(hymba_fwd, dim3(grid), dim3(NWAVES * 64), LDS_BYTES, stream, a);
}
```

```cpp
#include <hip/hip_runtime.h>
#include <cstdio>
#include <cstdint>
namespace pg8 {
#define PG8_LAS __attribute__((address_space(3)))
typedef unsigned short bf16_t;
typedef short bf16x8 __attribute__((ext_vector_type(8)));
typedef float f32x4 __attribute__((ext_vector_type(4)));
typedef unsigned u32x4 __attribute__((ext_vector_type(4)));
constexpr int BM = 256, BK = 64, HALF = 128, HTB = HALF * BK * 2  , STAGE_BYTES = 8 * HTB, NXCD = 8, WGM = 8;

__host__ __device__ __forceinline__ int lds_byte(int r, int c) { const int st = (r >> 4) * 2 + (c >> 5), rr = r & 15, cc = c & 31, ob = rr * 64 + cc * 2; return st * 1024 + (ob ^ (((ob >> 9) & 1) << 5)); }
__host__ __device__ __forceinline__ void stage_rc(int b, int& R, int& C) { const int st = b / 1024, sb = b % 1024, swz = sb ^ (((sb >> 9) & 1) << 5); R = (st >> 1) * 16 + swz / 64; C = (st & 1) * 32 + (swz % 64) / 2; }
__host__ __device__ __forceinline__ int perm32(int rho) { const int n = rho >> 4, i = rho & 15; return 8 * (i >> 2) + 4 * n + (i & 3); }

struct Unit { int a, b;
    __device__ __forceinline__ int pm() const { return a & 0xff; } __device__ __forceinline__ int pn() const { return (a >> 8) & 0xff; } __device__ __forceinline__ int kind() const { return (a >> 16) & 0xf; } __device__ __forceinline__ int sl() const { return (a >> 20) & 0xff; }
    __device__ __forceinline__ int k0() const { return b & 0xffff; } __device__ __forceinline__ int nt() const { return b >> 16; }
    __device__ __forceinline__ void set(int pm_, int pn_, int k0_, int nt_, int kind_, int sl_) { a = pm_ | (pn_ << 8) | (kind_ << 16) | (sl_ << 20); b = k0_ | (nt_ << 16); } };
struct Gemm { const bf16_t* A; const bf16_t* Bt; int M, N, K; int wave = 0; };

template <int MODE> struct PackedOrder {
    int nM, nN, nwg, G, c, ntfull, nmain, rank, nextra, nfirst, xstride, NX, nE;
    __device__ __forceinline__ void init(int nM_, int nN_, int G_, int c_, int ntfull_, int nE_ = 0) { nM = nM_; nN = nN_; nwg = nM * nN; G = G_; c = c_; ntfull = ntfull_; nE = nE_;
        const int rem = nwg % G; nmain = nwg / G + (c < rem ? 1 : 0); rank = c - rem; if (rank < 0) rank += G;
        NX = MODE == 0 ? 3 * (nE + 32) : (MODE == 4 ? 3 * nE : (MODE == 2 ? 344 : 256));
        if (MODE == 0 || MODE == 4) { const int nlight = rem ? G - rem : G; xstride = nlight; nextra = rank < nlight ? (NX - rank + nlight - 1) / nlight : 0; }
        else if (MODE == 2 && G == 256) { xstride = 1; nextra = rank < 64 ? 4 : (rank - 64 < NX - 256 ? 1 : 0); }
        else { xstride = G; nextra = rank < NX ? (NX - rank + G - 1) / G : 0; }
        if (nextra < 0) nextra = 0;
        nfirst = (MODE != 2 && (c & 7) < 4) ? nextra : 0;
    }
    __device__ __forceinline__ bool next(int i, Unit& u) const {
        int j = -1;
        int im = i - nfirst;
        if (i < nfirst) j = i; else if (im >= nmain) { j = nfirst + (im - nmain); if (j >= nextra) return false; }
        if (j < 0) { int wgid = im * G + c; { const int q = nwg / NXCD, r = nwg % NXCD, xcd = wgid % NXCD, off = wgid / NXCD; wgid = (xcd < r ? xcd * (q + 1) : r * (q + 1) + (xcd - r) * q) + off; }
            const int nig = WGM * nN, gid = wgid / nig, fm = gid * WGM, gsz = (nM - fm) < WGM ? (nM - fm) : WGM;
            u.set(fm + ((wgid % nig) % gsz), (wgid % nig) / gsz, 0, ntfull, 0, 0); return true; }
        int x;
        if (MODE == 2 && G == 256) x = rank < 64 ? rank * 4 + j : 256 + rank - 64; else x = rank + j * xstride;
        if (MODE == 0 || MODE == 4) { const int id = x / 3, s = x - 3 * id, pairs = ntfull / 2, base = pairs / 3, rem3 = pairs % 3;
            const int k0 = 2 * (s < rem3 ? (base + 1) * s : (base + 1) * rem3 + base * (s - rem3)), nt = 2 * (s < rem3 ? base + 1 : base);
            if (MODE == 4 || id < nE) u.set(32, id, k0, nt, 1, s); else u.set(id - nE, nE - 1, k0, nt, 2, s); }
        else if (MODE == 1) u.set(32, x >> 4, 4 * (x & 15), 4, 1, x & 15);
        else if (MODE == 2) u.set(32, x >> 2, (ntfull / 4) * (x & 3), ntfull / 4, 1, x & 3);
        else { const int s = x & 15, pairs = ntfull / 2, base = pairs / 16, rem = pairs % 16;
            u.set(32, x >> 4, 2 * (s < rem ? (base + 1) * s : (base + 1) * rem + base * (s - rem)), 2 * (s < rem ? base + 1 : base), 1, s); }
        return true;
    }
    __device__ __forceinline__ void a_ready(const Unit&) const {}
    __device__ __forceinline__ void done(const Unit&) const {}
};

typedef unsigned u32x2 __attribute__((ext_vector_type(2)));
__device__ __forceinline__ unsigned cvt_pk_bf16(float lo, float hi) { unsigned r; asm volatile("v_cvt_pk_bf16_f32 %0, %1, %2" : "=v"(r) : "v"(lo), "v"(hi)); return r; }
__device__ __forceinline__ float bf_lo(unsigned w) { return __uint_as_float(w << 16); }
__device__ __forceinline__ float bf_hi(unsigned w) { return __uint_as_float(w & 0xffff0000u); }
__device__ __forceinline__ float silu_f(float a) { return a * __builtin_amdgcn_rcpf(1.0f + __builtin_amdgcn_exp2f(-1.44269504089f * a)); }

constexpr int XROWS = 152;
struct EpiBf16 {
    static constexpr bool PERM = true, AFTER_DRAIN = false, I8 = false; typedef f32x4 acc_t;
    bf16_t* O; int ldc; float* slabX; float* slabA;
    __device__ __forceinline__ void operator()(const f32x4 (&acc)[2][2][4][2], const Unit& u, int wr, int wc, int fr, int fq) const {
        const int row0 = u.pm() * BM + wr * 64 + fr, col0 = u.pn() * BM + wc * 32 + 8 * fq;
        if (u.kind() == 1) { float* base = slabX + (size_t)u.sl() * XROWS * ldc + col0;
#pragma unroll
            for (int ai = 0; ai < 2; ++ai)
#pragma unroll
                for (int m = 0; m < 4; ++m) { const int r = ai * HALF + wr * 64 + m * 16 + fr; if (r < XROWS) { float* rowp = base + (size_t)r * ldc;
#pragma unroll
                    for (int bj = 0; bj < 2; ++bj) { *(f32x4*)(rowp + bj * HALF) = acc[ai][bj][m][0]; *(f32x4*)(rowp + bj * HALF + 4) = acc[ai][bj][m][1]; } } }
            return; }
        if (u.kind() == 2) { if (wc == 0 && fq < 2) { float* base = slabA + (size_t)u.sl() * 8192 * 16 + 8 * fq;
#pragma unroll
            for (int ai = 0; ai < 2; ++ai)
#pragma unroll
                for (int m = 0; m < 4; ++m) { float* p = base + (size_t)(row0 + ai * HALF + m * 16) * 16; *(f32x4*)p = acc[ai][0][m][0]; *(f32x4*)(p + 4) = acc[ai][0][m][1]; } }
            return; }
#pragma unroll
        for (int ai = 0; ai < 2; ++ai)
#pragma unroll
            for (int m = 0; m < 4; ++m) { bf16_t* rowp = O + (size_t)(row0 + ai * HALF + m * 16) * ldc + col0;
#pragma unroll
                for (int bj = 0; bj < 2; ++bj) { const f32x4 v0 = acc[ai][bj][m][0], v1 = acc[ai][bj][m][1];
                    u32x4 w; w.x = cvt_pk_bf16(v0[0], v0[1]); w.y = cvt_pk_bf16(v0[2], v0[3]); w.z = cvt_pk_bf16(v1[0], v1[1]); w.w = cvt_pk_bf16(v1[2], v1[3]);
                    *(u32x4*)(rowp + bj * HALF) = w; } }
    }
};
struct EpiResBf16 {
    static constexpr bool PERM = true, AFTER_DRAIN = false, I8 = false; typedef f32x4 acc_t;
    bf16_t* C; int ldc; const bf16_t* R; int ldr; float alpha; float* slab;
    __device__ __forceinline__ void operator()(const f32x4 (&acc)[2][2][4][2], const Unit& u, int wr, int wc, int fr, int fq) const {
        const int row0 = u.pm() * BM + wr * 64 + fr, col0 = u.pn() * BM + wc * 32 + 8 * fq;
        if (u.kind() != 0) {
#pragma unroll
            for (int m = 0; m < 4; ++m) { float* rowp = slab + ((size_t)u.sl() * 128 + wr * 64 + m * 16 + fr) * ldc + col0;
#pragma unroll
                for (int bj = 0; bj < 2; ++bj) { *(f32x4*)(rowp + bj * HALF) = acc[0][bj][m][0]; *(f32x4*)(rowp + bj * HALF + 4) = acc[0][bj][m][1]; } }
            return; }
#pragma unroll
        for (int ai = 0; ai < 2; ++ai) {
            u32x4 rvs[4][2];
#pragma unroll
            for (int m = 0; m < 4; ++m) { const bf16_t* rp = R + (size_t)(row0 + ai * HALF + m * 16) * ldr + col0; rvs[m][0] = __builtin_nontemporal_load((const u32x4*)rp); rvs[m][1] = __builtin_nontemporal_load((const u32x4*)(rp + HALF)); }
#pragma unroll
            for (int m = 0; m < 4; ++m) { const size_t row = (size_t)(row0 + ai * HALF + m * 16); bf16_t* rowp = C + row * ldc + col0;
#pragma unroll
                for (int bj = 0; bj < 2; ++bj) { const u32x4 rv = rvs[m][bj]; const f32x4 v0 = acc[ai][bj][m][0], v1 = acc[ai][bj][m][1];
                    u32x4 w; w.x = cvt_pk_bf16(v0[0] + alpha * bf_lo(rv.x), v0[1] + alpha * bf_hi(rv.x)); w.y = cvt_pk_bf16(v0[2] + alpha * bf_lo(rv.y), v0[3] + alpha * bf_hi(rv.y));
                    w.z = cvt_pk_bf16(v1[0] + alpha * bf_lo(rv.z), v1[1] + alpha * bf_hi(rv.z)); w.w = cvt_pk_bf16(v1[2] + alpha * bf_lo(rv.w), v1[3] + alpha * bf_hi(rv.w));
                    *(u32x4*)(rowp + bj * HALF) = w; } } }
    }
};
struct EpiSwiGLU {
    static constexpr bool PERM = true, AFTER_DRAIN = false, I8 = false; typedef f32x4 acc_t;
    bf16_t* O; int ldc; float* slab; int lds_;
    __device__ __forceinline__ void operator()(const f32x4 (&acc)[2][2][4][2], const Unit& u, int wr, int wc, int fr, int fq) const {
        const int row0 = u.pm() * BM + wr * 64 + fr, col0 = u.pn() * HALF + wc * 32 + 8 * fq;
        if (u.kind() != 0) {
#pragma unroll
            for (int m = 0; m < 4; ++m) { float* rowp = slab + ((size_t)u.sl() * 128 + wr * 64 + m * 16 + fr) * lds_ + u.pn() * BM + wc * 32 + 8 * fq;
#pragma unroll
                for (int bj = 0; bj < 2; ++bj) { *(f32x4*)(rowp + bj * HALF) = acc[0][bj][m][0]; *(f32x4*)(rowp + bj * HALF + 4) = acc[0][bj][m][1]; } }
            return; }
#pragma unroll
        for (int ai = 0; ai < 2; ++ai)
#pragma unroll
            for (int m = 0; m < 4; ++m) { bf16_t* rowp = O + (size_t)(row0 + ai * HALF + m * 16) * ldc + col0;
                const f32x4 g0 = acc[ai][0][m][0], g1 = acc[ai][0][m][1], u0 = acc[ai][1][m][0], u1 = acc[ai][1][m][1];
                u32x4 w; w.x = cvt_pk_bf16(silu_f(g0[0]) * u0[0], silu_f(g0[1]) * u0[1]); w.y = cvt_pk_bf16(silu_f(g0[2]) * u0[2], silu_f(g0[3]) * u0[3]);
                w.z = cvt_pk_bf16(silu_f(g1[0]) * u1[0], silu_f(g1[1]) * u1[1]); w.w = cvt_pk_bf16(silu_f(g1[2]) * u1[2], silu_f(g1[3]) * u1[3]);
                *(u32x4*)rowp = w; }
    }
};


typedef int i32x4e __attribute__((ext_vector_type(4)));
struct EpiSwiGLUi8 {
    static constexpr bool PERM = true, AFTER_DRAIN = false, I8 = true; typedef i32x4e acc_t;
    bf16_t* O; int ldc; float* slab; int lds_; const float* rs; const float* cm;
    __device__ __forceinline__ void operator()(const i32x4e (&acc)[2][2][4][2], const Unit& u, int wr, int wc, int fr, int fq) const {
        const int row0 = u.pm() * BM + wr * 64 + fr, col0 = u.pn() * HALF + wc * 32 + 8 * fq, gcol = u.pn() * BM + wc * 32 + 8 * fq;
        f32x4 cg0 = *(const f32x4*)(cm + gcol), cg1 = *(const f32x4*)(cm + gcol + 4), cu0 = *(const f32x4*)(cm + gcol + HALF), cu1 = *(const f32x4*)(cm + gcol + HALF + 4);
        cg0 *= (1.0f / 127.0f); cg1 *= (1.0f / 127.0f); cu0 *= (1.0f / 127.0f); cu1 *= (1.0f / 127.0f);
        if (u.kind() != 0) {
#pragma unroll
            for (int m = 0; m < 4; ++m) { const int r = wr * 64 + m * 16 + fr; const float s = rs[u.pm() * BM + r]; float* rowp = slab + ((size_t)u.sl() * 128 + r) * lds_ + gcol;
                const i32x4e a0 = acc[0][0][m][0], a1 = acc[0][0][m][1], b0 = acc[0][1][m][0], b1 = acc[0][1][m][1];
                *(f32x4*)(rowp) = (f32x4){(float)a0[0], (float)a0[1], (float)a0[2], (float)a0[3]} * cg0 * s; *(f32x4*)(rowp + 4) = (f32x4){(float)a1[0], (float)a1[1], (float)a1[2], (float)a1[3]} * cg1 * s;
                *(f32x4*)(rowp + HALF) = (f32x4){(float)b0[0], (float)b0[1], (float)b0[2], (float)b0[3]} * cu0 * s; *(f32x4*)(rowp + HALF + 4) = (f32x4){(float)b1[0], (float)b1[1], (float)b1[2], (float)b1[3]} * cu1 * s; }
            return; }
        float scs[2][4];
#pragma unroll
        for (int ai = 0; ai < 2; ++ai)
#pragma unroll
            for (int m = 0; m < 4; ++m) scs[ai][m] = rs[row0 + ai * HALF + m * 16];
#pragma unroll
        for (int ai = 0; ai < 2; ++ai)
#pragma unroll
            for (int m = 0; m < 4; ++m) { const int row = row0 + ai * HALF + m * 16; const float s = scs[ai][m]; bf16_t* rowp = O + (size_t)row * ldc + col0;
                const i32x4e a0 = acc[ai][0][m][0], a1 = acc[ai][0][m][1], b0 = acc[ai][1][m][0], b1 = acc[ai][1][m][1];
                const f32x4 g0 = (f32x4){(float)a0[0], (float)a0[1], (float)a0[2], (float)a0[3]} * cg0 * s, g1 = (f32x4){(float)a1[0], (float)a1[1], (float)a1[2], (float)a1[3]} * cg1 * s;
                const f32x4 u0 = (f32x4){(float)b0[0], (float)b0[1], (float)b0[2], (float)b0[3]} * cu0 * s, u1 = (f32x4){(float)b1[0], (float)b1[1], (float)b1[2], (float)b1[3]} * cu1 * s;
                const f32x4 y0 = (f32x4){silu_f(g0[0]) * u0[0], silu_f(g0[1]) * u0[1], silu_f(g0[2]) * u0[2], silu_f(g0[3]) * u0[3]}, y1 = (f32x4){silu_f(g1[0]) * u1[0], silu_f(g1[1]) * u1[1], silu_f(g1[2]) * u1[2], silu_f(g1[3]) * u1[3]};
                u32x4 w; w.x = cvt_pk_bf16(y0[0], y0[1]); w.y = cvt_pk_bf16(y0[2], y0[3]); w.z = cvt_pk_bf16(y1[0], y1[1]); w.w = cvt_pk_bf16(y1[2], y1[3]);
                *(u32x4*)rowp = w;
                }
    }
};
struct EpiResI8 {
    static constexpr bool PERM = true, AFTER_DRAIN = false, I8 = true; typedef i32x4e acc_t;
    bf16_t* C; int ldc; const bf16_t* R; int ldr; float alpha; float* slab; const float* amax; const float* cm;
    __device__ __forceinline__ void operator()(const i32x4e (&acc)[2][2][4][2], const Unit& u, int wr, int wc, int fr, int fq) const {
        const int row0 = u.pm() * BM + wr * 64 + fr, col0 = u.pn() * BM + wc * 32 + 8 * fq;
        f32x4 c00 = *(const f32x4*)(cm + col0), c01 = *(const f32x4*)(cm + col0 + 4), c10 = *(const f32x4*)(cm + col0 + HALF), c11 = *(const f32x4*)(cm + col0 + HALF + 4);
        const float k2 = 1.0f / (127.0f * 127.0f); c00 *= k2; c01 *= k2; c10 *= k2; c11 *= k2;
        if (u.kind() != 0) {
#pragma unroll
            for (int m = 0; m < 4; ++m) { const int r = wr * 64 + m * 16 + fr; const float s = amax[u.pm() * BM + r]; float* rowp = slab + ((size_t)u.sl() * 128 + r) * ldc + col0;
                const i32x4e a0 = acc[0][0][m][0], a1 = acc[0][0][m][1], b0 = acc[0][1][m][0], b1 = acc[0][1][m][1];
                *(f32x4*)(rowp) = (f32x4){(float)a0[0], (float)a0[1], (float)a0[2], (float)a0[3]} * c00 * s; *(f32x4*)(rowp + 4) = (f32x4){(float)a1[0], (float)a1[1], (float)a1[2], (float)a1[3]} * c01 * s;
                *(f32x4*)(rowp + HALF) = (f32x4){(float)b0[0], (float)b0[1], (float)b0[2], (float)b0[3]} * c10 * s; *(f32x4*)(rowp + HALF + 4) = (f32x4){(float)b1[0], (float)b1[1], (float)b1[2], (float)b1[3]} * c11 * s; }
            return; }
#pragma unroll
        for (int ai = 0; ai < 2; ++ai) {
            u32x4 rvs[4][2]; float scs[4];
#pragma unroll
            for (int m = 0; m < 4; ++m) { const size_t row = (size_t)(row0 + ai * HALF + m * 16); const bf16_t* rp = R + row * ldr + col0; scs[m] = amax[row]; rvs[m][0] = __builtin_nontemporal_load((const u32x4*)rp); rvs[m][1] = __builtin_nontemporal_load((const u32x4*)(rp + HALF)); }
#pragma unroll
            for (int m = 0; m < 4; ++m) { const size_t row = (size_t)(row0 + ai * HALF + m * 16); const float s = scs[m]; bf16_t* rowp = C + row * ldc + col0;
#pragma unroll
                for (int bj = 0; bj < 2; ++bj) { const u32x4 rv = rvs[m][bj]; const i32x4e a0 = acc[ai][bj][m][0], a1 = acc[ai][bj][m][1];
                    const f32x4 v0 = (f32x4){(float)a0[0], (float)a0[1], (float)a0[2], (float)a0[3]} * (bj ? c10 : c00) * s, v1 = (f32x4){(float)a1[0], (float)a1[1], (float)a1[2], (float)a1[3]} * (bj ? c11 : c01) * s;
                    u32x4 w; w.x = cvt_pk_bf16(v0[0] + alpha * bf_lo(rv.x), v0[1] + alpha * bf_hi(rv.x)); w.y = cvt_pk_bf16(v0[2] + alpha * bf_lo(rv.y), v0[3] + alpha * bf_hi(rv.y));
                    w.z = cvt_pk_bf16(v1[0] + alpha * bf_lo(rv.z), v1[1] + alpha * bf_hi(rv.z)); w.w = cvt_pk_bf16(v1[2] + alpha * bf_lo(rv.w), v1[3] + alpha * bf_hi(rv.w));
                    *(u32x4*)(rowp + bj * HALF) = w; } } }
    }
};

struct EpiBf16I8 {
    static constexpr bool PERM = true, AFTER_DRAIN = false, I8 = true; typedef i32x4e acc_t;
    bf16_t* O; int ldc; float* slabX; const float* rs; const float* cm; int nwrap, wrapoff;
    __device__ __forceinline__ void operator()(const i32x4e (&acc)[2][2][4][2], const Unit& u, int wr, int wc, int fr, int fq) const {
        const int row0 = u.pm() * BM + wr * 64 + fr, col0 = u.pn() * BM + wc * 32 + 8 * fq, ocol = u.pn() < nwrap ? col0 : col0 + wrapoff;
        f32x4 c00 = *(const f32x4*)(cm + col0), c01 = *(const f32x4*)(cm + col0 + 4), c10 = *(const f32x4*)(cm + col0 + HALF), c11 = *(const f32x4*)(cm + col0 + HALF + 4);
        c00 *= (1.0f / 127.0f); c01 *= (1.0f / 127.0f); c10 *= (1.0f / 127.0f); c11 *= (1.0f / 127.0f);
        if (u.kind() != 0) { float* base = slabX + (size_t)u.sl() * XROWS * ldc + col0;
#pragma unroll
            for (int ai = 0; ai < 2; ++ai)
#pragma unroll
                for (int m = 0; m < 4; ++m) { const int r = ai * HALF + wr * 64 + m * 16 + fr; if (r < XROWS) { const float s = rs[u.pm() * BM + r]; float* rowp = base + (size_t)r * ldc;
                    const i32x4e a0 = acc[ai][0][m][0], a1 = acc[ai][0][m][1], b0 = acc[ai][1][m][0], b1 = acc[ai][1][m][1];
                    *(f32x4*)(rowp) = (f32x4){(float)a0[0], (float)a0[1], (float)a0[2], (float)a0[3]} * c00 * s; *(f32x4*)(rowp + 4) = (f32x4){(float)a1[0], (float)a1[1], (float)a1[2], (float)a1[3]} * c01 * s;
                    *(f32x4*)(rowp + HALF) = (f32x4){(float)b0[0], (float)b0[1], (float)b0[2], (float)b0[3]} * c10 * s; *(f32x4*)(rowp + HALF + 4) = (f32x4){(float)b1[0], (float)b1[1], (float)b1[2], (float)b1[3]} * c11 * s; } }
            return; }
        float scs[2][4];
#pragma unroll
        for (int ai = 0; ai < 2; ++ai)
#pragma unroll
            for (int m = 0; m < 4; ++m) scs[ai][m] = rs[row0 + ai * HALF + m * 16];
#pragma unroll
        for (int ai = 0; ai < 2; ++ai)
#pragma unroll
            for (int m = 0; m < 4; ++m) { const int row = row0 + ai * HALF + m * 16; const float s = scs[ai][m]; bf16_t* rowp = O + (size_t)row * ldc + ocol;
#pragma unroll
                for (int bj = 0; bj < 2; ++bj) { const i32x4e a0 = acc[ai][bj][m][0], a1 = acc[ai][bj][m][1];
                    const f32x4 v0 = (f32x4){(float)a0[0], (float)a0[1], (float)a0[2], (float)a0[3]} * (bj ? c10 : c00) * s, v1 = (f32x4){(float)a1[0], (float)a1[1], (float)a1[2], (float)a1[3]} * (bj ? c11 : c01) * s;
                    u32x4 w; w.x = cvt_pk_bf16(v0[0], v0[1]); w.y = cvt_pk_bf16(v0[2], v0[3]); w.z = cvt_pk_bf16(v1[0], v1[1]); w.w = cvt_pk_bf16(v1[2], v1[3]);
                    *(u32x4*)(rowp + bj * HALF) = w; } }
    }
};
typedef int i32x4 __attribute__((ext_vector_type(4)));
template <bool I8> struct Mma16;
template <> struct Mma16<false> { static __device__ __forceinline__ f32x4 run(bf16x8 a, bf16x8 b, f32x4 c) { return __builtin_amdgcn_mfma_f32_16x16x32_bf16(a, b, c, 0, 0, 0); } };
template <> struct Mma16<true> { static __device__ __forceinline__ i32x4 run(bf16x8 a, bf16x8 b, i32x4 c) { return __builtin_amdgcn_mfma_i32_16x16x64_i8(__builtin_bit_cast(i32x4, a), __builtin_bit_cast(i32x4, b), c, 0, 0, 0); } };
template <bool I8, class T> __device__ __forceinline__ T mma16(bf16x8 a, bf16x8 b, T c) { return Mma16<I8>::run(a, b, c); }
struct NoSide { static constexpr int NV = 0; __device__ __forceinline__ void step() {} __device__ __forceinline__ void consume() {} };
template <class Epi, class Sched, bool ALIGN_EPI, bool SP2, class Side>
__device__ __forceinline__ void gemm_phase(PG8_LAS unsigned char* lds, const Gemm g, const Sched& S, const Epi& E, Side& sd) {
    int tid_ = g.wave * 64 + (int)__builtin_amdgcn_mbcnt_hi(~0u, __builtin_amdgcn_mbcnt_lo(~0u, 0u)); asm volatile("" : "+v"(tid_));
    const int tid = tid_, wid = __builtin_amdgcn_readfirstlane(tid >> 6), lane = tid & 63, wr = wid >> 2, wc = wid & 3, fr = lane & 15, fq = lane >> 4;
    const int K = g.K;
    unsigned voffA[2], voffB[2];
#pragma unroll
    for (int i = 0; i < 2; ++i) { int R, C; stage_rc(tid * 16 + i * 8192, R, C); const int Rb = Epi::PERM ? ((R & ~31) + perm32(R & 31)) : R;
        voffA[i] = (unsigned)(R * K + C) * 2u; voffB[i] = (unsigned)(Rb * K + C) * 2u; }
    const size_t kstep = (size_t)(BK * 2);
    const size_t hstep = (size_t)HALF * K * 2;
    const size_t tstep = 2 * hstep;
    const unsigned ldsw = (unsigned)wid * 1024u;
    const int aoff = lds_byte(wr * 64 + fr, fq * 8), boff = lds_byte(wc * 32 + fr, fq * 8);
#define PG8_SA(b, h) (((b) * 2 + (h)) * HTB)
#define PG8_SB(b, h) ((4 + (b) * 2 + (h)) * HTB)
#define PG8_STAGE(bufoff, gbase, voff) do { _Pragma("unroll") for (int _i = 0; _i < 2; ++_i) \
        __builtin_amdgcn_global_load_lds((const unsigned*)((const char*)(gbase) + (voff)[_i]), (PG8_LAS unsigned*)(lds + (bufoff) + ldsw + _i * 8192), 16, 0, 0); } while (0)
#define PG8_LDA(dst, b, h) do { _Pragma("unroll") for (int m = 0; m < 4; ++m) _Pragma("unroll") for (int k = 0; k < 2; ++k) dst[m][k] = *(const PG8_LAS bf16x8*)(lds + PG8_SA(b, h) + aoff + m * 2048 + k * 1024); } while (0)
#define PG8_LDB(dst, b, h) do { _Pragma("unroll") for (int n = 0; n < 2; ++n) _Pragma("unroll") for (int k = 0; k < 2; ++k) dst[n][k] = *(const PG8_LAS bf16x8*)(lds + PG8_SB(b, h) + boff + n * 2048 + k * 1024); } while (0)
#define PG8_MMA(ai, bj, At, Bt) do { __builtin_amdgcn_s_setprio(1); _Pragma("unroll") for (int m = 0; m < 4; ++m) _Pragma("unroll") for (int n = 0; n < 2; ++n) _Pragma("unroll") for (int k = 0; k < 2; ++k) \
        acc[ai][bj][m][n] = mma16<Epi::I8>(Bt[n][k], At[m][k], acc[ai][bj][m][n]); __builtin_amdgcn_s_setprio(0); } while (0)
#define PG8_WAIT_V(n) asm volatile("s_waitcnt vmcnt(" #n ")" ::: "memory")
#define PG8_WAIT_VS() asm volatile("s_waitcnt vmcnt(%0)" :: "n"(8 + Side::NV) : "memory")
#define PG8_WAIT_L(n) asm volatile("s_waitcnt lgkmcnt(" #n ")" ::: "memory")
#define PG8_BAR __builtin_amdgcn_s_barrier()
#define PG8_SCHED __builtin_amdgcn_sched_barrier(0)
    Unit cur, nxt; int ui = 0;
    if (!S.next(0, cur)) return;
    typedef typename Epi::acc_t acc_t;
    acc_t acc[2][2][4][2];
#pragma unroll
    for (int a = 0; a < 2; ++a)
#pragma unroll
        for (int b = 0; b < 2; ++b)
#pragma unroll
            for (int m = 0; m < 4; ++m)
#pragma unroll
                for (int n = 0; n < 2; ++n) acc[a][b][m][n] = (acc_t){0, 0, 0, 0};
    bf16x8 At[4][2], B0[2][2], B1[2][2];
    const char* cA = (const char*)g.A + (size_t)cur.pm() * tstep + (size_t)cur.k0() * kstep; const char* cB = (const char*)g.Bt + (size_t)cur.pn() * tstep + (size_t)cur.k0() * kstep;
    S.a_ready(cur);
    if constexpr (SP2) {
        PG8_STAGE(PG8_SB(0, 0), cB, voffB); PG8_STAGE(PG8_SB(0, 1), cB + hstep, voffB); PG8_STAGE(PG8_SA(0, 0), cA, voffA); PG8_STAGE(PG8_SA(0, 1), cA + hstep, voffA);
        if (wr == 1) PG8_BAR;
        PG8_WAIT_V(2); PG8_BAR;
        PG8_STAGE(PG8_SB(1, 0), cB + kstep, voffB); PG8_STAGE(PG8_SA(1, 0), cA + kstep, voffA); PG8_STAGE(PG8_SB(1, 1), cB + hstep + kstep, voffB);
        PG8_WAIT_V(6); PG8_BAR;
    } else {
        PG8_STAGE(PG8_SB(0, 0), cB, voffB); PG8_STAGE(PG8_SA(0, 0), cA, voffA); PG8_STAGE(PG8_SB(0, 1), cB + hstep, voffB); PG8_STAGE(PG8_SA(0, 1), cA + hstep, voffA);
        if (wr == 1) PG8_BAR;
        PG8_WAIT_V(4); PG8_BAR;
        PG8_STAGE(PG8_SB(1, 0), cB + kstep, voffB); PG8_STAGE(PG8_SA(1, 0), cA + kstep, voffA); PG8_STAGE(PG8_SB(1, 1), cB + hstep + kstep, voffB);
        PG8_WAIT_V(6); PG8_BAR;
    }
    for (;;) {
        const bool has_next = S.next(ui + 1, nxt);
        const char* nA = has_next ? (const char*)g.A + (size_t)nxt.pm() * tstep + (size_t)nxt.k0() * kstep : cA; const char* nB = has_next ? (const char*)g.Bt + (size_t)nxt.pn() * tstep + (size_t)nxt.k0() * kstep : cB;
        const int nt = cur.nt();
        for (int t = 0; t < nt; t += 2) {
            const bool last = (t == nt - 2);
            const char* a1 = cA + (size_t)(t + 1) * kstep;
            const char* a2 = last ? nA : cA + (size_t)(t + 2) * kstep; const char* b2 = last ? nB : cB + (size_t)(t + 2) * kstep;
            const char* a3 = a2 + kstep; const char* b3 = b2 + kstep;
            if (last && has_next) S.a_ready(nxt);
            if constexpr (SP2) {
            sd.step(); PG8_SCHED;
            PG8_LDB(B0, 0, 0); PG8_LDB(B1, 0, 1); PG8_SCHED; PG8_LDA(At, 0, 0); PG8_STAGE(PG8_SA(1, 1), a1 + hstep, voffA);
            PG8_WAIT_VS(); PG8_WAIT_L(0); PG8_BAR; PG8_MMA(0, 0, At, B0); PG8_MMA(0, 1, At, B1); PG8_BAR; PG8_SCHED;
            PG8_LDA(At, 0, 1); PG8_STAGE(PG8_SB(0, 0), b2, voffB); PG8_STAGE(PG8_SB(0, 1), b2 + hstep, voffB); PG8_STAGE(PG8_SA(0, 0), a2, voffA);
            PG8_WAIT_VS(); PG8_WAIT_L(0); PG8_BAR; PG8_MMA(1, 0, At, B0); PG8_MMA(1, 1, At, B1); PG8_BAR; PG8_SCHED;
            PG8_LDB(B0, 1, 0); PG8_LDB(B1, 1, 1); PG8_SCHED; PG8_LDA(At, 1, 0); PG8_STAGE(PG8_SA(0, 1), a2 + hstep, voffA);
            PG8_WAIT_V(8); PG8_WAIT_L(0); PG8_BAR; if constexpr (Side::NV > 0) { PG8_SCHED; sd.consume(); PG8_SCHED; }
            PG8_MMA(0, 0, At, B0); PG8_MMA(0, 1, At, B1); PG8_BAR; PG8_SCHED;
            PG8_LDA(At, 1, 1); PG8_STAGE(PG8_SB(1, 0), b3, voffB); PG8_STAGE(PG8_SB(1, 1), b3 + hstep, voffB); PG8_STAGE(PG8_SA(1, 0), a3, voffA);
            PG8_WAIT_V(8); PG8_WAIT_L(0); PG8_BAR; PG8_MMA(1, 0, At, B0); PG8_MMA(1, 1, At, B1); PG8_BAR; PG8_SCHED;
            } else {
            PG8_LDB(B0, 0, 0); PG8_SCHED; PG8_LDA(At, 0, 0); PG8_STAGE(PG8_SA(1, 1), a1 + hstep, voffA);
            PG8_WAIT_L(8); PG8_BAR; PG8_WAIT_L(0); PG8_MMA(0, 0, At, B0); PG8_BAR; PG8_SCHED;
            PG8_LDB(B1, 0, 1); PG8_STAGE(PG8_SB(0, 0), b2, voffB);
            PG8_BAR; PG8_WAIT_L(0); PG8_MMA(0, 1, At, B1); PG8_BAR;
            PG8_LDA(At, 0, 1); PG8_STAGE(PG8_SA(0, 0), a2, voffA);
            PG8_BAR; PG8_WAIT_L(0); PG8_MMA(1, 0, At, B0); PG8_BAR; PG8_SCHED;
            PG8_STAGE(PG8_SB(0, 1), b2 + hstep, voffB);
            PG8_WAIT_V(6); PG8_BAR; PG8_MMA(1, 1, At, B1); PG8_BAR;
            PG8_LDB(B0, 1, 0); PG8_SCHED; PG8_LDA(At, 1, 0); PG8_STAGE(PG8_SA(0, 1), a2 + hstep, voffA);
            PG8_WAIT_L(8); PG8_BAR; PG8_WAIT_L(0); PG8_MMA(0, 0, At, B0); PG8_BAR; PG8_SCHED;
            PG8_LDB(B1, 1, 1); PG8_STAGE(PG8_SB(1, 0), b3, voffB);
            PG8_BAR; PG8_WAIT_L(0); PG8_MMA(0, 1, At, B1); PG8_BAR;
            PG8_LDA(At, 1, 1); PG8_STAGE(PG8_SA(1, 0), a3, voffA);
            PG8_BAR; PG8_WAIT_L(0); PG8_MMA(1, 0, At, B0); PG8_BAR; PG8_SCHED;
            PG8_STAGE(PG8_SB(1, 1), b3 + hstep, voffB);
            PG8_WAIT_V(6); PG8_BAR; PG8_MMA(1, 1, At, B1); PG8_BAR;
            }
        }
        if constexpr (ALIGN_EPI) { if (wr == 0) PG8_BAR; }
        if constexpr (!Epi::AFTER_DRAIN) { int fr_ = fr, fq_ = fq; asm volatile("" : "+v"(fr_), "+v"(fq_));
            E(acc, cur, wr, wc, fr_, fq_); S.done(cur); }
        if (!has_next) break;
#pragma unroll
        for (int a = 0; a < 2; ++a)
#pragma unroll
            for (int b = 0; b < 2; ++b)
#pragma unroll
                for (int m = 0; m < 4; ++m)
#pragma unroll
                    for (int n = 0; n < 2; ++n) acc[a][b][m][n] = (acc_t){0, 0, 0, 0};
        cur = nxt; cA = nA; cB = nB; ++ui;
        if constexpr (ALIGN_EPI) { if (wr == 1) PG8_BAR; }
    }
    PG8_WAIT_V(0);
    if constexpr (!ALIGN_EPI) { if (wr == 0) PG8_BAR; }
    PG8_BAR;
    if constexpr (Epi::AFTER_DRAIN) { E.fused(acc, cur, wr, wc, fr, fq, lds, wid, lane); S.done(cur); }
#undef PG8_SA
#undef PG8_SB
#undef PG8_STAGE
#undef PG8_LDA
#undef PG8_LDB
#undef PG8_MMA
#undef PG8_WAIT_V
#undef PG8_WAIT_L
#undef PG8_WAIT_VS
#undef PG8_BAR
#undef PG8_SCHED
}
template <class Epi, class Sched, bool ALIGN_EPI = false, bool SP2 = false>
__device__ __forceinline__ void gemm_phase(PG8_LAS unsigned char* lds, const Gemm g, const Sched& S, const Epi& E) { NoSide ns; gemm_phase<Epi, Sched, ALIGN_EPI, SP2, NoSide>(lds, g, S, E, ns); }
}

#ifndef PG8_SP2
#define PG8_SP2 true
#endif
#ifndef PG8_ALIGN
#define PG8_ALIGN true
#endif
#define GAS __attribute__((address_space(1)))
#define LAS __attribute__((address_space(3)))
typedef unsigned short bf16;
typedef unsigned v4u __attribute__((ext_vector_type(4)));
typedef float f32x4 __attribute__((ext_vector_type(4)));
typedef short bf16x8 __attribute__((ext_vector_type(8)));
typedef GAS unsigned gu32;
typedef GAS unsigned long long gu64;
#define RLX_AGENT __ATOMIC_RELAXED, __HIP_MEMORY_SCOPE_AGENT
#define LDS_WAIT() asm volatile("s_waitcnt lgkmcnt(0)" ::: "memory")
#define VM_WAIT() asm volatile("s_waitcnt vmcnt(0)" ::: "memory")
__device__ __forceinline__ unsigned long long rt() { return __builtin_amdgcn_s_memrealtime(); }
__device__ __forceinline__ unsigned f2bf(float f) { unsigned u = __builtin_bit_cast(unsigned, f); return (u + 0x7fffu + ((u >> 16) & 1u)) >> 16; }
__device__ __forceinline__ unsigned pk2(float lo, float hi) { return f2bf(lo) | (f2bf(hi) << 16); }

#define XB_TMO      128
#define XB_XCNT(j)  (256  + 64 * (j))
#define XB_XSUB(j)  (1280 + 64 * (j))
#define XB_XGEN(j)  (2304 + 64 * (j))
#define XB_TOP      3328
#define XB_TOPGEN   3392
#define XCD_BAR_WORDS 3456
#define XB_SPIN_CAP (1u << 18)

__device__ __forceinline__ unsigned xb_ld(unsigned* p)              { return __hip_atomic_load(p, __ATOMIC_RELAXED, __HIP_MEMORY_SCOPE_AGENT); }
__device__ __forceinline__ unsigned xb_add(unsigned* p, unsigned v) { return __hip_atomic_fetch_add(p, v, __ATOMIC_RELAXED, __HIP_MEMORY_SCOPE_AGENT); }
__device__ __forceinline__ unsigned xb_xcc_id() { return (unsigned)__builtin_amdgcn_s_getreg((3 << 11) | 20) & 0xFu; }
#define XB_SPIN(cond, bar) do { unsigned _sp = 0; while (cond) { __builtin_amdgcn_s_sleep(1); \
    if ((++_sp & 255u) == 0u) { if (xb_ld(&(bar)[XB_TMO])) break; if (_sp > XB_SPIN_CAP) { atomicAdd(&(bar)[XB_TMO], 1u); break; } } } } while (0)

struct XcdBarrier {
    unsigned* bar; unsigned x; unsigned w;
    volatile LAS unsigned* st;
};

__device__ __forceinline__ XcdBarrier xcd_barrier_post(unsigned* bar, volatile LAS unsigned* st) {
    XcdBarrier b; b.bar = bar; b.x = xb_xcc_id(); b.st = st; b.w = (unsigned)__builtin_amdgcn_readfirstlane((int)(threadIdx.x >> 6));
    if (threadIdx.x == 0) (void)xb_add(&bar[XB_XCNT(b.x)], 1u);
    return b;
}
__device__ __forceinline__ void xcd_barrier_complete(unsigned* bar, unsigned x, unsigned& nloc, unsigned& nx) {
    const unsigned G = gridDim.x * gridDim.y * gridDim.z;
    unsigned sum, cnt, mine, sp = 0u;
    for (;;) {
        sum = 0u; cnt = 0u; mine = 0u;
#pragma unroll
        for (unsigned j = 0; j < 16; ++j) { const unsigned c = xb_ld(&bar[XB_XCNT(j)]); sum += c; cnt += (c > 0u) ? 1u : 0u; mine = (j == x) ? c : mine; }
        if (sum == G) break;
        __builtin_amdgcn_s_sleep(1);
        if ((++sp & 255u) == 0u) { if (xb_ld(&bar[XB_TMO])) break; if (sp > XB_SPIN_CAP) { atomicAdd(&bar[XB_TMO], 1u); break; } }
    }
    nloc = mine > 0u ? mine : 1u; nx = cnt > 0u ? cnt : 1u;
}

__device__ __forceinline__ void xcd_barrier(const XcdBarrier& b) {
    asm volatile("s_waitcnt vmcnt(0)" ::: "memory");
    __syncthreads();
    if (b.w == 0u && __builtin_amdgcn_mbcnt_hi(~0u, __builtin_amdgcn_mbcnt_lo(~0u, 0u)) == 0u) {
        unsigned* bar = b.bar;
        __builtin_amdgcn_s_waitcnt(0);
        unsigned nloc = b.st[0], nx = b.st[1];
        if (nloc == 0u) { xcd_barrier_complete(bar, b.x, nloc, nx); b.st[0] = nloc; b.st[1] = nx; }
        const unsigned old = xb_add(&bar[XB_XSUB(b.x)], 1u);
        const unsigned gen = old / nloc;
        if (old + 1u == (gen + 1u) * nloc) {
            __builtin_amdgcn_fence(__ATOMIC_RELEASE, "agent");
            asm volatile("s_waitcnt vmcnt(0)" ::: "memory");
            const unsigned og = xb_add(&bar[XB_TOP], 1u);
            const unsigned tg = og / nx;
            if (og + 1u == (tg + 1u) * nx) xb_add(&bar[XB_TOPGEN], 1u);
            else XB_SPIN(xb_ld(&bar[XB_TOPGEN]) == tg, bar);
            __builtin_amdgcn_fence(__ATOMIC_ACQUIRE, "agent");
            xb_add(&bar[XB_XGEN(b.x)], 1u);
            asm volatile("s_waitcnt vmcnt(0)" ::: "memory");
        } else {
            XB_SPIN(xb_ld(&bar[XB_XGEN(b.x)]) == gen, bar);
            __builtin_amdgcn_fence(__ATOMIC_ACQUIRE, "agent");
            asm volatile("s_waitcnt vmcnt(0)" ::: "memory");
        }
    }
    __syncthreads();
}

constexpr int NWAVES = 8;
constexpr int NCONV_CU = 0;
constexpr int D = 4096, NBATCH = 4, SEQ = 2048, NSAMP = 128, NMETA = 16;
constexpr int MPR = NBATCH * SEQ;
constexpr int ROW_S = MPR;
constexpr int ROW_META = MPR + NSAMP;
constexpr int MROWS = ROW_META + NMETA;
constexpr int MPAD = 8448;
constexpr int NIN = 12544;
constexpr int C_K = 0, C_V = 1024, C_CC = 3072, C_CH = 5120, C_AL = 7168, NBF = 7424, C_Q = 7424, C_G = 8448, C_CB = 10496, NI8X = 5120, NI8 = 9216;
static_assert(NBF + NI8X == 12544, "in-proj width");
constexpr int XROWS = pg8::XROWS;
constexpr int DFF = 11008, NGU = 2 * DFF;
constexpr int NH = 4, DK = 256, DV = 512, DGV = 2048, DCONV = 2048, RANK = 16, DGK = 1024;
constexpr float ALPHA = 1.18920711500272f;
constexpr float LN_EPS = 1e-5f, RMS_EPS = 1e-6f;
constexpr size_t O_YP = 0, O_YS = (size_t)MPR * D, O_GP = O_YS + (size_t)NSAMP * D, O_CP = O_GP + (size_t)NBATCH * NH * DK * DV,
                 O_GS = O_CP + (size_t)NBATCH * 2 * DCONV, O_CS = O_GS + (size_t)NSAMP * NH * DK * DV, O_END = O_CS + (size_t)NSAMP * 2 * DCONV;
constexpr size_t MiB = 1u << 20;
constexpr size_t WS_CTL = 0, CTL_ZERO_BYTES = 1 * MiB;
constexpr size_t WS_WIN = 1 * MiB;
constexpr size_t WS_WOUT = WS_WIN + 98 * MiB;
constexpr size_t WS_WGU = WS_WOUT + 32 * MiB;
constexpr size_t WS_WDN = WS_WGU + 172 * MiB;
constexpr size_t WS_H0 = WS_WDN + 86 * MiB;
constexpr size_t WS_PROJ = WS_H0 + 66 * MiB;
constexpr size_t WS_MIX = WS_PROJ + 203 * MiB;
constexpr size_t WS_OBUF = WS_MIX + 66 * MiB;
constexpr size_t WS_R = WS_OBUF + 33 * MiB;
constexpr size_t WS_SLAB = WS_R + 132 * MiB;
constexpr size_t WS_H1Q = WS_SLAB + 48 * MiB;
constexpr size_t WS_END = WS_H1Q + 34 * MiB;
constexpr size_t CTL_RS0 = 800 * 1024, CTL_CMIN = 840 * 1024;
constexpr size_t CTL_AMAX = 704 * 1024, CTL_CMDN = 768 * 1024;
constexpr size_t CTL_CMAX = 512 * 1024, CTL_RSC = 640 * 1024;
constexpr size_t SLAB_A_OFF = 24 * MiB;
static_assert((size_t)NIN * D * 2 <= 98 * MiB && (size_t)NGU * D * 2 <= 172 * MiB && (size_t)D * DFF * 2 <= 86 * MiB && (size_t)MPAD * D * 2 <= 66 * MiB && (size_t)MPAD * NIN * 2 <= 203 * MiB && (size_t)MPAD * D * 4 <= 132 * MiB, "ws map");
constexpr int CW_BAR = 4096;
constexpr int RING_OFF = 0, RING_BYTES = 131072;
constexpr int LDSCTL_OFF = RING_BYTES, MISC_OFF = LDSCTL_OFF + 320;
constexpr int LDS_BYTES = 147456;
static_assert(MISC_OFF + 128 <= LDS_BYTES, "LDS map");

__device__ __forceinline__ unsigned long long karg(int i) {
    const unsigned long long ka = (unsigned long long)__builtin_amdgcn_kernarg_segment_ptr(); unsigned long long p;
    asm volatile("s_load_dwordx2 %0, %1, %2\n\ts_waitcnt lgkmcnt(0)" : "=s"(p) : "s"(ka), "n"(i * 8) : "memory");
    return p;
}
enum { A_XP = 0, A_XS, A_SGLA, A_SCONV, A_META, A_EMBG, A_EMBB, A_WIN, A_WA2, A_BA, A_GNORM, A_CONVW, A_WOUT, A_LN1G, A_LN1B, A_WGATE, A_WUP, A_WDOWN, A_LN2G, A_LN2B, A_OUT, A_WS };
struct Frame {
    LAS unsigned char* lds;
    volatile LAS unsigned* MISC;
    gu32* ctl;
    int tid, lane, wave;
    int vcu, G;
    __device__ __forceinline__ void refresh() { int l = (int)__builtin_amdgcn_mbcnt_hi(~0u, __builtin_amdgcn_mbcnt_lo(~0u, 0u)); asm volatile("" : "+v"(l)); lane = l; tid = wave * 64 + l;   int g = G; asm volatile("" : "+s"(g)); G = g; }
    unsigned char* ws;
    template <int I> __device__ __forceinline__ const float* in() const { return (const float*)(const GAS float*)karg(I); }
    __device__ __forceinline__ float* out() const { return (float*)(GAS float*)karg(A_OUT); }
    __device__ __forceinline__ bf16* Wt_in() const { return (bf16*)(ws + WS_WIN); }
    __device__ __forceinline__ bf16* Wt_out() const { return (bf16*)(ws + WS_WOUT); }
    __device__ __forceinline__ bf16* Wt_gu() const { return (bf16*)(ws + WS_WGU); }
    __device__ __forceinline__ bf16* Wt_dn() const { return (bf16*)(ws + WS_WDN); }
    __device__ __forceinline__ bf16* h0() const { return (bf16*)(ws + WS_H0); }
    __device__ __forceinline__ bf16* proj() const { return (bf16*)(ws + WS_PROJ); }
    __device__ __forceinline__ bf16* act() const { return (bf16*)(ws + WS_PROJ); }
    __device__ __forceinline__ bf16* mix() const { return (bf16*)(ws + WS_MIX); }
    __device__ __forceinline__ bf16* h1() const { return (bf16*)(ws + WS_MIX); }
    __device__ __forceinline__ bf16* obuf() const { return (bf16*)(ws + WS_OBUF); }
    __device__ __forceinline__ bf16* R() const { return (bf16*)(ws + WS_R); }
    __device__ __forceinline__ unsigned char* gscr() const { return ws + WS_R; }
    __device__ __forceinline__ float* slab() const { return (float*)(ws + WS_SLAB); }
    __device__ __forceinline__ signed char* h1q() const { return (signed char*)(ws + WS_H1Q); }
    __device__ __forceinline__ float* cmax() const { return (float*)(ws + WS_CTL + CTL_CMAX); }
    __device__ __forceinline__ float* rsc() const { return (float*)(ws + WS_CTL + CTL_RSC); }
    __device__ __forceinline__ float* amax() const { return (float*)(ws + WS_CTL + CTL_AMAX); }
    __device__ __forceinline__ float* rs0() const { return (float*)(ws + WS_CTL + CTL_RS0); }
    __device__ __forceinline__ float* cmin() const { return (float*)(ws + WS_CTL + CTL_CMIN); }
    __device__ __forceinline__ signed char* h0q() const { return (signed char*)(ws + WS_WGU); }
    __device__ __forceinline__ signed char* Wq_in() const { return (signed char*)(ws + WS_WDN); }
    __device__ __forceinline__ float* cmdn() const { return (float*)(ws + WS_CTL + CTL_CMDN); }
    __device__ __forceinline__ signed char* actq() const { return (signed char*)(ws + WS_WIN); }
};
typedef unsigned u32x2v __attribute__((ext_vector_type(2)));
__device__ __forceinline__ float wave_sum(float v) {
#pragma unroll
    for (int o = 1; o < 64; o <<= 1) v += __shfl_xor(v, o);
    return v;
}
__device__ __forceinline__ unsigned q4(float a, float b, float c, float d, float inv) {
    int x = __float2int_rn(a * inv), y = __float2int_rn(b * inv), z = __float2int_rn(c * inv), w = __float2int_rn(d * inv);
    x = min(max(x, -127), 127); y = min(max(y, -127), 127); z = min(max(z, -127), 127); w = min(max(w, -127), 127);
    return (unsigned)(x & 0xff) | ((unsigned)(y & 0xff) << 8) | ((unsigned)(z & 0xff) << 16) | ((unsigned)(w & 0xff) << 24);
}
__device__ __forceinline__ float wave_max(float v) {
#pragma unroll
    for (int o = 1; o < 64; o <<= 1) v = fmaxf(v, __shfl_xor(v, o));
    return v;
}
__device__ __forceinline__ float bflo(unsigned w) { return __uint_as_float(w << 16); }
__device__ __forceinline__ float bfhi(unsigned w) { return __uint_as_float(w & 0xffff0000u); }
__device__ __forceinline__ float bf2f(bf16 h) { return __uint_as_float(((unsigned)h) << 16); }
__device__ __forceinline__ float silu(float a) { return a * __builtin_amdgcn_rcpf(1.0f + __builtin_amdgcn_exp2f(-1.44269504089f * a)); }
__device__ __forceinline__ float logsigmoid(float z) { return fminf(z, 0.f) - __logf(1.0f + __expf(-fabsf(z))); }
__device__ __forceinline__ void unpack8(const v4u w, float (&f)[8]) { f[0] = bflo(w.x); f[1] = bfhi(w.x); f[2] = bflo(w.y); f[3] = bfhi(w.y); f[4] = bflo(w.z); f[5] = bfhi(w.z); f[6] = bflo(w.w); f[7] = bfhi(w.w); }
__device__ __forceinline__ v4u pack8(const float (&f)[8]) { v4u w; w.x = pk2(f[0], f[1]); w.y = pk2(f[2], f[3]); w.z = pk2(f[4], f[5]); w.w = pk2(f[6], f[7]); return w; }

__device__ __forceinline__ void p0_transpose_load(f32x4 (&x)[8], const float* W, int ldw, int src_col0, int nvalid, int k0, int lane) {
    const int ng = lane & 7, kg = lane >> 3;
    const float* src = W + (size_t)(k0 + 8 * kg) * ldw + src_col0 + 4 * ng;
    if (4 * ng < nvalid) {
#pragma unroll
        for (int i = 0; i < 8; ++i) x[i] = __builtin_nontemporal_load((const f32x4*)(src + (size_t)i * ldw));
    } else {
#pragma unroll
        for (int i = 0; i < 8; ++i) x[i] = (f32x4){0.f, 0.f, 0.f, 0.f};
    }
}
__device__ __forceinline__ void p0_transpose_finish(const f32x4 (&x)[8], bf16* WT, int K, int dst_row0, int k0, int lane, unsigned* cm) {
    const int ng = lane & 7, kg = lane >> 3;
    if (cm) { f32x4 m = (f32x4){0.f, 0.f, 0.f, 0.f};
#pragma unroll
        for (int i = 0; i < 8; ++i) { m.x = fmaxf(m.x, fabsf(x[i].x)); m.y = fmaxf(m.y, fabsf(x[i].y)); m.z = fmaxf(m.z, fabsf(x[i].z)); m.w = fmaxf(m.w, fabsf(x[i].w)); }
#pragma unroll
        for (int o = 8; o < 64; o <<= 1) { m.x = fmaxf(m.x, __shfl_xor(m.x, o)); m.y = fmaxf(m.y, __shfl_xor(m.y, o)); m.z = fmaxf(m.z, __shfl_xor(m.z, o)); m.w = fmaxf(m.w, __shfl_xor(m.w, o)); }
        if (kg == 0) { unsigned* c = cm + 4 * ng; __hip_atomic_fetch_max(c + 0, __float_as_uint(m.x), __ATOMIC_RELAXED, __HIP_MEMORY_SCOPE_AGENT); __hip_atomic_fetch_max(c + 1, __float_as_uint(m.y), __ATOMIC_RELAXED, __HIP_MEMORY_SCOPE_AGENT);
            __hip_atomic_fetch_max(c + 2, __float_as_uint(m.z), __ATOMIC_RELAXED, __HIP_MEMORY_SCOPE_AGENT); __hip_atomic_fetch_max(c + 3, __float_as_uint(m.w), __ATOMIC_RELAXED, __HIP_MEMORY_SCOPE_AGENT); } }
    bf16* dst = WT + (size_t)(dst_row0 + 4 * ng) * K + k0 + 8 * kg;
    { v4u o; o.x = pk2(x[0].x, x[1].x); o.y = pk2(x[2].x, x[3].x); o.z = pk2(x[4].x, x[5].x); o.w = pk2(x[6].x, x[7].x); *(GAS v4u*)(dst) = o; }
    { v4u o; o.x = pk2(x[0].y, x[1].y); o.y = pk2(x[2].y, x[3].y); o.z = pk2(x[4].y, x[5].y); o.w = pk2(x[6].y, x[7].y); *(GAS v4u*)(dst + (size_t)K) = o; }
    { v4u o; o.x = pk2(x[0].z, x[1].z); o.y = pk2(x[2].z, x[3].z); o.z = pk2(x[4].z, x[5].z); o.w = pk2(x[6].z, x[7].z); *(GAS v4u*)(dst + (size_t)2 * K) = o; }
    { v4u o; o.x = pk2(x[0].w, x[1].w); o.y = pk2(x[2].w, x[3].w); o.z = pk2(x[4].w, x[5].w); o.w = pk2(x[6].w, x[7].w); *(GAS v4u*)(dst + (size_t)3 * K) = o; }
}
template <bool OUT_F32>
__device__ __forceinline__ void ln_row(const float* src, const float* g, const float* b, void* dst, int lane) {
    const GAS f32x4* xr = (const GAS f32x4*)src + lane;
    f32x4 v[16]; float s = 0.f;
#pragma unroll
    for (int j = 0; j < 16; ++j) { v[j] = __builtin_nontemporal_load(xr + 64 * j); s += (v[j].x + v[j].y) + (v[j].z + v[j].w); }
    const float mean = wave_sum(s) * (1.f / D); float s2 = 0.f;
#pragma unroll
    for (int j = 0; j < 16; ++j) { v[j] = v[j] - mean; s2 += (v[j].x * v[j].x + v[j].y * v[j].y) + (v[j].z * v[j].z + v[j].w * v[j].w); }
    const float rstd = 1.f / sqrtf(wave_sum(s2) * (1.f / D) + LN_EPS);
    const GAS f32x4* gr = (const GAS f32x4*)g + lane; const GAS f32x4* br = (const GAS f32x4*)b + lane;
#pragma unroll
    for (int j = 0; j < 16; ++j) { const f32x4 o = v[j] * rstd * gr[64 * j] + br[64 * j];
        if (OUT_F32) ((GAS f32x4*)dst)[lane + 64 * j] = o;
        else { u32x2v w; w.x = pk2(o.x, o.y); w.y = pk2(o.z, o.w); ((GAS u32x2v*)dst)[lane + 64 * j] = w; } }
}
template <bool OUT_F32, int NSL>
__device__ __forceinline__ void ln_row_slab_block(Frame& F, const float* slab, int r, const bf16* res, const float* g, const float* b, void* dst, signed char* dq = nullptr, float* scale = nullptr) {
    LAS float* red = (LAS float*)(F.lds);
    const int t = F.tid; float v[8];
    unpack8(*(const v4u*)(res + 8 * t), v);
#pragma unroll
    for (int e = 0; e < 8; ++e) v[e] *= ALPHA;
#pragma unroll 4
    for (int s = 0; s < NSL; ++s) { const f32x4* p = (const f32x4*)(slab + ((size_t)s * 128 + r) * D + 8 * t); const f32x4 a = p[0], c = p[1];
        v[0] += a.x; v[1] += a.y; v[2] += a.z; v[3] += a.w; v[4] += c.x; v[5] += c.y; v[6] += c.z; v[7] += c.w; }
    float s1 = 0.f;
#pragma unroll
    for (int e = 0; e < 8; ++e) s1 += v[e];
    s1 = wave_sum(s1);
    __syncthreads();
    if (F.lane == 0) red[F.wave] = s1;
    __syncthreads();
    float tot = 0.f;
#pragma unroll
    for (int w = 0; w < 8; ++w) tot += red[w];
    const float mean = tot * (1.f / D); float s2 = 0.f;
#pragma unroll
    for (int e = 0; e < 8; ++e) { v[e] -= mean; s2 += v[e] * v[e]; }
    s2 = wave_sum(s2);
    if (F.lane == 0) red[8 + F.wave] = s2;
    __syncthreads();
    float tot2 = 0.f;
#pragma unroll
    for (int w = 0; w < 8; ++w) tot2 += red[8 + w];
    const float rstd = 1.f / sqrtf(tot2 * (1.f / D) + LN_EPS);
    const f32x4* gp = (const f32x4*)(g + 8 * t); const f32x4* bp = (const f32x4*)(b + 8 * t); const f32x4 g0 = gp[0], g1 = gp[1], b0 = bp[0], b1 = bp[1];
    float o[8]; o[0] = v[0] * rstd * g0.x + b0.x; o[1] = v[1] * rstd * g0.y + b0.y; o[2] = v[2] * rstd * g0.z + b0.z; o[3] = v[3] * rstd * g0.w + b0.w;
    o[4] = v[4] * rstd * g1.x + b1.x; o[5] = v[5] * rstd * g1.y + b1.y; o[6] = v[6] * rstd * g1.z + b1.z; o[7] = v[7] * rstd * g1.w + b1.w;
    if (OUT_F32) { f32x4* op = (f32x4*)((float*)dst + 8 * t); op[0] = (f32x4){o[0], o[1], o[2], o[3]}; op[1] = (f32x4){o[4], o[5], o[6], o[7]}; }
    else { *(v4u*)((bf16*)dst + 8 * t) = pack8(o);
        if (dq) {
            float mx = 0.f;
#pragma unroll
            for (int e = 0; e < 8; ++e) mx = fmaxf(mx, fabsf(o[e]));
            mx = wave_max(mx);
            __syncthreads();
            if (F.lane == 0) red[F.wave] = mx;
            __syncthreads();
            float tm = 0.f;
#pragma unroll
            for (int w = 0; w < 8; ++w) tm = fmaxf(tm, red[w]);
            const float inv = tm > 0.f ? 127.0f / tm : 0.f;
            if (t == 0) *scale = tm * (1.0f / 127.0f);
            u32x2v q; q.x = q4(o[0], o[1], o[2], o[3], inv); q.y = q4(o[4], o[5], o[6], o[7], inv); *(u32x2v*)(dq + 8 * t) = q; } }
}
constexpr int LDS_GB = 65536;
__device__ __forceinline__ void stage_gb(Frame& F, const float* g, const float* b) {
    LAS f32x4* Lg = (LAS f32x4*)(F.lds + LDS_GB); __syncthreads();
    for (int i = F.tid; i < D / 4; i += NWAVES * 64) { Lg[i] = ((const GAS f32x4*)(const GAS float*)g)[i]; Lg[D / 4 + i] = ((const GAS f32x4*)(const GAS float*)b)[i]; }
    __syncthreads(); }
template <bool OUT_F32>
__device__ __forceinline__ void ln_row_b16(const bf16* src, const LAS f32x4* Lg, void* dst, int lane) {
    const GAS v4u* xr = (const GAS v4u*)src + lane;
    float v[8][8]; float s = 0.f;
#pragma unroll
    for (int j = 0; j < 8; ++j) { unpack8(__builtin_nontemporal_load(xr + 64 * j), v[j]);
#pragma unroll
        for (int e = 0; e < 8; ++e) s += v[j][e]; }
    const float mean = wave_sum(s) * (1.f / D); float s2 = 0.f;
#pragma unroll
    for (int j = 0; j < 8; ++j)
#pragma unroll
        for (int e = 0; e < 8; ++e) { v[j][e] -= mean; s2 += v[j][e] * v[j][e]; }
    const float rstd = 1.f / sqrtf(wave_sum(s2) * (1.f / D) + LN_EPS);
#pragma unroll
    for (int j = 0; j < 8; ++j) { const int c0 = 8 * (lane + 64 * j); const LAS f32x4* gp = Lg + c0 / 4; const f32x4 g0 = gp[0], g1 = gp[1], b0 = gp[D / 4], b1 = gp[D / 4 + 1];
        float o[8]; o[0] = v[j][0] * rstd * g0.x + b0.x; o[1] = v[j][1] * rstd * g0.y + b0.y; o[2] = v[j][2] * rstd * g0.z + b0.z; o[3] = v[j][3] * rstd * g0.w + b0.w;
        o[4] = v[j][4] * rstd * g1.x + b1.x; o[5] = v[j][5] * rstd * g1.y + b1.y; o[6] = v[j][6] * rstd * g1.z + b1.z; o[7] = v[j][7] * rstd * g1.w + b1.w;
        if (OUT_F32) { GAS f32x4* op = (GAS f32x4*)((float*)dst + c0); op[0] = (f32x4){o[0], o[1], o[2], o[3]}; op[1] = (f32x4){o[4], o[5], o[6], o[7]}; }
        else *(GAS v4u*)((bf16*)dst + c0) = pack8(o); }
}
constexpr int NB_IN = NBF / 32 - 7, NB_ALL = NB_IN + NI8X / 32, I_IN = 64 * NB_IN, NB_OUT = 128, I_OUT = 64 * NB_OUT, NB_GU = NGU / 32, I_GU = 64 * NB_GU, NB_DN = 128, I_DN = (DFF / 64) * NB_DN;
__device__ __forceinline__ void ln0_row_quant(const float* src, const LAS f32x4* Lg, bf16* dst, signed char* dq, float* scale, int lane) {
    const GAS f32x4* xr = (const GAS f32x4*)src + lane;
    f32x4 v[16]; float s = 0.f;
#pragma unroll
    for (int j = 0; j < 16; ++j) { v[j] = __builtin_nontemporal_load(xr + 64 * j); s += (v[j].x + v[j].y) + (v[j].z + v[j].w); }
    const float mean = wave_sum(s) * (1.f / D); float s2 = 0.f;
#pragma unroll
    for (int j = 0; j < 16; ++j) { v[j] = v[j] - mean; s2 += (v[j].x * v[j].x + v[j].y * v[j].y) + (v[j].z * v[j].z + v[j].w * v[j].w); }
    const float rstd = 1.f / sqrtf(wave_sum(s2) * (1.f / D) + LN_EPS); float mx = 0.f;
    const LAS f32x4* gr = Lg + lane; const LAS f32x4* br = Lg + D / 4 + lane;
#pragma unroll
    for (int j = 0; j < 16; ++j) { v[j] = v[j] * rstd * gr[64 * j] + br[64 * j]; mx = fmaxf(mx, fmaxf(fmaxf(fabsf(v[j].x), fabsf(v[j].y)), fmaxf(fabsf(v[j].z), fabsf(v[j].w))));
        u32x2v w; w.x = pk2(v[j].x, v[j].y); w.y = pk2(v[j].z, v[j].w); ((GAS u32x2v*)dst)[lane + 64 * j] = w; }
    mx = wave_max(mx); const float inv = mx > 0.f ? 127.0f / mx : 0.f;
    if (lane == 0) *scale = mx * (1.0f / 127.0f);
#pragma unroll
    for (int j = 0; j < 16; ++j) ((GAS unsigned*)dq)[lane + 64 * j] = q4(v[j].x, v[j].y, v[j].z, v[j].w, inv);
}
__device__ __forceinline__ int src_col_i8(int lc) { return lc < 1024 ? lc : (lc < 3072 ? lc + 3072 : lc + 3088); }
constexpr int CI_ITEMS_X = (NI8X / 256) * (D / 64), CI_ITEMS = (NI8 / 256) * (D / 64), QI_NB = NI8 / 32, QI_ITEMS = QI_NB * (D / 128);
__device__ __forceinline__ void p0_prologue(Frame& F) {
    const int gw = F.vcu * NWAVES + F.wave, NGW = F.G * NWAVES;
    const float* w_in = F.in<A_WIN>();
    for (int r0 = gw; r0 < 64 * NB_ALL; r0 += 2 * NGW) { f32x4 xa[8], xb[8]; int n0s[2], kbs[2]; unsigned* cms[2]; const bool two = r0 + NGW < 64 * NB_ALL;
#pragma unroll
        for (int q = 0; q < 2; ++q) { const int r = (q && two) ? r0 + NGW : r0, kb = r / NB_ALL, nb = r % NB_ALL, n0 = nb < NB_IN ? 32 * nb : NBF + 32 * (nb - NB_IN);
            int src = n0 < C_CC ? n0 + 1024 : (n0 < C_AL ? n0 + 5136 : src_col_i8(n0 - NBF)), nv = 32; if (nb == NB_IN - 1) { src = 6144; nv = 16; }
            cms[q] = n0 >= NBF ? (unsigned*)F.cmin() + (n0 - NBF) : ((n0 >= C_CC && n0 < C_AL) ? (unsigned*)F.cmin() + NI8X + (n0 - C_CC) : nullptr); n0s[q] = n0; kbs[q] = kb;
            if (q == 0) p0_transpose_load(xa, w_in, 12304, src, nv, 64 * kb, F.lane); else p0_transpose_load(xb, w_in, 12304, src, nv, 64 * kb, F.lane); }
        p0_transpose_finish(xa, F.Wt_in(), D, n0s[0], 64 * kbs[0], F.lane, cms[0]);
        if (two) p0_transpose_finish(xb, F.Wt_in(), D, n0s[1], 64 * kbs[1], F.lane, cms[1]); }
    const float *x_prompt = F.in<A_XP>(), *x_sample = F.in<A_XS>(), *meta = F.in<A_META>(), *emb_g = F.in<A_EMBG>(), *emb_b = F.in<A_EMBB>();
    stage_gb(F, emb_g, emb_b);
    for (int m = gw; m < MROWS + 2 * NBATCH; m += NGW) {
        const float* src = m < ROW_S ? x_prompt + (size_t)m * D : (m < ROW_META ? x_sample + (size_t)(m - ROW_S) * D : (m < MROWS ? meta + (size_t)(m - ROW_META) * D : x_prompt + (size_t)(((m - MROWS) >> 1) * SEQ + SEQ - 2 + ((m - MROWS) & 1)) * D));
        ln0_row_quant(src, (const LAS f32x4*)(F.lds + LDS_GB), F.h0() + (size_t)m * D, F.h0q() + (size_t)m * D, F.rs0() + m, F.lane);
    }
}
__device__ __forceinline__ void quant_in_pass(Frame& F, int gw, int ngw) {
    const float* cm = F.cmin(); signed char* Wq = F.Wq_in(); const bf16* Wt = F.Wt_in(); const int lane = F.lane;
    for (int p = gw; p < NI8 / 2; p += ngw) { v4u x[2][8]; float inv[2];
#pragma unroll
        for (int rr = 0; rr < 2; ++rr) { const int lc = 2 * p + rr, srow = lc < NI8X ? NBF + lc : C_CC + (lc - NI8X); const GAS v4u* sp = (const GAS v4u*)(const GAS bf16*)(Wt + (size_t)srow * D) + lane;
#pragma unroll
            for (int j = 0; j < 8; ++j) x[rr][j] = __builtin_nontemporal_load(sp + 64 * j);
            const float c = cm[lc]; inv[rr] = c > 0.f ? 127.0f / c : 0.f; }
#pragma unroll
        for (int rr = 0; rr < 2; ++rr) { GAS u32x2v* dp = (GAS u32x2v*)(GAS signed char*)(Wq + (size_t)(2 * p + rr) * D) + lane;
#pragma unroll
            for (int j = 0; j < 8; ++j) { float f[8]; unpack8(x[rr][j], f); u32x2v q; q.x = q4(f[0], f[1], f[2], f[3], inv[rr]); q.y = q4(f[4], f[5], f[6], f[7], inv[rr]); dp[64 * j] = q; } } }
}
struct CvItem { const float* src; bf16* dst; int ldw, K; };
__device__ __forceinline__ CvItem cv_decode(Frame& F, int it, const float* w_out, const float* w_gate, const float* w_up, const float* w_down, int lane) {
    const int ng = lane & 7, kg = lane >> 3; CvItem c; int r = it;
    if (r < I_OUT) { const int kb = r / NB_OUT, nb = r % NB_OUT; c.ldw = D; c.K = D; c.src = w_out + (size_t)(64 * kb + 8 * kg) * D + 32 * nb + 4 * ng; c.dst = F.Wt_out() + (size_t)(32 * nb + 4 * ng) * D + 64 * kb + 8 * kg; return c; } r -= I_OUT;
    if (r < I_GU) { const int kb = r / NB_GU, nb = r % NB_GU, n0 = 32 * nb, pn = n0 >> 8, cc = n0 & 255; c.ldw = DFF; c.K = D;
        c.src = (cc < 128 ? w_gate : w_up) + (size_t)(64 * kb + 8 * kg) * DFF + 128 * pn + (cc & 127) + 4 * ng; c.dst = F.Wt_gu() + (size_t)(n0 + 4 * ng) * D + 64 * kb + 8 * kg; return c; } r -= I_GU;
    { const int kb = r / NB_DN, nb = r % NB_DN; c.ldw = D; c.K = DFF; c.src = w_down + (size_t)(64 * kb + 8 * kg) * D + 32 * nb + 4 * ng; c.dst = F.Wt_dn() + (size_t)(32 * nb + 4 * ng) * DFF + 64 * kb + 8 * kg; return c; }
}
__device__ __forceinline__ void cv_store(const CvItem& c, const f32x4 (&x)[8]) {
    { v4u o; o.x = pk2(x[0].x, x[1].x); o.y = pk2(x[2].x, x[3].x); o.z = pk2(x[4].x, x[5].x); o.w = pk2(x[6].x, x[7].x); __builtin_nontemporal_store(o, (GAS v4u*)(c.dst)); }
    { v4u o; o.x = pk2(x[0].y, x[1].y); o.y = pk2(x[2].y, x[3].y); o.z = pk2(x[4].y, x[5].y); o.w = pk2(x[6].y, x[7].y); __builtin_nontemporal_store(o, (GAS v4u*)(c.dst + (size_t)c.K)); }
    { v4u o; o.x = pk2(x[0].z, x[1].z); o.y = pk2(x[2].z, x[3].z); o.z = pk2(x[4].z, x[5].z); o.w = pk2(x[6].z, x[7].z); __builtin_nontemporal_store(o, (GAS v4u*)(c.dst + (size_t)2 * c.K)); }
    { v4u o; o.x = pk2(x[0].w, x[1].w); o.y = pk2(x[2].w, x[3].w); o.z = pk2(x[4].w, x[5].w); o.w = pk2(x[6].w, x[7].w); __builtin_nontemporal_store(o, (GAS v4u*)(c.dst + (size_t)3 * c.K)); }
}
__device__ __forceinline__ void convert_rest(Frame& F, int gw, int ngw, int it_lo, int it_hi) {
    const float *w_out = F.in<A_WOUT>(), *w_gate = F.in<A_WGATE>(), *w_up = F.in<A_WUP>(), *w_down = F.in<A_WDOWN>();
    const int NIT = it_hi;
    for (int it = it_lo + gw; it < NIT; it += 2 * ngw) {
        const CvItem a = cv_decode(F, it, w_out, w_gate, w_up, w_down, F.lane); const bool two = it + ngw < NIT;
        const CvItem b = cv_decode(F, two ? it + ngw : it, w_out, w_gate, w_up, w_down, F.lane);
        f32x4 xa[8], xb[8];
#pragma unroll
        for (int i = 0; i < 8; ++i) xa[i] = __builtin_nontemporal_load((const f32x4*)(a.src + (size_t)i * a.ldw));
#pragma unroll
        for (int i = 0; i < 8; ++i) xb[i] = __builtin_nontemporal_load((const f32x4*)(b.src + (size_t)i * b.ldw));
        cv_store(a, xa);
        if (two) cv_store(b, xb);
    }
}

constexpr int CM_STRIPS = DFF / 256, CM_KR = D / 64, CM_ITEMS = 2 * CM_STRIPS * CM_KR;
__device__ __forceinline__ void colmax_pass(Frame& F, int gw, int ngw) {
    const float *w_gate = F.in<A_WGATE>(), *w_up = F.in<A_WUP>(); unsigned* cm = (unsigned*)F.cmax();
    for (int it = gw; it < CM_ITEMS; it += ngw) { const int kr = it % CM_KR, sm = it / CM_KR, strip = sm % CM_STRIPS, mat = sm / CM_STRIPS, c0 = 256 * strip + 4 * F.lane;
        const float* src = (mat ? w_up : w_gate) + (size_t)(64 * kr) * DFF + c0; f32x4 m = (f32x4){0.f, 0.f, 0.f, 0.f};
#pragma unroll
        for (int b = 0; b < 4; ++b) { f32x4 x[16];
#pragma unroll
            for (int i = 0; i < 16; ++i) x[i] = *(const f32x4*)(src + (size_t)(16 * b + i) * DFF);
#pragma unroll
            for (int i = 0; i < 16; ++i) { m.x = fmaxf(m.x, fabsf(x[i].x)); m.y = fmaxf(m.y, fabsf(x[i].y)); m.z = fmaxf(m.z, fabsf(x[i].z)); m.w = fmaxf(m.w, fabsf(x[i].w)); } }
        const int gc = 256 * (c0 >> 7) + (mat ? 128 : 0) + (c0 & 127);
        __hip_atomic_fetch_max(cm + gc + 0, __float_as_uint(m.x), __ATOMIC_RELAXED, __HIP_MEMORY_SCOPE_AGENT); __hip_atomic_fetch_max(cm + gc + 1, __float_as_uint(m.y), __ATOMIC_RELAXED, __HIP_MEMORY_SCOPE_AGENT);
        __hip_atomic_fetch_max(cm + gc + 2, __float_as_uint(m.z), __ATOMIC_RELAXED, __HIP_MEMORY_SCOPE_AGENT); __hip_atomic_fetch_max(cm + gc + 3, __float_as_uint(m.w), __ATOMIC_RELAXED, __HIP_MEMORY_SCOPE_AGENT); }
}
constexpr int WQ_NB = NGU / 32, WQ_KB = D / 128, WQ_ITEMS = WQ_NB * WQ_KB;
__device__ __forceinline__ void quant_gu_pass(Frame& F, int gw, int ngw) {
    const float *w_gate = F.in<A_WGATE>(), *w_up = F.in<A_WUP>(); const float* cm = F.cmax(); signed char* Wq = (signed char*)F.Wt_gu();
    const int ng = F.lane & 7, kg = F.lane >> 3;
    for (int it = gw; it < WQ_ITEMS; it += ngw) { const int kb = it / WQ_NB, nb = it % WQ_NB, n0 = 32 * nb, pn = n0 >> 8, cc = n0 & 255, k0 = 128 * kb;
        const float* src = (cc < 128 ? w_gate : w_up) + (size_t)(k0 + 16 * kg) * DFF + 128 * pn + (cc & 127) + 4 * ng;
        f32x4 x[16];
#pragma unroll
        for (int i = 0; i < 16; ++i) x[i] = __builtin_nontemporal_load((const f32x4*)(src + (size_t)i * DFF));
        const f32x4 c4 = *(const f32x4*)(cm + n0 + 4 * ng);
        const float i0 = c4.x > 0.f ? 127.0f / c4.x : 0.f, i1 = c4.y > 0.f ? 127.0f / c4.y : 0.f, i2 = c4.z > 0.f ? 127.0f / c4.z : 0.f, i3 = c4.w > 0.f ? 127.0f / c4.w : 0.f;
        signed char* dst = Wq + (size_t)(n0 + 4 * ng) * D + k0 + 16 * kg;
        { v4u o; o.x = q4(x[0].x, x[1].x, x[2].x, x[3].x, i0); o.y = q4(x[4].x, x[5].x, x[6].x, x[7].x, i0); o.z = q4(x[8].x, x[9].x, x[10].x, x[11].x, i0); o.w = q4(x[12].x, x[13].x, x[14].x, x[15].x, i0); *(GAS v4u*)(dst) = o; }
        { v4u o; o.x = q4(x[0].y, x[1].y, x[2].y, x[3].y, i1); o.y = q4(x[4].y, x[5].y, x[6].y, x[7].y, i1); o.z = q4(x[8].y, x[9].y, x[10].y, x[11].y, i1); o.w = q4(x[12].y, x[13].y, x[14].y, x[15].y, i1); *(GAS v4u*)(dst + (size_t)D) = o; }
        { v4u o; o.x = q4(x[0].z, x[1].z, x[2].z, x[3].z, i2); o.y = q4(x[4].z, x[5].z, x[6].z, x[7].z, i2); o.z = q4(x[8].z, x[9].z, x[10].z, x[11].z, i2); o.w = q4(x[12].z, x[13].z, x[14].z, x[15].z, i2); *(GAS v4u*)(dst + (size_t)2 * D) = o; }
        { v4u o; o.x = q4(x[0].w, x[1].w, x[2].w, x[3].w, i3); o.y = q4(x[4].w, x[5].w, x[6].w, x[7].w, i3); o.z = q4(x[8].w, x[9].w, x[10].w, x[11].w, i3); o.w = q4(x[12].w, x[13].w, x[14].w, x[15].w, i3); *(GAS v4u*)(dst + (size_t)3 * D) = o; } }
}
constexpr int CD_STRIPS = D / 256, CD_KR = DFF / 64, CD_ITEMS = CD_STRIPS * CD_KR;
__device__ __forceinline__ void colmax_dn_pass(Frame& F, int gw, int ngw) {
    const float* w_down = F.in<A_WDOWN>(); unsigned* cm = (unsigned*)F.cmdn();
    for (int it = gw; it < CD_ITEMS; it += ngw) { const int kr = it % CD_KR, strip = it / CD_KR, c0 = 256 * strip + 4 * F.lane;
        const float* src = w_down + (size_t)(64 * kr) * D + c0; f32x4 m = (f32x4){0.f, 0.f, 0.f, 0.f};
#pragma unroll
        for (int b = 0; b < 4; ++b) { f32x4 x[16];
#pragma unroll
            for (int i = 0; i < 16; ++i) x[i] = *(const f32x4*)(src + (size_t)(16 * b + i) * D);
#pragma unroll
            for (int i = 0; i < 16; ++i) { m.x = fmaxf(m.x, fabsf(x[i].x)); m.y = fmaxf(m.y, fabsf(x[i].y)); m.z = fmaxf(m.z, fabsf(x[i].z)); m.w = fmaxf(m.w, fabsf(x[i].w)); } }
        __hip_atomic_fetch_max(cm + c0 + 0, __float_as_uint(m.x), __ATOMIC_RELAXED, __HIP_MEMORY_SCOPE_AGENT); __hip_atomic_fetch_max(cm + c0 + 1, __float_as_uint(m.y), __ATOMIC_RELAXED, __HIP_MEMORY_SCOPE_AGENT);
        __hip_atomic_fetch_max(cm + c0 + 2, __float_as_uint(m.z), __ATOMIC_RELAXED, __HIP_MEMORY_SCOPE_AGENT); __hip_atomic_fetch_max(cm + c0 + 3, __float_as_uint(m.w), __ATOMIC_RELAXED, __HIP_MEMORY_SCOPE_AGENT); }
}
constexpr int WD_NB = D / 32, WD_KB = DFF / 128, WD_ITEMS = WD_NB * WD_KB;
__device__ __forceinline__ void quant_dn_pass(Frame& F, int gw, int ngw) {
    const float* w_down = F.in<A_WDOWN>(); const float* cm = F.cmdn(); signed char* Wq = (signed char*)F.Wt_dn();
    const int ng = F.lane & 7, kg = F.lane >> 3;
    for (int it = gw; it < WD_ITEMS; it += ngw) { const int kb = it / WD_NB, nb = it % WD_NB, n0 = 32 * nb, k0 = 128 * kb;
        const float* src = w_down + (size_t)(k0 + 16 * kg) * D + n0 + 4 * ng;
        f32x4 x[16];
#pragma unroll
        for (int i = 0; i < 16; ++i) x[i] = __builtin_nontemporal_load((const f32x4*)(src + (size_t)i * D));
        const f32x4 c4 = *(const f32x4*)(cm + n0 + 4 * ng);
        const float i0 = c4.x > 0.f ? 127.0f / c4.x : 0.f, i1 = c4.y > 0.f ? 127.0f / c4.y : 0.f, i2 = c4.z > 0.f ? 127.0f / c4.z : 0.f, i3 = c4.w > 0.f ? 127.0f / c4.w : 0.f;
        signed char* dst = Wq + (size_t)(n0 + 4 * ng) * DFF + k0 + 16 * kg;
        { v4u o; o.x = q4(x[0].x, x[1].x, x[2].x, x[3].x, i0); o.y = q4(x[4].x, x[5].x, x[6].x, x[7].x, i0); o.z = q4(x[8].x, x[9].x, x[10].x, x[11].x, i0); o.w = q4(x[12].x, x[13].x, x[14].x, x[15].x, i0); *(GAS v4u*)(dst) = o; }
        { v4u o; o.x = q4(x[0].y, x[1].y, x[2].y, x[3].y, i1); o.y = q4(x[4].y, x[5].y, x[6].y, x[7].y, i1); o.z = q4(x[8].y, x[9].y, x[10].y, x[11].y, i1); o.w = q4(x[12].y, x[13].y, x[14].y, x[15].y, i1); *(GAS v4u*)(dst + (size_t)DFF) = o; }
        { v4u o; o.x = q4(x[0].z, x[1].z, x[2].z, x[3].z, i2); o.y = q4(x[4].z, x[5].z, x[6].z, x[7].z, i2); o.z = q4(x[8].z, x[9].z, x[10].z, x[11].z, i2); o.w = q4(x[12].z, x[13].z, x[14].z, x[15].z, i2); *(GAS v4u*)(dst + (size_t)2 * DFF) = o; }
        { v4u o; o.x = q4(x[0].w, x[1].w, x[2].w, x[3].w, i3); o.y = q4(x[4].w, x[5].w, x[6].w, x[7].w, i3); o.z = q4(x[8].w, x[9].w, x[10].w, x[11].w, i3); o.w = q4(x[12].w, x[13].w, x[14].w, x[15].w, i3); *(GAS v4u*)(dst + (size_t)3 * DFF) = o; } }
}
__device__ __forceinline__ void act_row_quant(Frame& F, int row, int lane) {
    const GAS v4u* src = (const GAS v4u*)(F.act() + (size_t)row * DFF) + lane; GAS u32x2v* dst = (GAS u32x2v*)(F.actq() + (size_t)row * DFF) + lane;
    v4u x[22]; float mx = 0.f;
#pragma unroll
    for (int i = 0; i < 21; ++i) x[i] = __builtin_nontemporal_load(src + 64 * i);
    x[21] = (lane + 64 * 21 < DFF / 8) ? __builtin_nontemporal_load(src + 64 * 21) : (v4u){0u, 0u, 0u, 0u};
#pragma unroll
    for (int i = 0; i < 22; ++i) { mx = fmaxf(mx, fmaxf(fmaxf(fabsf(bflo(x[i].x)), fabsf(bfhi(x[i].x))), fmaxf(fabsf(bflo(x[i].y)), fabsf(bfhi(x[i].y)))));
        mx = fmaxf(mx, fmaxf(fmaxf(fabsf(bflo(x[i].z)), fabsf(bfhi(x[i].z))), fmaxf(fabsf(bflo(x[i].w)), fabsf(bfhi(x[i].w))))); }
    mx = wave_max(mx); const float inv = mx > 0.f ? 127.0f / mx : 0.f;
    if (lane == 0) F.amax()[row] = mx;
#pragma unroll
    for (int i = 0; i < 22; ++i) if (lane + 64 * i < DFF / 8) { u32x2v q; q.x = q4(bflo(x[i].x), bfhi(x[i].x), bflo(x[i].y), bfhi(x[i].y), inv); q.y = q4(bflo(x[i].z), bfhi(x[i].z), bflo(x[i].w), bfhi(x[i].w), inv); dst[64 * i] = q; }
}
__device__ __forceinline__ void ln1_row_quant(const bf16* src, const LAS f32x4* Lg, bf16* dst, signed char* dq, float* scale, int lane) {
    const GAS v4u* xr = (const GAS v4u*)src + lane;
    float v[8][8]; float s = 0.f;
#pragma unroll
    for (int j = 0; j < 8; ++j) { unpack8(__builtin_nontemporal_load(xr + 64 * j), v[j]);
#pragma unroll
        for (int e = 0; e < 8; ++e) s += v[j][e]; }
    const float mean = wave_sum(s) * (1.f / D); float s2 = 0.f;
#pragma unroll
    for (int j = 0; j < 8; ++j)
#pragma unroll
        for (int e = 0; e < 8; ++e) { v[j][e] -= mean; s2 += v[j][e] * v[j][e]; }
    const float rstd = 1.f / sqrtf(wave_sum(s2) * (1.f / D) + LN_EPS); float mx = 0.f;
#pragma unroll
    for (int j = 0; j < 8; ++j) { const int c0 = 8 * (lane + 64 * j); const LAS f32x4* gp = Lg + c0 / 4; const f32x4 g0 = gp[0], g1 = gp[1], b0 = gp[D / 4], b1 = gp[D / 4 + 1];
        v[j][0] = v[j][0] * rstd * g0.x + b0.x; v[j][1] = v[j][1] * rstd * g0.y + b0.y; v[j][2] = v[j][2] * rstd * g0.z + b0.z; v[j][3] = v[j][3] * rstd * g0.w + b0.w;
        v[j][4] = v[j][4] * rstd * g1.x + b1.x; v[j][5] = v[j][5] * rstd * g1.y + b1.y; v[j][6] = v[j][6] * rstd * g1.z + b1.z; v[j][7] = v[j][7] * rstd * g1.w + b1.w;
#pragma unroll
        for (int e = 0; e < 8; ++e) mx = fmaxf(mx, fabsf(v[j][e]));
        __builtin_nontemporal_store(pack8(v[j]), (GAS v4u*)(dst + c0)); }
    mx = wave_max(mx); const float inv = mx > 0.f ? 127.0f / mx : 0.f;
    if (lane == 0) *scale = mx * (1.0f / 127.0f);
#pragma unroll
    for (int j = 0; j < 8; ++j) { u32x2v q; q.x = q4(v[j][0], v[j][1], v[j][2], v[j][3], inv); q.y = q4(v[j][4], v[j][5], v[j][6], v[j][7], inv); *(GAS u32x2v*)(dq + 8 * (lane + 64 * j)) = q; }
}

__device__ __forceinline__ void gla_sample_item(Frame& F, int it, const float* w_a2, const float* b_a, const float* state_gla, float* out) {
    const int n = it >> 2, h = it & 3, row = ROW_S + n, t = F.tid;
    LAS float* Aa = (LAS float*)(F.lds); LAS float* Kk = Aa + 256; LAS float* Qq = Aa + 512; LAS float* Ored = Aa + 768;
    const bf16* prow = F.proj() + (size_t)row * NIN;
    __syncthreads();
    if (t < 256) { const int d = t; float z = b_a[h * DK + d];
#pragma unroll
        for (int r = 0; r < 16; ++r) z += bf2f(prow[C_AL + r]) * w_a2[r * DGK + h * DK + d];
        Aa[d] = __expf(logsigmoid(z) * 0.0625f); Kk[d] = bf2f(prow[C_K + h * DK + d]); Qq[d] = bf2f(prow[C_Q + h * DK + d]) * 0.0625f; }
    __syncthreads();
    const int cg = t & 127, rg = t >> 7;
    const u32x2v vw = *(const u32x2v*)(prow + C_V + h * DV + 4 * cg);
    const f32x4 v4 = (f32x4){bflo(vw.x), bfhi(vw.x), bflo(vw.y), bfhi(vw.y)};
    const f32x4* S0 = (const f32x4*)(state_gla + (size_t)(n * NH + h) * DK * DV) + cg;
    f32x4* S1 = (f32x4*)(out + O_GS + (size_t)(n * NH + h) * DK * DV) + cg;
    f32x4 o4 = (f32x4){0.f, 0.f, 0.f, 0.f};
    for (int i0 = 0; i0 < 64; i0 += 16) {
        f32x4 s[16];
#pragma unroll
        for (int k = 0; k < 16; ++k) s[k] = __builtin_nontemporal_load(S0 + (size_t)(rg * 64 + i0 + k) * 128);
#pragma unroll
        for (int k = 0; k < 16; ++k) { const int d = rg * 64 + i0 + k; s[k] = s[k] * Aa[d] + v4 * Kk[d]; __builtin_nontemporal_store(s[k], S1 + (size_t)d * 128); o4 += s[k] * Qq[d]; }
    }
    *(LAS f32x4*)(Ored + rg * 512 + 4 * cg) = o4;
    __syncthreads();
    { const float o = (Ored[t] + Ored[512 + t]) + (Ored[1024 + t] + Ored[1536 + t]); F.obuf()[(size_t)row * DGV + h * DV + t] = (bf16)f2bf(o); }
    __syncthreads();
}
__device__ __forceinline__ void conv_row(Frame& F, int row, int lane, const float* state_conv, const float* conv_w, float* out) {
    const bool samp = row >= ROW_S; const int tq = row & (SEQ - 1), b = row >> 11, n = row - ROW_S;
    const int r1 = tq >= 1 ? row - 1 : ROW_META + 15, r2 = tq >= 2 ? row - 2 : ROW_META + 14 + tq;
    const bf16* p0 = F.proj() + (size_t)row * NIN; const bf16* p1 = F.proj() + (size_t)r1 * NIN; const bf16* p2 = F.proj() + (size_t)r2 * NIN;
#pragma unroll
    for (int jp = 0; jp < 2; ++jp) {
        v4u vcb[2], vcc[2], vch[2], vc1[2], vh1[2], vc2[2], vh2[2]; f32x4 s1[2][2], s0[2][2], wq[2][3][2];
#pragma unroll
        for (int jj = 0; jj < 2; ++jj) { const int c0 = 512 * (2 * jp + jj) + 8 * lane;
            vcb[jj] = *(const v4u*)(p0 + C_CB + c0); vcc[jj] = *(const v4u*)(p0 + C_CC + c0); vch[jj] = *(const v4u*)(p0 + C_CH + c0);
            if (!samp) { vc1[jj] = *(const v4u*)(p1 + C_CC + c0); vh1[jj] = *(const v4u*)(p1 + C_CH + c0); vc2[jj] = *(const v4u*)(p2 + C_CC + c0); vh2[jj] = *(const v4u*)(p2 + C_CH + c0); }
            else { const f32x4* q1 = (const f32x4*)(state_conv + (size_t)(n * 2 + 1) * DCONV + c0); const f32x4* q0 = (const f32x4*)(state_conv + (size_t)(n * 2 + 0) * DCONV + c0);
                s1[jj][0] = q1[0]; s1[jj][1] = q1[1]; s0[jj][0] = q0[0]; s0[jj][1] = q0[1]; }
#pragma unroll
            for (int k = 0; k < 3; ++k) { const f32x4* q = (const f32x4*)(conv_w + k * DCONV + c0); wq[jj][k][0] = q[0]; wq[jj][k][1] = q[1]; } }
#pragma unroll
        for (int jj = 0; jj < 2; ++jj) { const int c0 = 512 * (2 * jp + jj) + 8 * lane;
            float cb[8], cc[8], ch[8], ut[8], u1[8], u2[8], y[8];
            unpack8(vcb[jj], cb); unpack8(vcc[jj], cc); unpack8(vch[jj], ch);
#pragma unroll
            for (int e = 0; e < 8; ++e) ut[e] = cc[e] * ch[e];
            if (!samp) { unpack8(vc1[jj], cc); unpack8(vh1[jj], ch);
#pragma unroll
                for (int e = 0; e < 8; ++e) u1[e] = cc[e] * ch[e];
                unpack8(vc2[jj], cc); unpack8(vh2[jj], ch);
#pragma unroll
                for (int e = 0; e < 8; ++e) u2[e] = cc[e] * ch[e]; }
            else { const f32x4 a0 = s1[jj][0], a1 = s1[jj][1], b0 = s0[jj][0], b1 = s0[jj][1];
                u1[0] = a0.x; u1[1] = a0.y; u1[2] = a0.z; u1[3] = a0.w; u1[4] = a1.x; u1[5] = a1.y; u1[6] = a1.z; u1[7] = a1.w;
                u2[0] = b0.x; u2[1] = b0.y; u2[2] = b0.z; u2[3] = b0.w; u2[4] = b1.x; u2[5] = b1.y; u2[6] = b1.z; u2[7] = b1.w; }
            const float w0[8] = {wq[jj][0][0].x, wq[jj][0][0].y, wq[jj][0][0].z, wq[jj][0][0].w, wq[jj][0][1].x, wq[jj][0][1].y, wq[jj][0][1].z, wq[jj][0][1].w};
            const float w1[8] = {wq[jj][1][0].x, wq[jj][1][0].y, wq[jj][1][0].z, wq[jj][1][0].w, wq[jj][1][1].x, wq[jj][1][1].y, wq[jj][1][1].z, wq[jj][1][1].w};
            const float w2[8] = {wq[jj][2][0].x, wq[jj][2][0].y, wq[jj][2][0].z, wq[jj][2][0].w, wq[jj][2][1].x, wq[jj][2][1].y, wq[jj][2][1].z, wq[jj][2][1].w};
#pragma unroll
            for (int e = 0; e < 8; ++e) y[e] = cb[e] * (w0[e] * u2[e] + w1[e] * u1[e] + w2[e] * ut[e]);
            *(v4u*)(F.mix() + (size_t)row * D + DGV + c0) = pack8(y);
            if (!samp) { if (tq >= SEQ - 2) { f32x4* o = (f32x4*)(out + O_CP + (size_t)(b * 2 + (tq - (SEQ - 2))) * DCONV + c0); o[0] = (f32x4){ut[0], ut[1], ut[2], ut[3]}; o[1] = (f32x4){ut[4], ut[5], ut[6], ut[7]}; } }
            else { f32x4* o = (f32x4*)(out + O_CS + (size_t)(n * 2) * DCONV + c0); o[0] = (f32x4){u1[0], u1[1], u1[2], u1[3]}; o[1] = (f32x4){u1[4], u1[5], u1[6], u1[7]};
                f32x4* o2 = (f32x4*)(out + O_CS + (size_t)(n * 2 + 1) * DCONV + c0); o2[0] = (f32x4){ut[0], ut[1], ut[2], ut[3]}; o2[1] = (f32x4){ut[4], ut[5], ut[6], ut[7]}; } }
    }
}
typedef float f32x16 __attribute__((ext_vector_type(16)));
constexpr int NCH = 33, NBH = NBATCH * NH;
constexpr size_t GS_QF = 0, GS_KF = GS_QF + (size_t)NBH * NCH * 32768, GS_AF = GS_KF + (size_t)NBH * NCH * 32768, GS_VF = GS_AF + (size_t)NBH * NCH * 8192,
                 GS_EL = GS_VF + (size_t)NBH * NCH * 65536, GS_END = GS_EL + (size_t)NBH * NCH * 1024;
static_assert(GS_END <= 132 * MiB, "GLA scratch aliases the R region");
constexpr int L_QS = 0, L_KS = 33792, L_KKT = 67584, L_AT = 101376, L_AL = 110592, L_BT = 114688;
__device__ __forceinline__ int crow32(int i, int h) { return (i & 3) + 8 * (i >> 2) + 4 * h; }

__device__ __forceinline__ void conv_rows4(Frame& F, int row0, int lane, const float* conv_w, float* out) {
    const int tq0 = row0 & (SEQ - 1), b = row0 >> 11;
    const bf16* pm2 = F.proj() + (size_t)(tq0 ? row0 - 2 : ROW_META + 14) * NIN; const bf16* pm1 = F.proj() + (size_t)(tq0 ? row0 - 1 : ROW_META + 15) * NIN; const bf16* p0 = F.proj() + (size_t)row0 * NIN;
#pragma unroll 1
    for (int g = 0; g < 4; ++g) { const int c0 = 512 * g + 8 * lane;
        v4u vcc[6], vch[6], vcb[4]; f32x4 wq[3][2];
        vcc[0] = __builtin_nontemporal_load((const v4u*)(pm2 + C_CC + c0)); vch[0] = __builtin_nontemporal_load((const v4u*)(pm2 + C_CH + c0)); vcc[1] = __builtin_nontemporal_load((const v4u*)(pm1 + C_CC + c0)); vch[1] = __builtin_nontemporal_load((const v4u*)(pm1 + C_CH + c0));
#pragma unroll
        for (int i = 0; i < 4; ++i) { vcc[2 + i] = __builtin_nontemporal_load((const v4u*)(p0 + (size_t)i * NIN + C_CC + c0)); vch[2 + i] = __builtin_nontemporal_load((const v4u*)(p0 + (size_t)i * NIN + C_CH + c0)); vcb[i] = __builtin_nontemporal_load((const v4u*)(p0 + (size_t)i * NIN + C_CB + c0)); }
#pragma unroll
        for (int k = 0; k < 3; ++k) { const f32x4* q = (const f32x4*)(conv_w + k * DCONV + c0); wq[k][0] = q[0]; wq[k][1] = q[1]; }
        float u[6][8];
#pragma unroll
        for (int j = 0; j < 6; ++j) { float cc[8], ch[8]; unpack8(vcc[j], cc); unpack8(vch[j], ch);
#pragma unroll
            for (int e = 0; e < 8; ++e) u[j][e] = cc[e] * ch[e]; }
        const float w0[8] = {wq[0][0].x, wq[0][0].y, wq[0][0].z, wq[0][0].w, wq[0][1].x, wq[0][1].y, wq[0][1].z, wq[0][1].w};
        const float w1[8] = {wq[1][0].x, wq[1][0].y, wq[1][0].z, wq[1][0].w, wq[1][1].x, wq[1][1].y, wq[1][1].z, wq[1][1].w};
        const float w2[8] = {wq[2][0].x, wq[2][0].y, wq[2][0].z, wq[2][0].w, wq[2][1].x, wq[2][1].y, wq[2][1].z, wq[2][1].w};
#pragma unroll
        for (int i = 0; i < 4; ++i) { float cb[8], y[8]; unpack8(vcb[i], cb);
#pragma unroll
            for (int e = 0; e < 8; ++e) y[e] = cb[e] * (w0[e] * u[i][e] + w1[e] * u[i + 1][e] + w2[e] * u[i + 2][e]);
            *(v4u*)(F.mix() + (size_t)(row0 + i) * D + DGV + c0) = pack8(y); }
        if (tq0 == SEQ - 4) {
#pragma unroll
            for (int i = 0; i < 2; ++i) { const bf16* px = F.proj() + (size_t)(MROWS + 2 * b + i) * NIN; float cc[8], ch[8]; unpack8(*(const v4u*)(px + C_CC + c0), cc); unpack8(*(const v4u*)(px + C_CH + c0), ch);
                f32x4* o = (f32x4*)(out + O_CP + (size_t)(b * 2 + i) * DCONV + c0); o[0] = (f32x4){cc[0] * ch[0], cc[1] * ch[1], cc[2] * ch[2], cc[3] * ch[3]}; o[1] = (f32x4){cc[4] * ch[4], cc[5] * ch[5], cc[6] * ch[6], cc[7] * ch[7]}; } }
    }
}
__device__ __forceinline__ void gla_prep_qk(Frame& F, int item, const float* w_a2, const float* b_a) {
    const int bh = item / NCH, c = item - bh * NCH, b = bh >> 2, hd = bh & 3, t = F.tid, lane = F.lane, w = F.wave;
    const int nreal = c == 0 ? NMETA : 64, row0 = c == 0 ? ROW_META : b * SEQ + (c - 1) * 64;
    LAS bf16* Qs = (LAS bf16*)(F.lds + L_QS); LAS bf16* Ks = (LAS bf16*)(F.lds + L_KS); LAS unsigned* KKt = (LAS unsigned*)(F.lds + L_KKT);
    LAS bf16* At = (LAS bf16*)(F.lds + L_AT); LAS float* Al = (LAS float*)(F.lds + L_AL); LAS float* Bt = (LAS float*)(F.lds + L_BT);
    unsigned char* gs = F.gscr();
    const int d = t & 255, half = t >> 8;
    __syncthreads();
#pragma unroll
    for (int x = 0; x < 2; ++x) { const int idx = t + 512 * x, j = idx >> 4, rr = idx & 15; Al[idx] = j < nreal ? bf2f(F.proj()[(size_t)(row0 + j) * NIN + C_AL + rr]) : 0.f; }
    float w2[16];
#pragma unroll
    for (int rr = 0; rr < 16; ++rr) w2[rr] = w_a2[rr * DGK + hd * DK + d];
    const float ba = b_a[hd * DK + d];
    unsigned qv[32], kv[32];
    { const GAS unsigned char* bq = (const GAS unsigned char*)(const GAS bf16*)F.proj() + (size_t)C_Q * 2; const GAS unsigned char* bk = (const GAS unsigned char*)(const GAS bf16*)F.proj() + (size_t)C_K * 2;
      unsigned off = (unsigned)(((size_t)(row0 + half * 32) * NIN + hd * DK + d) * 2);
#pragma unroll
      for (int jj = 0; jj < 32; ++jj) { asm volatile("global_load_ushort %0, %1, %2 nt" : "=v"(qv[jj]) : "v"(off), "s"(bq) : "memory"); asm volatile("global_load_ushort %0, %1, %2 nt" : "=v"(kv[jj]) : "v"(off), "s"(bk) : "memory"); off += NIN * 2; } }
    __syncthreads();
    float bc[32]; float run = 0.f;
    const LAS float* Alh = Al + half * 512;
    LAS bf16* Qsh = Qs + half * (32 * 264) + d; LAS bf16* Ksh = Ks + half * (32 * 264) + d; LAS unsigned* KKh = KKt + d * 33 + half * 16;
#pragma unroll
    for (int jj = 0; jj < 32; ++jj) { const int j = half * 32 + jj; float z = ba;
#pragma unroll
        for (int rr = 0; rr < 16; ++rr) z += Alh[jj * 16 + rr] * w2[rr];
        float la = logsigmoid(z) * 0.0625f; if (j >= nreal) la = 0.f; run += la; bc[jj] = run; if ((jj & 3) == 3) __builtin_amdgcn_sched_barrier(0); }
    Bt[half * 256 + d] = run;
    __syncthreads();
    asm volatile("s_waitcnt vmcnt(0)" ::: "memory");
#pragma unroll
    for (int jj = 0; jj < 32; ++jj) asm volatile("" : "+v"(qv[jj]), "+v"(kv[jj]));
    const float off = half ? Bt[d] : 0.f, blast = Bt[d] + Bt[256 + d];
    if (half == 0) ((float*)(gs + GS_EL))[(size_t)(bh * NCH + c) * 256 + d] = __expf(blast);
#pragma unroll
    for (int jj = 0; jj < 32; jj += 2) { const int j = half * 32 + jj; float q0 = 0.f, k0 = 0.f, q1 = 0.f, k1 = 0.f;
        if (j < nreal) { q0 = __uint_as_float(qv[jj] << 16); k0 = __uint_as_float(kv[jj] << 16); } if (j + 1 < nreal) { q1 = __uint_as_float(qv[jj + 1] << 16); k1 = __uint_as_float(kv[jj + 1] << 16); }
        const float b0 = bc[jj] + off, b1 = bc[jj + 1] + off;
        Qsh[jj * 264] = (bf16)f2bf(q0 * __expf(b0) * 0.0625f); Qsh[(jj + 1) * 264] = (bf16)f2bf(q1 * __expf(b1) * 0.0625f);
        Ksh[jj * 264] = (bf16)f2bf(k0 * __expf(-b0)); Ksh[(jj + 1) * 264] = (bf16)f2bf(k1 * __expf(-b1));
        KKh[jj >> 1] = pk2(k0 * __expf(blast - b0), k1 * __expf(blast - b1)); __builtin_amdgcn_sched_barrier(0); }
    __syncthreads();
    { const int fr = lane & 15, fq = lane >> 4, ti = w & 3;
#pragma unroll
      for (int tt = 0; tt < 2; ++tt) { const int tj = 2 * (w >> 2) + tt; f32x4 acc = (f32x4){0.f, 0.f, 0.f, 0.f};
        if (tj <= ti) {
#pragma unroll
            for (int ks = 0; ks < 8; ++ks) { const bf16x8 A = *(const LAS bf16x8*)(Ks + (16 * tj + fr) * 264 + 32 * ks + 8 * fq); const bf16x8 B = *(const LAS bf16x8*)(Qs + (16 * ti + fr) * 264 + 32 * ks + 8 * fq);
                acc = __builtin_amdgcn_mfma_f32_16x16x32_bf16(A, B, acc, 0, 0, 0); } }
        const int i = 16 * ti + fr, j0 = 16 * tj + 4 * fq;
        u32x2v o; o.x = pk2(j0 + 0 <= i ? acc[0] : 0.f, j0 + 1 <= i ? acc[1] : 0.f); o.y = pk2(j0 + 2 <= i ? acc[2] : 0.f, j0 + 3 <= i ? acc[3] : 0.f);
        *(LAS u32x2v*)(At + i * 72 + j0) = o; } }
    __syncthreads();
    { const int r = lane & 31, h = lane >> 5;
      GAS v4u* QFg = (GAS v4u*)(gs + GS_QF) + (size_t)(bh * NCH + c) * 2048; GAS v4u* KFg = (GAS v4u*)(gs + GS_KF) + (size_t)(bh * NCH + c) * 2048; GAS v4u* AFg = (GAS v4u*)(gs + GS_AF) + (size_t)(bh * NCH + c) * 512;
#pragma unroll
      for (int ff = 0; ff < 4; ++ff) { const int f = w * 4 + ff, rt = f >> 4, kt = f & 15, i = 32 * rt + r, d0 = 16 * kt + 4 * h;
          const u32x2v lo = *(const LAS u32x2v*)(Qs + i * 264 + d0), hi = *(const LAS u32x2v*)(Qs + i * 264 + d0 + 8);
          v4u o; o.x = lo.x; o.y = lo.y; o.z = hi.x; o.w = hi.y; QFg[f * 64 + lane] = o; }
#pragma unroll
      for (int ff = 0; ff < 4; ++ff) { const int f = w * 4 + ff, dt = f >> 2, ks = f & 3, dd = 32 * dt + r; const LAS unsigned* p = KKt + dd * 33 + 8 * ks + 4 * h;
          v4u o; o.x = p[0]; o.y = p[1]; o.z = p[2]; o.w = p[3]; KFg[f * 64 + lane] = o; }
      { const int f = w, rt = f >> 2, ks = f & 3, i = 32 * rt + r, j0 = 16 * ks + 8 * h; AFg[f * 64 + lane] = *(const LAS v4u*)(At + i * 72 + j0); } }
}
__device__ __forceinline__ void gla_prep_v(Frame& F, int item) {
    const int bh = item / NCH, c = item - bh * NCH, b = bh >> 2, hd = bh & 3, t = F.tid, lane = F.lane, w = F.wave;
    const int nreal = c == 0 ? NMETA : 64, row0 = c == 0 ? ROW_META : b * SEQ + (c - 1) * 64;
    LAS bf16* Vs = (LAS bf16*)(F.lds);
    unsigned char* gs = F.gscr();
    __syncthreads();
    v4u vv[8];
#pragma unroll
    for (int x = 0; x < 8; ++x) { const int p = t + 512 * x, j = p >> 6, cc = (p & 63) * 8; vv[x] = __builtin_nontemporal_load((const v4u*)(F.proj() + (size_t)(row0 + j) * NIN + C_V + hd * DV + cc)); }
#pragma unroll
    for (int x = 0; x < 8; ++x) { const int p = t + 512 * x, j = p >> 6, cc = (p & 63) * 8; *(LAS v4u*)(Vs + j * 520 + cc) = j < nreal ? vv[x] : (v4u){0u, 0u, 0u, 0u}; }
    __syncthreads();
    const int r = lane & 31, h = lane >> 5;
    GAS v4u* VFg = (GAS v4u*)(gs + GS_VF) + (size_t)(bh * NCH + c) * 4096;
#pragma unroll
    for (int ff = 0; ff < 8; ++ff) { const int f = w * 8 + ff, vt = f >> 2, ks = f & 3, col = 32 * vt + r, j0 = 16 * ks + 8 * h; const LAS bf16* p = Vs + j0 * 520 + col;
        v4u o; o.x = (unsigned)p[0] | ((unsigned)p[520] << 16); o.y = (unsigned)p[2 * 520] | ((unsigned)p[3 * 520] << 16); o.z = (unsigned)p[4 * 520] | ((unsigned)p[5 * 520] << 16); o.w = (unsigned)p[6 * 520] | ((unsigned)p[7 * 520] << 16);
        VFg[f * 64 + lane] = o; }
}
#define MFMA32(a, b, c) __builtin_amdgcn_mfma_f32_32x32x16_bf16(__builtin_bit_cast(bf16x8, (a)), __builtin_bit_cast(bf16x8, (b)), (c), 0, 0, 0)
__device__ __forceinline__ void gla_scan(Frame& F, int unit, float* out) {
    const int bh = unit >> 4, sl = unit & 15, b = bh >> 2, hd = bh & 3, e = F.wave, lane = F.lane, r = lane & 31, h = lane >> 5;
    const GAS unsigned char* gs = (const GAS unsigned char*)F.gscr();
    const unsigned lo = (unsigned)lane * 16u, loe = (unsigned)h * 16u;
    const GAS unsigned char* QFb = gs + GS_QF + ((size_t)bh * NCH * 2048 + (2 * e) * 64) * 16;
    const GAS unsigned char* KFb = gs + GS_KF + ((size_t)bh * NCH * 2048 + (4 * e) * 64) * 16;
    const GAS unsigned char* AFb = gs + GS_AF + ((size_t)bh * NCH * 512 + ((e & 1) * 4 + (e >> 1)) * 64) * 16;
    const GAS unsigned char* VFb = gs + GS_VF + ((size_t)bh * NCH * 4096 + (sl * 4) * 64) * 16;
    const GAS unsigned char* ELb = gs + GS_EL + ((size_t)bh * NCH * 256 + 32 * e) * 4;
    LAS float* Part = (LAS float*)F.lds;
    LAS v4u* VS = (LAS v4u*)(F.lds + LDSCTL_OFF + 512);
    bf16* orow = F.obuf() + (size_t)(b * SEQ) * DGV + hd * DV + 32 * sl + r;
    const int ksel = e >> 1;
    f32x16 S;
#pragma unroll
    for (int i = 0; i < 16; ++i) S[i] = 0.f;
    v4u q00, q01, q10, q11, at, k0, k1, k2, k3, v0, v1, v2, v3, vtA = (v4u){0u, 0u, 0u, 0u}, vtB = (v4u){0u, 0u, 0u, 0u}; f32x4 e0, e1, e2, e3;
#define LDV(p) (*(const GAS v4u*)(p))
#define GLA_LOADQ(c_) do { const GAS unsigned char* qp = QFb + (size_t)(c_) * 32768; q00 = LDV(qp + lo); q01 = LDV(qp + 1024 + lo); q10 = LDV(qp + 16384 + lo); q11 = LDV(qp + 17408 + lo); \
        at = LDV(AFb + (size_t)(c_) * 8192 + lo); } while (0)
#define GLA_LOADV(c_) do { const GAS unsigned char* vp = VFb + (size_t)(c_) * 65536; v0 = LDV(vp + lo); v1 = LDV(vp + 1024 + lo); v2 = LDV(vp + 2048 + lo); v3 = LDV(vp + 3072 + lo); } while (0)
#define GLA_LOADK(c_) do { const GAS unsigned char* kp = KFb + (size_t)(c_) * 32768; k0 = LDV(kp + lo); k1 = LDV(kp + 1024 + lo); k2 = LDV(kp + 2048 + lo); k3 = LDV(kp + 3072 + lo); \
        const GAS unsigned char* ep = ELb + (size_t)(c_) * 1024; e0 = *(const GAS f32x4*)(ep + loe); e1 = *(const GAS f32x4*)(ep + 32 + loe); e2 = *(const GAS f32x4*)(ep + 64 + loe); e3 = *(const GAS f32x4*)(ep + 96 + loe); } while (0)
#define GLA_STATE() do { S[0] *= e0.x; S[1] *= e0.y; S[2] *= e0.z; S[3] *= e0.w; S[4] *= e1.x; S[5] *= e1.y; S[6] *= e1.z; S[7] *= e1.w; \
        S[8] *= e2.x; S[9] *= e2.y; S[10] *= e2.z; S[11] *= e2.w; S[12] *= e3.x; S[13] *= e3.y; S[14] *= e3.z; S[15] *= e3.w; \
        S = MFMA32(k0, v0, S); S = MFMA32(k1, v1, S); S = MFMA32(k2, v2, S); S = MFMA32(k3, v3, S); } while (0)
#define GLA_ATTN(o) do { if (ksel == 0) o = MFMA32(at, v0, o); else if (ksel == 1) o = MFMA32(at, v1, o); else if (ksel == 2) o = MFMA32(at, v2, o); else o = MFMA32(at, v3, o); } while (0)
#define GLA_STEP(VT, VN, c_) do { const int cc_ = (c_); LAS float* P = Part + (cc_ & 1) * 16384; \
        if (cc_ >= 3) { const LAS v4u* vs = VS + (cc_ % 3) * 256 + lane; v0 = vs[0]; v1 = vs[64]; v2 = vs[128]; v3 = vs[192]; } \
        { v4u s0, s1; s0.x = pk2(S[0], S[1]); s0.y = pk2(S[2], S[3]); s0.z = pk2(S[4], S[5]); s0.w = pk2(S[6], S[7]); s1.x = pk2(S[8], S[9]); s1.y = pk2(S[10], S[11]); s1.z = pk2(S[12], S[13]); s1.w = pk2(S[14], S[15]); \
          f32x16 o; _Pragma("unroll") for (int i = 0; i < 16; ++i) o[i] = 0.f; \
          o = MFMA32(q00, s0, o); o = MFMA32(q01, s1, o); if (!(e & 1)) GLA_ATTN(o); \
          _Pragma("unroll") for (int i = 0; i < 16; ++i) P[((e * 2 + 0) * 16 + i) * 64 + lane] = o[i]; \
          _Pragma("unroll") for (int i = 0; i < 16; ++i) o[i] = 0.f; \
          o = MFMA32(q10, s0, o); o = MFMA32(q11, s1, o); if (e & 1) GLA_ATTN(o); \
          _Pragma("unroll") for (int i = 0; i < 16; ++i) P[((e * 2 + 1) * 16 + i) * 64 + lane] = o[i]; } \
        if (cc_ + 1 < NCH) GLA_LOADQ(cc_ + 1); \
        GLA_STATE(); \
        if (cc_ + 1 < NCH) GLA_LOADK(cc_ + 1); \
        if (cc_ + 1 < NCH && cc_ + 1 < 3) GLA_LOADV(cc_ + 1);                       \
        if (e < 4 && cc_ + 2 < NCH) VT = __builtin_nontemporal_load((const GAS v4u*)(VFb + (size_t)(cc_ + 2) * 65536 + e * 1024 + lo)); \
        if (e < 4 && cc_ + 1 < NCH && cc_ + 1 >= 3) VS[((cc_ + 1) % 3) * 256 + e * 64 + lane] = VN; \
        __syncthreads(); \
        _Pragma("unroll") for (int pp = 0; pp < 4; ++pp) { const int p = 4 * e + pp, rt = p >> 4, reg = p & 15; float s = 0.f; \
            _Pragma("unroll") for (int w2 = 0; w2 < 8; ++w2) s += P[((w2 * 2 + rt) * 16 + reg) * 64 + lane]; \
            const int i = 32 * rt + crow32(reg, h); orow[(size_t)((cc_ - 1) * 64 + i) * DGV] = (bf16)f2bf(s); } } while (0)
    __syncthreads();
    GLA_LOADK(0); GLA_LOADV(0); GLA_LOADQ(1);
    GLA_STATE();
    GLA_LOADK(1); GLA_LOADV(1);
    for (int c = 1; c < NCH; c += 2) { GLA_STEP(vtB, vtA, c); GLA_STEP(vtA, vtB, c + 1); }
#undef LDV
#undef GLA_LOADQ
#undef GLA_LOADV
#undef GLA_LOADK
#undef GLA_STATE
#undef GLA_ATTN
#undef GLA_STEP
    float* gp = out + O_GP + ((size_t)(b * NH + hd) * DK + 32 * e) * DV + 32 * sl + r;
#pragma unroll
    for (int i = 0; i < 16; ++i) gp[(size_t)crow32(i, h) * DV] = S[i];
    __syncthreads();
}

__device__ __forceinline__ void finish_rows(Frame& F, int row, int lane, const float* gnorm) {
    const f32x4* gq = (const f32x4*)(gnorm + 8 * lane); const f32x4 g0 = gq[0], g1 = gq[1];
    const float gn[8] = {g0.x, g0.y, g0.z, g0.w, g1.x, g1.y, g1.z, g1.w};
    const bf16* op = F.obuf() + (size_t)row * DGV + 8 * lane; const bf16* gp = F.proj() + (size_t)row * NIN + C_G + 8 * lane;
    v4u ov[4], gv[4];
#pragma unroll
    for (int hd = 0; hd < 4; ++hd) { ov[hd] = __builtin_nontemporal_load((const v4u*)(op + hd * DV)); gv[hd] = __builtin_nontemporal_load((const v4u*)(gp + hd * DV)); }
    float ss[4];
#pragma unroll
    for (int hd = 0; hd < 4; ++hd) { float o[8]; unpack8(ov[hd], o); float s = 0.f;
#pragma unroll
        for (int e = 0; e < 8; ++e) s += o[e] * o[e];
        ss[hd] = s; }
#pragma unroll
    for (int o = 1; o < 64; o <<= 1) { ss[0] += __shfl_xor(ss[0], o); ss[1] += __shfl_xor(ss[1], o); ss[2] += __shfl_xor(ss[2], o); ss[3] += __shfl_xor(ss[3], o); }
#pragma unroll
    for (int hd = 0; hd < 4; ++hd) { float o[8], g[8], y[8]; unpack8(ov[hd], o); unpack8(gv[hd], g); const float rs = 1.f / sqrtf(ss[hd] * (1.f / DV) + RMS_EPS);
#pragma unroll
        for (int e = 0; e < 8; ++e) y[e] = o[e] * rs * gn[e] * silu(g[e]);
        *(v4u*)(F.mix() + (size_t)row * D + hd * DV + 8 * lane) = pack8(y); }
}

struct Args { const float* in[20]; float* out; unsigned char* ws; };
constexpr int SC_GU = 2 * CM_STRIPS * D, SC_TOTAL = SC_GU + CD_STRIPS * DFF;
struct SideColMax {
    static constexpr int NV = 2;
    const Frame* F; const GAS unsigned char* base; int cg, cur, left; unsigned voff;
    f32x4 m, x0, x1;
    __device__ __forceinline__ int K() const { return cg < 2 * CM_STRIPS ? D : DFF; }
    __device__ __forceinline__ unsigned pitch() const { return cg < 2 * CM_STRIPS ? DFF * 4u : D * 4u; }
    __device__ __forceinline__ void setcg() {
        if (cg < 2 * CM_STRIPS) { const int mt = cg >= CM_STRIPS ? 1 : 0, strip = cg - mt * CM_STRIPS; base = (const GAS unsigned char*)(const GAS float*)(mt ? F->in<A_WUP>() : F->in<A_WGATE>()) + (size_t)strip * 1024; }
        else base = (const GAS unsigned char*)(const GAS float*)F->in<A_WDOWN>() + (size_t)(cg - 2 * CM_STRIPS) * 1024; }
    __device__ __forceinline__ void init(const Frame& F_, int gw, int ngw, int lo, int hi) { F = &F_; voff = 16u * (unsigned)F_.lane;
        int share = (hi - lo + ngw - 1) / ngw; share += share & 1; const int i0 = lo + gw * share; left = hi - i0; left = left < 0 ? 0 : (left > share ? share : left);
        if (left == 0) { cg = 0; cur = 1; } else if (i0 < SC_GU) { cg = i0 / D; cur = i0 - cg * D; } else { const int j = i0 - SC_GU; cg = j / DFF; cur = j - cg * DFF; cg += 2 * CM_STRIPS; }
        setcg(); m = x0 = x1 = (f32x4){0.f, 0.f, 0.f, 0.f}; }
    __device__ __forceinline__ void consume() {
        m.x = fmaxf(fmaxf(m.x, fabsf(x0.x)), fabsf(x1.x)); m.y = fmaxf(fmaxf(m.y, fabsf(x0.y)), fabsf(x1.y)); m.z = fmaxf(fmaxf(m.z, fabsf(x0.z)), fabsf(x1.z)); m.w = fmaxf(fmaxf(m.w, fabsf(x0.w)), fabsf(x1.w)); }
    __device__ __forceinline__ void flush() {
        unsigned* cm;
        if (cg < 2 * CM_STRIPS) { const int mt = cg >= CM_STRIPS ? 1 : 0, c0 = 256 * (cg - mt * CM_STRIPS) + 4 * F->lane; cm = (unsigned*)F->cmax() + 256 * (c0 >> 7) + (mt ? 128 : 0) + (c0 & 127); }
        else cm = (unsigned*)F->cmdn() + 256 * (cg - 2 * CM_STRIPS) + 4 * F->lane;
        __hip_atomic_fetch_max(cm + 0, __float_as_uint(m.x), __ATOMIC_RELAXED, __HIP_MEMORY_SCOPE_AGENT); __hip_atomic_fetch_max(cm + 1, __float_as_uint(m.y), __ATOMIC_RELAXED, __HIP_MEMORY_SCOPE_AGENT);
        __hip_atomic_fetch_max(cm + 2, __float_as_uint(m.z), __ATOMIC_RELAXED, __HIP_MEMORY_SCOPE_AGENT); __hip_atomic_fetch_max(cm + 3, __float_as_uint(m.w), __ATOMIC_RELAXED, __HIP_MEMORY_SCOPE_AGENT);
        m = (f32x4){0.f, 0.f, 0.f, 0.f}; }
    __device__ __forceinline__ void step() {
        if (left > 0 && cur == K()) { flush(); ++cg; setcg(); cur = 0; }
        int n = K() - cur; n = n < left ? n : left; n = n < 2 ? n : 2;
        const int last = n > 0 ? cur + n - 1 : cur - 1, r0 = cur < last ? cur : last;
        const GAS unsigned char* p0 = base + (size_t)r0 * pitch(); const GAS unsigned char* p1 = base + (size_t)last * pitch();
        asm volatile("global_load_dwordx4 %0, %1, %2 nt" : "=v"(x0) : "v"(voff), "s"(p0) : "memory");
        asm volatile("global_load_dwordx4 %0, %1, %2 nt" : "=v"(x1) : "v"(voff), "s"(p1) : "memory");
        cur += n; left -= n; }
    __device__ __forceinline__ void finish() { while (left > 0) { step(); asm volatile("s_waitcnt vmcnt(0)" ::: "memory"); consume(); } flush(); }
};
__global__ void __launch_bounds__(NWAVES * 64, 2) hymba_fwd(Args args) {
    extern __shared__ __attribute__((aligned(16))) unsigned char lds[];
    Frame F;
    F.lds = (LAS unsigned char*)lds;
    F.MISC = (volatile LAS unsigned*)(F.lds + MISC_OFF);
    F.tid = threadIdx.x; F.lane = F.tid & 63; F.wave = __builtin_amdgcn_readfirstlane(F.tid >> 6);
    F.G = gridDim.x; { const int bx = blockIdx.x; F.vcu = (F.G % 8 == 0) ? (bx % 8) * (F.G / 8) + bx / 8 : bx; }
    unsigned char* ws = args.ws;
    F.ctl = (gu32*)(ws + WS_CTL);
    F.ws = ws;
    for (int u = F.tid; u < (LDS_BYTES - LDSCTL_OFF) / 4; u += NWAVES * 64) ((LAS unsigned*)(F.lds + LDSCTL_OFF))[u] = 0u;
    __syncthreads();
    XcdBarrier bar = xcd_barrier_post((unsigned*)(F.ctl + CW_BAR), F.MISC + 8);
    const int gw = F.vcu * NWAVES + F.wave, NGW = F.G * NWAVES;

    p0_prologue(F);
    if (NCONV_CU == 0 || F.G != 256) convert_rest(F, F.vcu * NWAVES + F.wave, F.G * NWAVES, 0, I_OUT);
    xcd_barrier(bar); F.refresh();
    quant_in_pass(F, gw, NGW);
    xcd_barrier(bar); F.refresh();
    { SideColMax sd; sd.init(F, gw, NGW, 0, SC_GU);
      { pg8::Gemm g{F.h0(), F.Wt_in(), MPAD, NBF, D}; g.wave = F.wave; pg8::PackedOrder<0> S; S.init(MPR / 256, C_CC / 256, F.G, (int)blockIdx.x, D / 64, NBF / 256);
        pg8::EpiBf16 E{F.proj(), NIN, F.slab(), (float*)((unsigned char*)F.slab() + SLAB_A_OFF)};
        pg8::gemm_phase<pg8::EpiBf16, pg8::PackedOrder<0>, PG8_ALIGN, PG8_SP2, SideColMax>(F.lds + RING_OFF, g, S, E, sd); }
      { const int c2 = (F.G == 256) ? (((int)blockIdx.x + 128) & 255) : (int)blockIdx.x;
        pg8::Gemm g{(const bf16*)F.h0q(), (const bf16*)F.Wq_in(), MPAD, NI8, D / 2}; g.wave = F.wave; pg8::PackedOrder<4> S; S.init(MPR / 256, NI8 / 256, F.G, c2, D / 128, NI8X / 256);
        pg8::EpiBf16I8 E{F.proj() + NBF, NIN, F.slab() + NBF, F.rs0(), F.cmin(), NI8X / 256, C_CC - NBF - NI8X};
        pg8::gemm_phase<pg8::EpiBf16I8, pg8::PackedOrder<4>, PG8_ALIGN, PG8_SP2, SideColMax>(F.lds + RING_OFF, g, S, E, sd); }
      sd.finish(); }
    xcd_barrier(bar); F.refresh();
    { const int gt = blockIdx.x * (NWAVES * 64) + F.tid, NT = F.G * NWAVES * 64; const float* sx = F.slab(); const float* sa = (const float*)((const unsigned char*)F.slab() + SLAB_A_OFF);
      for (int idx = gt; idx < XROWS * (NIN / 8); idx += NT) { const int r = idx / (NIN / 8), cg = idx - r * (NIN / 8); const float* p = sx + (size_t)r * NIN + 8 * cg; float v[8];
          { const f32x4 a = __builtin_nontemporal_load((const f32x4*)p), c = __builtin_nontemporal_load((const f32x4*)p + 1); v[0] = a.x; v[1] = a.y; v[2] = a.z; v[3] = a.w; v[4] = c.x; v[5] = c.y; v[6] = c.z; v[7] = c.w; }
#pragma unroll
          for (int s = 1; s < 3; ++s) { const f32x4 a = __builtin_nontemporal_load((const f32x4*)(p + (size_t)s * XROWS * NIN)), c = __builtin_nontemporal_load((const f32x4*)(p + (size_t)s * XROWS * NIN) + 1); v[0] += a.x; v[1] += a.y; v[2] += a.z; v[3] += a.w; v[4] += c.x; v[5] += c.y; v[6] += c.z; v[7] += c.w; }
          *(v4u*)(F.proj() + (size_t)(MPR + r) * NIN + 8 * cg) = pack8(v); }
      for (int idx = gt; idx < MPR * 2; idx += NT) { const int row = idx >> 1, hf = idx & 1; const float* p = sa + (size_t)row * 16 + 8 * hf; float v[8];
          { const f32x4 a = ((const f32x4*)p)[0], c = ((const f32x4*)p)[1]; v[0] = a.x; v[1] = a.y; v[2] = a.z; v[3] = a.w; v[4] = c.x; v[5] = c.y; v[6] = c.z; v[7] = c.w; }
#pragma unroll
          for (int s = 1; s < 3; ++s) { const f32x4 a = ((const f32x4*)(p + (size_t)s * MPR * 16))[0], c = ((const f32x4*)(p + (size_t)s * MPR * 16))[1]; v[0] += a.x; v[1] += a.y; v[2] += a.z; v[3] += a.w; v[4] += c.x; v[5] += c.y; v[6] += c.z; v[7] += c.w; }
          *(v4u*)(F.proj() + (size_t)row * NIN + C_AL + 8 * hf) = pack8(v); } }
    xcd_barrier(bar); F.refresh();
    { const float *w_a2 = F.in<A_WA2>(), *b_a = F.in<A_BA>(), *state_conv = F.in<A_SCONV>(), *conv_w = F.in<A_CONVW>(), *state_gla = F.in<A_SGLA>(); float* out = F.out();
      const int nsa = F.G == 256 ? 256 : 0;
      if (blockIdx.x & 1) for (int it = blockIdx.x; it < nsa; it += F.G) gla_sample_item(F, it, w_a2, b_a, state_gla, out);
      if (F.G == 256) { const int c = blockIdx.x;
          gla_prep_qk(F, c, w_a2, b_a); gla_prep_qk(F, c + 256, w_a2, b_a);
          if (c < 16) gla_prep_qk(F, c + 512, w_a2, b_a);
          else { gla_prep_v(F, c - 16); gla_prep_v(F, c - 16 + 240); if (c - 16 < 48) gla_prep_v(F, c - 16 + 480); } }
      else for (int it = blockIdx.x; it < 2 * NBH * NCH; it += F.G) { if (it < NBH * NCH) gla_prep_qk(F, it, w_a2, b_a); else gla_prep_v(F, it - NBH * NCH); }
      for (int r4 = gw; r4 < MPR / 4; r4 += NGW) conv_rows4(F, 4 * r4, F.lane, conv_w, out);
      for (int row = ROW_S + gw; row < ROW_META; row += NGW) conv_row(F, row, F.lane, state_conv, conv_w, out);
      if (!(blockIdx.x & 1)) for (int it = blockIdx.x; it < nsa; it += F.G) gla_sample_item(F, it, w_a2, b_a, state_gla, out); }
    xcd_barrier(bar); F.refresh();
    { const float *w_a2 = F.in<A_WA2>(), *b_a = F.in<A_BA>(), *state_gla = F.in<A_SGLA>(); float* out = F.out();
      const int nsa = F.G == 256 ? 256 : 0;
      if (!(blockIdx.x & 1)) for (int it = nsa + blockIdx.x; it < NSAMP * NH; it += F.G) gla_sample_item(F, it, w_a2, b_a, state_gla, out);
      for (int u0 = blockIdx.x; u0 < 256; u0 += F.G) { const int i = u0 >> 3, u = F.G == 256 ? (2 * (u0 & 7) + (i >> 4)) * 16 + (i & 15) : u0; gla_scan(F, u, out); }
      if (blockIdx.x & 1) for (int it = nsa + blockIdx.x; it < NSAMP * NH; it += F.G) gla_sample_item(F, it, w_a2, b_a, state_gla, out); }
    xcd_barrier(bar); F.refresh();
    { const float* gnorm = F.in<A_GNORM>(); for (int row = gw; row < ROW_META; row += NGW) finish_rows(F, row, F.lane, gnorm); }
    xcd_barrier(bar); F.refresh();
    { pg8::Gemm g{F.mix(), F.Wt_out(), MPAD, D, D}; g.wave = F.wave; pg8::PackedOrder<1> S; S.init(MPR / 256, D / 256, F.G, (int)blockIdx.x, D / 64);
      pg8::EpiResBf16 E{F.R(), D, F.h0(), D, ALPHA, F.slab()};
      SideColMax sd; sd.init(F, gw, NGW, SC_GU, SC_TOTAL);
      pg8::gemm_phase<pg8::EpiResBf16, pg8::PackedOrder<1>, PG8_ALIGN, PG8_SP2, SideColMax>(F.lds + RING_OFF, g, S, E, sd);
      sd.finish(); }
    xcd_barrier(bar); F.refresh();
    { const float *ln_g = F.in<A_LN1G>(), *ln_b = F.in<A_LN1B>();
      for (int r = blockIdx.x; r < NSAMP; r += F.G) ln_row_slab_block<false, 16>(F, F.slab(), r, F.h0() + (size_t)(ROW_S + r) * D, ln_g, ln_b, F.h1() + (size_t)(ROW_S + r) * D, F.h1q() + (size_t)(ROW_S + r) * D, F.rsc() + ROW_S + r);
      stage_gb(F, ln_g, ln_b);
      for (int row = gw; row < MPR; row += NGW) ln1_row_quant(F.R() + (size_t)row * D, (const LAS f32x4*)(F.lds + LDS_GB), F.h1() + (size_t)row * D, F.h1q() + (size_t)row * D, F.rsc() + row, F.lane); }
    quant_gu_pass(F, gw, NGW);
    xcd_barrier(bar); F.refresh();
    { pg8::Gemm g{(const bf16*)F.h1q(), F.Wt_gu(), MPAD, NGU, D / 2}; g.wave = F.wave; pg8::PackedOrder<2> S; S.init(MPR / 256, NGU / 256, F.G, (int)blockIdx.x, D / 128);
      pg8::EpiSwiGLUi8 E{F.act(), DFF, F.slab(), NGU, F.rsc(), F.cmax()};
      pg8::gemm_phase<pg8::EpiSwiGLUi8, pg8::PackedOrder<2>, PG8_ALIGN, PG8_SP2>(F.lds + RING_OFF, g, S, E); }
    xcd_barrier(bar); F.refresh();
    for (int r = blockIdx.x; r < NSAMP; r += F.G) { LAS float* red = (LAS float*)F.lds; const int t = F.tid; float y[3][8]; float mx = 0.f;
#pragma unroll
        for (int gi = 0; gi < 3; ++gi) { const int cg = t + 512 * gi;
#pragma unroll
            for (int e = 0; e < 8; ++e) y[gi][e] = 0.f;
            if (cg < DFF / 8) { const int col0 = 8 * cg, pn = col0 >> 7, cc = col0 & 127; const float* pg = F.slab() + (size_t)r * NGU + 256 * pn + cc; float gv[8], uv[8];
#pragma unroll
                for (int e = 0; e < 8; ++e) { gv[e] = 0.f; uv[e] = 0.f; }
#pragma unroll
                for (int s = 0; s < 4; ++s) { const f32x4* q = (const f32x4*)(pg + (size_t)s * 128 * NGU); const f32x4 a = q[0], c = q[1], d0 = q[32], d1 = q[33];
                    gv[0] += a.x; gv[1] += a.y; gv[2] += a.z; gv[3] += a.w; gv[4] += c.x; gv[5] += c.y; gv[6] += c.z; gv[7] += c.w;
                    uv[0] += d0.x; uv[1] += d0.y; uv[2] += d0.z; uv[3] += d0.w; uv[4] += d1.x; uv[5] += d1.y; uv[6] += d1.z; uv[7] += d1.w; }
#pragma unroll
                for (int e = 0; e < 8; ++e) { y[gi][e] = silu(gv[e]) * uv[e]; mx = fmaxf(mx, fabsf(y[gi][e])); } } }
        mx = wave_max(mx);
        __syncthreads();
        if (F.lane == 0) red[F.wave] = mx;
        __syncthreads();
        float tm = 0.f;
#pragma unroll
        for (int w = 0; w < 8; ++w) tm = fmaxf(tm, red[w]);
        const float inv = tm > 0.f ? 127.0f / tm : 0.f;
        if (t == 0) F.amax()[ROW_S + r] = tm;
#pragma unroll
        for (int gi = 0; gi < 3; ++gi) { const int cg = t + 512 * gi; if (cg < DFF / 8) { u32x2v q; q.x = q4(y[gi][0], y[gi][1], y[gi][2], y[gi][3], inv); q.y = q4(y[gi][4], y[gi][5], y[gi][6], y[gi][7], inv);
            *(u32x2v*)(F.actq() + (size_t)(ROW_S + r) * DFF + 8 * cg) = q; } } }
    for (int row = gw; row < MPR; row += NGW) act_row_quant(F, row, F.lane);
    quant_dn_pass(F, gw, NGW);
    xcd_barrier(bar); F.refresh();
    { pg8::Gemm g{(const bf16*)F.actq(), F.Wt_dn(), MPAD, D, DFF / 2}; g.wave = F.wave; pg8::PackedOrder<3> S; S.init(MPR / 256, D / 256, F.G, (int)blockIdx.x, DFF / 128);
      pg8::EpiResI8 E{F.R(), D, F.h1(), D, ALPHA, F.slab(), F.amax(), F.cmdn()};
      pg8::gemm_phase<pg8::EpiResI8, pg8::PackedOrder<3>, PG8_ALIGN, PG8_SP2>(F.lds + RING_OFF, g, S, E); }
    xcd_barrier(bar); F.refresh();
    { const float *ln_g = F.in<A_LN2G>(), *ln_b = F.in<A_LN2B>(); float* out = F.out();
      for (int r = blockIdx.x; r < NSAMP; r += F.G) ln_row_slab_block<true, 16>(F, F.slab(), r, F.h1() + (size_t)(ROW_S + r) * D, ln_g, ln_b, out + O_YS + (size_t)r * D);
      stage_gb(F, ln_g, ln_b);
      for (int row = gw; row < MPR; row += NGW) { int l = F.lane; asm volatile("" : "+v"(l));
          ln_row_b16<true>(F.R() + (size_t)row * D, (const LAS f32x4*)(F.lds + LDS_GB), out + O_YP + (size_t)row * D, l); } }
}

extern "C" void kernel_launch(void* const* d_in, const int* in_sizes, int n_in, void* d_out, int out_size, void* d_ws, size_t ws_size, hipStream_t stream) {
    static int grid = 0;
    if (grid == 0) {
        if (n_in != 20 || (size_t)out_size != O_END || ws_size < WS_END) { fprintf(stderr, "kernel_launch: unexpected shapes (n_in %d out %d ws %zu)\n", n_in, out_size, ws_size); grid = -1; return; }
        int dev = 0, cus = 0, per_cu = 0;
        if (hipGetDevice(&dev) != hipSuccess || hipDeviceGetAttribute(&cus, hipDeviceAttributeMultiprocessorCount, dev) != hipSuccess) { grid = -1; return; }
        if (hipFuncSetAttribute((const void*)hymba_fwd, hipFuncAttributeMaxDynamicSharedMemorySize, LDS_BYTES) != hipSuccess) { fprintf(stderr, "kernel_launch: hipFuncSetAttribute failed\n"); grid = -1; return; }
        if (hipOccupancyMaxActiveBlocksPerMultiprocessor(&per_cu, (const void*)hymba_fwd, NWAVES * 64, LDS_BYTES) != hipSuccess || per_cu < 1) { fprintf(stderr, "kernel_launch: occupancy query says %d\n", per_cu); (void)hipGetLastError(); grid = -1; return; }
        grid = cus;
    }
    if (grid < 0) return;
    if (hipMemsetAsync((char*)d_ws + WS_CTL, 0, CTL_ZERO_BYTES, stream) != hipSuccess) return;
    Args a{};
    for (int i = 0; i < 20; ++i) a.in[i] = (const float*)d_in[i];
    a.out = (float*)d_out; a.ws = (unsigned char*)d_ws;
    hipLaunchKernelGGL(hymba_fwd, dim3(grid), dim3(NWAVES * 64), LDS_BYTES, stream, a);
}
```

```cpp
#include <hip/hip_runtime.h>
#include <cstdio>
#include <cstdint>
namespace pg8 {
#define PG8_LAS __attribute__((address_space(3)))
typedef unsigned short bf16_t;
typedef short bf16x8 __attribute__((ext_vector_type(8)));
typedef float f32x4 __attribute__((ext_vector_type(4)));
typedef unsigned u32x4 __attribute__((ext_vector_type(4)));
constexpr int BM = 256, BK = 64, HALF = 128, HTB = HALF * BK * 2  , STAGE_BYTES = 8 * HTB, NXCD = 8, WGM = 8;

__host__ __device__ __forceinline__ int lds_byte(int r, int c) { const int st = (r >> 4) * 2 + (c >> 5), rr = r & 15, cc = c & 31, ob = rr * 64 + cc * 2; return st * 1024 + (ob ^ (((ob >> 9) & 1) << 5)); }
__host__ __device__ __forceinline__ void stage_rc(int b, int& R, int& C) { const int st = b / 1024, sb = b % 1024, swz = sb ^ (((sb >> 9) & 1) << 5); R = (st >> 1) * 16 + swz / 64; C = (st & 1) * 32 + (swz % 64) / 2; }
__host__ __device__ __forceinline__ int perm32(int rho) { const int n = rho >> 4, i = rho & 15; return 8 * (i >> 2) + 4 * n + (i & 3); }

struct Unit { int a, b;
    __device__ __forceinline__ int pm() const { return a & 0xff; } __device__ __forceinline__ int pn() const { return (a >> 8) & 0xff; } __device__ __forceinline__ int kind() const { return (a >> 16) & 0xf; } __device__ __forceinline__ int sl() const { return (a >> 20) & 0xff; }
    __device__ __forceinline__ int k0() const { return b & 0xffff; } __device__ __forceinline__ int nt() const { return b >> 16; }
    __device__ __forceinline__ void set(int pm_, int pn_, int k0_, int nt_, int kind_, int sl_) { a = pm_ | (pn_ << 8) | (kind_ << 16) | (sl_ << 20); b = k0_ | (nt_ << 16); } };
struct Gemm { const bf16_t* A; const bf16_t* Bt; int M, N, K; int wave = 0; };

template <int MODE> struct PackedOrder {
    int nM, nN, nwg, G, c, ntfull, nmain, rank, nextra, nfirst, xstride, NX, nE;
    __device__ __forceinline__ void init(int nM_, int nN_, int G_, int c_, int ntfull_, int nE_ = 0) { nM = nM_; nN = nN_; nwg = nM * nN; G = G_; c = c_; ntfull = ntfull_; nE = nE_;
        const int rem = nwg % G; nmain = nwg / G + (c < rem ? 1 : 0); rank = c - rem; if (rank < 0) rank += G;
        NX = MODE == 0 ? 3 * (nE + 32) : (MODE == 4 ? 3 * nE : (MODE == 2 ? 344 : 256));
        if (MODE == 0 || MODE == 4) { const int nlight = rem ? G - rem : G; xstride = nlight; nextra = rank < nlight ? (NX - rank + nlight - 1) / nlight : 0; }
        else if (MODE == 2 && G == 256) { xstride = 1; nextra = rank < 64 ? 4 : (rank - 64 < NX - 256 ? 1 : 0); }
        else { xstride = G; nextra = rank < NX ? (NX - rank + G - 1) / G : 0; }
        if (nextra < 0) nextra = 0;
        nfirst = (MODE != 2 && (c & 7) < 4) ? nextra : 0;
    }
    __device__ __forceinline__ bool next(int i, Unit& u) const {
        int j = -1;
        int im = i - nfirst;
        if (i < nfirst) j = i; else if (im >= nmain) { j = nfirst + (im - nmain); if (j >= nextra) return false; }
        if (j < 0) { int wgid = im * G + c; { const int q = nwg / NXCD, r = nwg % NXCD, xcd = wgid % NXCD, off = wgid / NXCD; wgid = (xcd < r ? xcd * (q + 1) : r * (q + 1) + (xcd - r) * q) + off; }
            const int nig = WGM * nN, gid = wgid / nig, fm = gid * WGM, gsz = (nM - fm) < WGM ? (nM - fm) : WGM;
            u.set(fm + ((wgid % nig) % gsz), (wgid % nig) / gsz, 0, ntfull, 0, 0); return true; }
        int x;
        if (MODE == 2 && G == 256) x = rank < 64 ? rank * 4 + j : 256 + rank - 64; else x = rank + j * xstride;
        if (MODE == 0 || MODE == 4) { const int id = x / 3, s = x - 3 * id, pairs = ntfull / 2, base = pairs / 3, rem3 = pairs % 3;
            const int k0 = 2 * (s < rem3 ? (base + 1) * s : (base + 1) * rem3 + base * (s - rem3)), nt = 2 * (s < rem3 ? base + 1 : base);
            if (MODE == 4 || id < nE) u.set(32, id, k0, nt, 1, s); else u.set(id - nE, nE - 1, k0, nt, 2, s); }
        else if (MODE == 1) u.set(32, x >> 4, 4 * (x & 15), 4, 1, x & 15);
        else if (MODE == 2) u.set(32, x >> 2, (ntfull / 4) * (x & 3), ntfull / 4, 1, x & 3);
        else { const int s = x & 15, pairs = ntfull / 2, base = pairs / 16, rem = pairs % 16;
            u.set(32, x >> 4, 2 * (s < rem ? (base + 1) * s : (base + 1) * rem + base * (s - rem)), 2 * (s < rem ? base + 1 : base), 1, s); }
        return true;
    }
    __device__ __forceinline__ void a_ready(const Unit&) const {}
    __device__ __forceinline__ void done(const Unit&) const {}
};

typedef unsigned u32x2 __attribute__((ext_vector_type(2)));
__device__ __forceinline__ unsigned cvt_pk_bf16(float lo, float hi) { unsigned r; asm volatile("v_cvt_pk_bf16_f32 %0, %1, %2" : "=v"(r) : "v"(lo), "v"(hi)); return r; }
__device__ __forceinline__ float bf_lo(unsigned w) { return __uint_as_float(w << 16); }
__device__ __forceinline__ float bf_hi(unsigned w) { return __uint_as_float(w & 0xffff0000u); }
__device__ __forceinline__ float silu_f(float a) { return a * __builtin_amdgcn_rcpf(1.0f + __builtin_amdgcn_exp2f(-1.44269504089f * a)); }

constexpr int XROWS = 152;
struct EpiBf16 {
    static constexpr bool PERM = true, AFTER_DRAIN = false, I8 = false; typedef f32x4 acc_t;
    bf16_t* O; int ldc; float* slabX; float* slabA;
    __device__ __forceinline__ void operator()(const f32x4 (&acc)[2][2][4][2], const Unit& u, int wr, int wc, int fr, int fq) const {
        const int row0 = u.pm() * BM + wr * 64 + fr, col0 = u.pn() * BM + wc * 32 + 8 * fq;
        if (u.kind() == 1) { float* base = slabX + (size_t)u.sl() * XROWS * ldc + col0;
#pragma unroll
            for (int ai = 0; ai < 2; ++ai)
#pragma unroll
                for (int m = 0; m < 4; ++m) { const int r = ai * HALF + wr * 64 + m * 16 + fr; if (r < XROWS) { float* rowp = base + (size_t)r * ldc;
#pragma unroll
                    for (int bj = 0; bj < 2; ++bj) { *(f32x4*)(rowp + bj * HALF) = acc[ai][bj][m][0]; *(f32x4*)(rowp + bj * HALF + 4) = acc[ai][bj][m][1]; } } }
            return; }
        if (u.kind() == 2) { if (wc == 0 && fq < 2) { float* base = slabA + (size_t)u.sl() * 8192 * 16 + 8 * fq;
#pragma unroll
            for (int ai = 0; ai < 2; ++ai)
#pragma unroll
                for (int m = 0; m < 4; ++m) { float* p = base + (size_t)(row0 + ai * HALF + m * 16) * 16; *(f32x4*)p = acc[ai][0][m][0]; *(f32x4*)(p + 4) = acc[ai][0][m][1]; } }
            return; }
#pragma unroll
        for (int ai = 0; ai < 2; ++ai)
#pragma unroll
            for (int m = 0; m < 4; ++m) { bf16_t* rowp = O + (size_t)(row0 + ai * HALF + m * 16) * ldc + col0;
#pragma unroll
                for (int bj = 0; bj < 2; ++bj) { const f32x4 v0 = acc[ai][bj][m][0], v1 = acc[ai][bj][m][1];
                    u32x4 w; w.x = cvt_pk_bf16(v0[0], v0[1]); w.y = cvt_pk_bf16(v0[2], v0[3]); w.z = cvt_pk_bf16(v1[0], v1[1]); w.w = cvt_pk_bf16(v1[2], v1[3]);
                    *(u32x4*)(rowp + bj * HALF) = w; } }
    }
};
struct EpiResBf16 {
    static constexpr bool PERM = true, AFTER_DRAIN = false, I8 = false; typedef f32x4 acc_t;
    bf16_t* C; int ldc; const bf16_t* R; int ldr; float alpha; float* slab;
    __device__ __forceinline__ void operator()(const f32x4 (&acc)[2][2][4][2], const Unit& u, int wr, int wc, int fr, int fq) const {
        const int row0 = u.pm() * BM + wr * 64 + fr, col0 = u.pn() * BM + wc * 32 + 8 * fq;
        if (u.kind() != 0) {
#pragma unroll
            for (int m = 0; m < 4; ++m) { float* rowp = slab + ((size_t)u.sl() * 128 + wr * 64 + m * 16 + fr) * ldc + col0;
#pragma unroll
                for (int bj = 0; bj < 2; ++bj) { *(f32x4*)(rowp + bj * HALF) = acc[0][bj][m][0]; *(f32x4*)(rowp + bj * HALF + 4) = acc[0][bj][m][1]; } }
            return; }
#pragma unroll
        for (int ai = 0; ai < 2; ++ai) {
            u32x4 rvs[4][2];
#pragma unroll
            for (int m = 0; m < 4; ++m) { const bf16_t* rp = R + (size_t)(row0 + ai * HALF + m * 16) * ldr + col0; rvs[m][0] = __builtin_nontemporal_load((const u32x4*)rp); rvs[m][1] = __builtin_nontemporal_load((const u32x4*)(rp + HALF)); }
#pragma unroll
            for (int m = 0; m < 4; ++m) { const size_t row = (size_t)(row0 + ai * HALF + m * 16); bf16_t* rowp = C + row * ldc + col0;
#pragma unroll
                for (int bj = 0; bj < 2; ++bj) { const u32x4 rv = rvs[m][bj]; const f32x4 v0 = acc[ai][bj][m][0], v1 = acc[ai][bj][m][1];
                    u32x4 w; w.x = cvt_pk_bf16(v0[0] + alpha * bf_lo(rv.x), v0[1] + alpha * bf_hi(rv.x)); w.y = cvt_pk_bf16(v0[2] + alpha * bf_lo(rv.y), v0[3] + alpha * bf_hi(rv.y));
                    w.z = cvt_pk_bf16(v1[0] + alpha * bf_lo(rv.z), v1[1] + alpha * bf_hi(rv.z)); w.w = cvt_pk_bf16(v1[2] + alpha * bf_lo(rv.w), v1[3] + alpha * bf_hi(rv.w));
                    *(u32x4*)(rowp + bj * HALF) = w; } } }
    }
};
struct EpiSwiGLU {
    static constexpr bool PERM = true, AFTER_DRAIN = false, I8 = false; typedef f32x4 acc_t;
    bf16_t* O; int ldc; float* slab; int lds_;
    __device__ __forceinline__ void operator()(const f32x4 (&acc)[2][2][4][2], const Unit& u, int wr, int wc, int fr, int fq) const {
        const int row0 = u.pm() * BM + wr * 64 + fr, col0 = u.pn() * HALF + wc * 32 + 8 * fq;
        if (u.kind() != 0) {
#pragma unroll
            for (int m = 0; m < 4; ++m) { float* rowp = slab + ((size_t)u.sl() * 128 + wr * 64 + m * 16 + fr) * lds_ + u.pn() * BM + wc * 32 + 8 * fq;
#pragma unroll
                for (int bj = 0; bj < 2; ++bj) { *(f32x4*)(rowp + bj * HALF) = acc[0][bj][m][0]; *(f32x4*)(rowp + bj * HALF + 4) = acc[0][bj][m][1]; } }
            return; }
#pragma unroll
        for (int ai = 0; ai < 2; ++ai)
#pragma unroll
            for (int m = 0; m < 4; ++m) { bf16_t* rowp = O + (size_t)(row0 + ai * HALF + m * 16) * ldc + col0;
                const f32x4 g0 = acc[ai][0][m][0], g1 = acc[ai][0][m][1], u0 = acc[ai][1][m][0], u1 = acc[ai][1][m][1];
                u32x4 w; w.x = cvt_pk_bf16(silu_f(g0[0]) * u0[0], silu_f(g0[1]) * u0[1]); w.y = cvt_pk_bf16(silu_f(g0[2]) * u0[2], silu_f(g0[3]) * u0[3]);
                w.z = cvt_pk_bf16(silu_f(g1[0]) * u1[0], silu_f(g1[1]) * u1[1]); w.w = cvt_pk_bf16(silu_f(g1[2]) * u1[2], silu_f(g1[3]) * u1[3]);
                *(u32x4*)rowp = w; }
    }
};


typedef int i32x4e __attribute__((ext_vector_type(4)));
struct EpiSwiGLUi8 {
    static constexpr bool PERM = true, AFTER_DRAIN = false, I8 = true; typedef i32x4e acc_t;
    bf16_t* O; int ldc; float* slab; int lds_; const float* rs; const float* cm;
    __device__ __forceinline__ void operator()(const i32x4e (&acc)[2][2][4][2], const Unit& u, int wr, int wc, int fr, int fq) const {
        const int row0 = u.pm() * BM + wr * 64 + fr, col0 = u.pn() * HALF + wc * 32 + 8 * fq, gcol = u.pn() * BM + wc * 32 + 8 * fq;
        f32x4 cg0 = *(const f32x4*)(cm + gcol), cg1 = *(const f32x4*)(cm + gcol + 4), cu0 = *(const f32x4*)(cm + gcol + HALF), cu1 = *(const f32x4*)(cm + gcol + HALF + 4);
        cg0 *= (1.0f / 127.0f); cg1 *= (1.0f / 127.0f); cu0 *= (1.0f / 127.0f); cu1 *= (1.0f / 127.0f);
        if (u.kind() != 0) {
#pragma unroll
            for (int m = 0; m < 4; ++m) { const int r = wr * 64 + m * 16 + fr; const float s = rs[u.pm() * BM + r]; float* rowp = slab + ((size_t)u.sl() * 128 + r) * lds_ + gcol;
                const i32x4e a0 = acc[0][0][m][0], a1 = acc[0][0][m][1], b0 = acc[0][1][m][0], b1 = acc[0][1][m][1];
                *(f32x4*)(rowp) = (f32x4){(float)a0[0], (float)a0[1], (float)a0[2], (float)a0[3]} * cg0 * s; *(f32x4*)(rowp + 4) = (f32x4){(float)a1[0], (float)a1[1], (float)a1[2], (float)a1[3]} * cg1 * s;
                *(f32x4*)(rowp + HALF) = (f32x4){(float)b0[0], (float)b0[1], (float)b0[2], (float)b0[3]} * cu0 * s; *(f32x4*)(rowp + HALF + 4) = (f32x4){(float)b1[0], (float)b1[1], (float)b1[2], (float)b1[3]} * cu1 * s; }
            return; }
        float scs[2][4];
#pragma unroll
        for (int ai = 0; ai < 2; ++ai)
#pragma unroll
            for (int m = 0; m < 4; ++m) scs[ai][m] = rs[row0 + ai * HALF + m * 16];
#pragma unroll
        for (int ai = 0; ai < 2; ++ai)
#pragma unroll
            for (int m = 0; m < 4; ++m) { const int row = row0 + ai * HALF + m * 16; const float s = scs[ai][m]; bf16_t* rowp = O + (size_t)row * ldc + col0;
                const i32x4e a0 = acc[ai][0][m][0], a1 = acc[ai][0][m][1], b0 = acc[ai][1][m][0], b1 = acc[ai][1][m][1];
                const f32x4 g0 = (f32x4){(float)a0[0], (float)a0[1], (float)a0[2], (float)a0[3]} * cg0 * s, g1 = (f32x4){(float)a1[0], (float)a1[1], (float)a1[2], (float)a1[3]} * cg1 * s;
                const f32x4 u0 = (f32x4){(float)b0[0], (float)b0[1], (float)b0[2], (float)b0[3]} * cu0 * s, u1 = (f32x4){(float)b1[0], (float)b1[1], (float)b1[2], (float)b1[3]} * cu1 * s;
                const f32x4 y0 = (f32x4){silu_f(g0[0]) * u0[0], silu_f(g0[1]) * u0[1], silu_f(g0[2]) * u0[2], silu_f(g0[3]) * u0[3]}, y1 = (f32x4){silu_f(g1[0]) * u1[0], silu_f(g1[1]) * u1[1], silu_f(g1[2]) * u1[2], silu_f(g1[3]) * u1[3]};
                u32x4 w; w.x = cvt_pk_bf16(y0[0], y0[1]); w.y = cvt_pk_bf16(y0[2], y0[3]); w.z = cvt_pk_bf16(y1[0], y1[1]); w.w = cvt_pk_bf16(y1[2], y1[3]);
                *(u32x4*)rowp = w;
                }
    }
};
struct EpiResI8 {
    static constexpr bool PERM = true, AFTER_DRAIN = false, I8 = true; typedef i32x4e acc_t;
    bf16_t* C; int ldc; const bf16_t* R; int ldr; float alpha; float* slab; const float* amax; const float* cm;
    __device__ __forceinline__ void operator()(const i32x4e (&acc)[2][2][4][2], const Unit& u, int wr, int wc, int fr, int fq) const {
        const int row0 = u.pm() * BM + wr * 64 + fr, col0 = u.pn() * BM + wc * 32 + 8 * fq;
        f32x4 c00 = *(const f32x4*)(cm + col0), c01 = *(const f32x4*)(cm + col0 + 4), c10 = *(const f32x4*)(cm + col0 + HALF), c11 = *(const f32x4*)(cm + col0 + HALF + 4);
        const float k2 = 1.0f / (127.0f * 127.0f); c00 *= k2; c01 *= k2; c10 *= k2; c11 *= k2;
        if (u.kind() != 0) {
#pragma unroll
            for (int m = 0; m < 4; ++m) { const int r = wr * 64 + m * 16 + fr; const float s = amax[u.pm() * BM + r]; float* rowp = slab + ((size_t)u.sl() * 128 + r) * ldc + col0;
                const i32x4e a0 = acc[0][0][m][0], a1 = acc[0][0][m][1], b0 = acc[0][1][m][0], b1 = acc[0][1][m][1];
                *(f32x4*)(rowp) = (f32x4){(float)a0[0], (float)a0[1], (float)a0[2], (float)a0[3]} * c00 * s; *(f32x4*)(rowp + 4) = (f32x4){(float)a1[0], (float)a1[1], (float)a1[2], (float)a1[3]} * c01 * s;
                *(f32x4*)(rowp + HALF) = (f32x4){(float)b0[0], (float)b0[1], (float)b0[2], (float)b0[3]} * c10 * s; *(f32x4*)(rowp + HALF + 4) = (f32x4){(float)b1[0], (float)b1[1], (float)b1[2], (float)b1[3]} * c11 * s; }
            return; }
#pragma unroll
        for (int ai = 0; ai < 2; ++ai) {
            u32x4 rvs[4][2]; float scs[4];
#pragma unroll
            for (int m = 0; m < 4; ++m) { const size_t row = (size_t)(row0 + ai * HALF + m * 16); const bf16_t* rp = R + row * ldr + col0; scs[m] = amax[row]; rvs[m][0] = __builtin_nontemporal_load((const u32x4*)rp); rvs[m][1] = __builtin_nontemporal_load((const u32x4*)(rp + HALF)); }
#pragma unroll
            for (int m = 0; m < 4; ++m) { const size_t row = (size_t)(row0 + ai * HALF + m * 16); const float s = scs[m]; bf16_t* rowp = C + row * ldc + col0;
#pragma unroll
                for (int bj = 0; bj < 2; ++bj) { const u32x4 rv = rvs[m][bj]; const i32x4e a0 = acc[ai][bj][m][0], a1 = acc[ai][bj][m][1];
                    const f32x4 v0 = (f32x4){(float)a0[0], (float)a0[1], (float)a0[2], (float)a0[3]} * (bj ? c10 : c00) * s, v1 = (f32x4){(float)a1[0], (float)a1[1], (float)a1[2], (float)a1[3]} * (bj ? c11 : c01) * s;
                    u32x4 w; w.x = cvt_pk_bf16(v0[0] + alpha * bf_lo(rv.x), v0[1] + alpha * bf_hi(rv.x)); w.y = cvt_pk_bf16(v0[2] + alpha * bf_lo(rv.y), v0[3] + alpha * bf_hi(rv.y));
                    w.z = cvt_pk_bf16(v1[0] + alpha * bf_lo(rv.z), v1[1] + alpha * bf_hi(rv.z)); w.w = cvt_pk_bf16(v1[2] + alpha * bf_lo(rv.w), v1[3] + alpha * bf_hi(rv.w));
                    *(u32x4*)(rowp + bj * HALF) = w; } } }
    }
};

struct EpiBf16I8 {
    static constexpr bool PERM = true, AFTER_DRAIN = false, I8 = true; typedef i32x4e acc_t;
    bf16_t* O; int ldc; float* slabX; const float* rs; const float* cm; int nwrap, wrapoff;
    __device__ __forceinline__ void operator()(const i32x4e (&acc)[2][2][4][2], const Unit& u, int wr, int wc, int fr, int fq) const {
        const int row0 = u.pm() * BM + wr * 64 + fr, col0 = u.pn() * BM + wc * 32 + 8 * fq, ocol = u.pn() < nwrap ? col0 : col0 + wrapoff;
        f32x4 c00 = *(const f32x4*)(cm + col0), c01 = *(const f32x4*)(cm + col0 + 4), c10 = *(const f32x4*)(cm + col0 + HALF), c11 = *(const f32x4*)(cm + col0 + HALF + 4);
        c00 *= (1.0f / 127.0f); c01 *= (1.0f / 127.0f); c10 *= (1.0f / 127.0f); c11 *= (1.0f / 127.0f);
        if (u.kind() != 0) { float* base = slabX + (size_t)u.sl() * XROWS * ldc + col0;
#pragma unroll
            for (int ai = 0; ai < 2; ++ai)
#pragma unroll
                for (int m = 0; m < 4; ++m) { const int r = ai * HALF + wr * 64 + m * 16 + fr; if (r < XROWS) { const float s = rs[u.pm() * BM + r]; float* rowp = base + (size_t)r * ldc;
                    const i32x4e a0 = acc[ai][0][m][0], a1 = acc[ai][0][m][1], b0 = acc[ai][1][m][0], b1 = acc[ai][1][m][1];
                    *(f32x4*)(rowp) = (f32x4){(float)a0[0], (float)a0[1], (float)a0[2], (float)a0[3]} * c00 * s; *(f32x4*)(rowp + 4) = (f32x4){(float)a1[0], (float)a1[1], (float)a1[2], (float)a1[3]} * c01 * s;
                    *(f32x4*)(rowp + HALF) = (f32x4){(float)b0[0], (float)b0[1], (float)b0[2], (float)b0[3]} * c10 * s; *(f32x4*)(rowp + HALF + 4) = (f32x4){(float)b1[0], (float)b1[1], (float)b1[2], (float)b1[3]} * c11 * s; } }
            return; }
        float scs[2][4];
#pragma unroll
        for (int ai = 0; ai < 2; ++ai)
#pragma unroll
            for (int m = 0; m < 4; ++m) scs[ai][m] = rs[row0 + ai * HALF + m * 16];
#pragma unroll
        for (int ai = 0; ai < 2; ++ai)
#pragma unroll
            for (int m = 0; m < 4; ++m) { const int row = row0 + ai * HALF + m * 16; const float s = scs[ai][m]; bf16_t* rowp = O + (size_t)row * ldc + ocol;
#pragma unroll
                for (int bj = 0; bj < 2; ++bj) { const i32x4e a0 = acc[ai][bj][m][0], a1 = acc[ai][bj][m][1];
                    const f32x4 v0 = (f32x4){(float)a0[0], (float)a0[1], (float)a0[2], (float)a0[3]} * (bj ? c10 : c00) * s, v1 = (f32x4){(float)a1[0], (float)a1[1], (float)a1[2], (float)a1[3]} * (bj ? c11 : c01) * s;
                    u32x4 w; w.x = cvt_pk_bf16(v0[0], v0[1]); w.y = cvt_pk_bf16(v0[2], v0[3]); w.z = cvt_pk_bf16(v1[0], v1[1]); w.w = cvt_pk_bf16(v1[2], v1[3]);
                    *(u32x4*)(rowp + bj * HALF) = w; } }
    }
};
typedef int i32x4 __attribute__((ext_vector_type(4)));
template <bool I8> struct Mma16;
template <> struct Mma16<false> { static __device__ __forceinline__ f32x4 run(bf16x8 a, bf16x8 b, f32x4 c) { return __builtin_amdgcn_mfma_f32_16x16x32_bf16(a, b, c, 0, 0, 0); } };
template <> struct Mma16<true> { static __device__ __forceinline__ i32x4 run(bf16x8 a, bf16x8 b, i32x4 c) { return __builtin_amdgcn_mfma_i32_16x16x64_i8(__builtin_bit_cast(i32x4, a), __builtin_bit_cast(i32x4, b), c, 0, 0, 0); } };
template <bool I8, class T> __device__ __forceinline__ T mma16(bf16x8 a, bf16x8 b, T c) { return Mma16<I8>::run(a, b, c); }
struct NoSide { static constexpr int NV = 0; __device__ __forceinline__ void step() {} __device__ __forceinline__ void consume() {} };
template <class Epi, class Sched, bool ALIGN_EPI, bool SP2, class Side>
__device__ __forceinline__ void gemm_phase(PG8_LAS unsigned char* lds, const Gemm g, const Sched& S, const Epi& E, Side& sd) {
    int tid_ = g.wave * 64 + (int)__builtin_amdgcn_mbcnt_hi(~0u, __builtin_amdgcn_mbcnt_lo(~0u, 0u)); asm volatile("" : "+v"(tid_));
    const int tid = tid_, wid = __builtin_amdgcn_readfirstlane(tid >> 6), lane = tid & 63, wr = wid >> 2, wc = wid & 3, fr = lane & 15, fq = lane >> 4;
    const int K = g.K;
    unsigned voffA[2], voffB[2];
#pragma unroll
    for (int i = 0; i < 2; ++i) { int R, C; stage_rc(tid * 16 + i * 8192, R, C); const int Rb = Epi::PERM ? ((R & ~31) + perm32(R & 31)) : R;
        voffA[i] = (unsigned)(R * K + C) * 2u; voffB[i] = (unsigned)(Rb * K + C) * 2u; }
    const size_t kstep = (size_t)(BK * 2);
    const size_t hstep = (size_t)HALF * K * 2;
    const size_t tstep = 2 * hstep;
    const unsigned ldsw = (unsigned)wid * 1024u;
    const int aoff = lds_byte(wr * 64 + fr, fq * 8), boff = lds_byte(wc * 32 + fr, fq * 8);
#define PG8_SA(b, h) (((b) * 2 + (h)) * HTB)
#define PG8_SB(b, h) ((4 + (b) * 2 + (h)) * HTB)
#define PG8_STAGE(bufoff, gbase, voff) do { _Pragma("unroll") for (int _i = 0; _i < 2; ++_i) \
        __builtin_amdgcn_global_load_lds((const unsigned*)((const char*)(gbase) + (voff)[_i]), (PG8_LAS unsigned*)(lds + (bufoff) + ldsw + _i * 8192), 16, 0, 0); } while (0)
#define PG8_LDA(dst, b, h) do { _Pragma("unroll") for (int m = 0; m < 4; ++m) _Pragma("unroll") for (int k = 0; k < 2; ++k) dst[m][k] = *(const PG8_LAS bf16x8*)(lds + PG8_SA(b, h) + aoff + m * 2048 + k * 1024); } while (0)
#define PG8_LDB(dst, b, h) do { _Pragma("unroll") for (int n = 0; n < 2; ++n) _Pragma("unroll") for (int k = 0; k < 2; ++k) dst[n][k] = *(const PG8_LAS bf16x8*)(lds + PG8_SB(b, h) + boff + n * 2048 + k * 1024); } while (0)
#define PG8_MMA(ai, bj, At, Bt) do { __builtin_amdgcn_s_setprio(1); _Pragma("unroll") for (int m = 0; m < 4; ++m) _Pragma("unroll") for (int n = 0; n < 2; ++n) _Pragma("unroll") for (int k = 0; k < 2; ++k) \
        acc[ai][bj][m][n] = mma16<Epi::I8>(Bt[n][k], At[m][k], acc[ai][bj][m][n]); __builtin_amdgcn_s_setprio(0); } while (0)
#define PG8_WAIT_V(n) asm volatile("s_waitcnt vmcnt(" #n ")" ::: "memory")
#define PG8_WAIT_VS() asm volatile("s_waitcnt vmcnt(%0)" :: "n"(8 + Side::NV) : "memory")
#define PG8_WAIT_L(n) asm volatile("s_waitcnt lgkmcnt(" #n ")" ::: "memory")
#define PG8_BAR __builtin_amdgcn_s_barrier()
#define PG8_SCHED __builtin_amdgcn_sched_barrier(0)
    Unit cur, nxt; int ui = 0;
    if (!S.next(0, cur)) return;
    typedef typename Epi::acc_t acc_t;
    acc_t acc[2][2][4][2];
#pragma unroll
    for (int a = 0; a < 2; ++a)
#pragma unroll
        for (int b = 0; b < 2; ++b)
#pragma unroll
            for (int m = 0; m < 4; ++m)
#pragma unroll
                for (int n = 0; n < 2; ++n) acc[a][b][m][n] = (acc_t){0, 0, 0, 0};
    bf16x8 At[4][2], B0[2][2], B1[2][2];
    const char* cA = (const char*)g.A + (size_t)cur.pm() * tstep + (size_t)cur.k0() * kstep; const char* cB = (const char*)g.Bt + (size_t)cur.pn() * tstep + (size_t)cur.k0() * kstep;
    S.a_ready(cur);
    if constexpr (SP2) {
        PG8_STAGE(PG8_SB(0, 0), cB, voffB); PG8_STAGE(PG8_SB(0, 1), cB + hstep, voffB); PG8_STAGE(PG8_SA(0, 0), cA, voffA); PG8_STAGE(PG8_SA(0, 1), cA + hstep, voffA);
        if (wr == 1) PG8_BAR;
        PG8_WAIT_V(2); PG8_BAR;
        PG8_STAGE(PG8_SB(1, 0), cB + kstep, voffB); PG8_STAGE(PG8_SA(1, 0), cA + kstep, voffA); PG8_STAGE(PG8_SB(1, 1), cB + hstep + kstep, voffB);
        PG8_WAIT_V(6); PG8_BAR;
    } else {
        PG8_STAGE(PG8_SB(0, 0), cB, voffB); PG8_STAGE(PG8_SA(0, 0), cA, voffA); PG8_STAGE(PG8_SB(0, 1), cB + hstep, voffB); PG8_STAGE(PG8_SA(0, 1), cA + hstep, voffA);
        if (wr == 1) PG8_BAR;
        PG8_WAIT_V(4); PG8_BAR;
        PG8_STAGE(PG8_SB(1, 0), cB + kstep, voffB); PG8_STAGE(PG8_SA(1, 0), cA + kstep, voffA); PG8_STAGE(PG8_SB(1, 1), cB + hstep + kstep, voffB);
        PG8_WAIT_V(6); PG8_BAR;
    }
    for (;;) {
        const bool has_next = S.next(ui + 1, nxt);
        const char* nA = has_next ? (const char*)g.A + (size_t)nxt.pm() * tstep + (size_t)nxt.k0() * kstep : cA; const char* nB = has_next ? (const char*)g.Bt + (size_t)nxt.pn() * tstep + (size_t)nxt.k0() * kstep : cB;
        const int nt = cur.nt();
        for (int t = 0; t < nt; t += 2) {
            const bool last = (t == nt - 2);
            const char* a1 = cA + (size_t)(t + 1) * kstep;
            const char* a2 = last ? nA : cA + (size_t)(t + 2) * kstep; const char* b2 = last ? nB : cB + (size_t)(t + 2) * kstep;
            const char* a3 = a2 + kstep; const char* b3 = b2 + kstep;
            if (last && has_next) S.a_ready(nxt);
            if constexpr (SP2) {
            sd.step(); PG8_SCHED;
            PG8_LDB(B0, 0, 0); PG8_LDB(B1, 0, 1); PG8_SCHED; PG8_LDA(At, 0, 0); PG8_STAGE(PG8_SA(1, 1), a1 + hstep, voffA);
            PG8_WAIT_VS(); PG8_WAIT_L(0); PG8_BAR; PG8_MMA(0, 0, At, B0); PG8_MMA(0, 1, At, B1); PG8_BAR; PG8_SCHED;
            PG8_LDA(At, 0, 1); PG8_STAGE(PG8_SB(0, 0), b2, voffB); PG8_STAGE(PG8_SB(0, 1), b2 + hstep, voffB); PG8_STAGE(PG8_SA(0, 0), a2, voffA);
            PG8_WAIT_VS(); PG8_WAIT_L(0); PG8_BAR; PG8_MMA(1, 0, At, B0); PG8_MMA(1, 1, At, B1); PG8_BAR; PG8_SCHED;
            PG8_LDB(B0, 1, 0); PG8_LDB(B1, 1, 1); PG8_SCHED; PG8_LDA(At, 1, 0); PG8_STAGE(PG8_SA(0, 1), a2 + hstep, voffA);
            PG8_WAIT_V(8); PG8_WAIT_L(0); PG8_BAR; if constexpr (Side::NV > 0) { PG8_SCHED; sd.consume(); PG8_SCHED; }
            PG8_MMA(0, 0, At, B0); PG8_MMA(0, 1, At, B1); PG8_BAR; PG8_SCHED;
            PG8_LDA(At, 1, 1); PG8_STAGE(PG8_SB(1, 0), b3, voffB); PG8_STAGE(PG8_SB(1, 1), b3 + hstep, voffB); PG8_STAGE(PG8_SA(1, 0), a3, voffA);
            PG8_WAIT_V(8); PG8_WAIT_L(0); PG8_BAR; PG8_MMA(1, 0, At, B0); PG8_MMA(1, 1, At, B1); PG8_BAR; PG8_SCHED;
            } else {
            PG8_LDB(B0, 0, 0); PG8_SCHED; PG8_LDA(At, 0, 0); PG8_STAGE(PG8_SA(1, 1), a1 + hstep, voffA);
            PG8_WAIT_L(8); PG8_BAR; PG8_WAIT_L(0); PG8_MMA(0, 0, At, B0); PG8_BAR; PG8_SCHED;
            PG8_LDB(B1, 0, 1); PG8_STAGE(PG8_SB(0, 0), b2, voffB);
            PG8_BAR; PG8_WAIT_L(0); PG8_MMA(0, 1, At, B1); PG8_BAR;
            PG8_LDA(At, 0, 1); PG8_STAGE(PG8_SA(0, 0), a2, voffA);
            PG8_BAR; PG8_WAIT_L(0); PG8_MMA(1, 0, At, B0); PG8_BAR; PG8_SCHED;
            PG8_STAGE(PG8_SB(0, 1), b2 + hstep, voffB);
            PG8_WAIT_V(6); PG8_BAR; PG8_MMA(1, 1, At, B1); PG8_BAR;
            PG8_LDB(B0, 1, 0); PG8_SCHED; PG8_LDA(At, 1, 0); PG8_STAGE(PG8_SA(0, 1), a2 + hstep, voffA);
            PG8_WAIT_L(8); PG8_BAR; PG8_WAIT_L(0); PG8_MMA(0, 0, At, B0); PG8_BAR; PG8_SCHED;
            PG8_LDB(B1, 1, 1); PG8_STAGE(PG8_SB(1, 0), b3, voffB);
            PG8_BAR; PG8_WAIT_L(0); PG8_MMA(0, 1, At, B1); PG8_BAR;
            PG8_LDA(At, 1, 1); PG8_STAGE(PG8_SA(1, 0), a3, voffA);
            PG8_BAR; PG8_WAIT_L(0); PG8_MMA(1, 0, At, B0); PG8_BAR; PG8_SCHED;
            PG8_STAGE(PG8_SB(1, 1), b3 + hstep, voffB);
            PG8_WAIT_V(6); PG8_BAR; PG8_MMA(1, 1, At, B1); PG8_BAR;
            }
        }
        if constexpr (ALIGN_EPI) { if (wr == 0) PG8_BAR; }
        if constexpr (!Epi::AFTER_DRAIN) { int fr_ = fr, fq_ = fq; asm volatile("" : "+v"(fr_), "+v"(fq_));
            E(acc, cur, wr, wc, fr_, fq_); S.done(cur); }
        if (!has_next) break;
#pragma unroll
        for (int a = 0; a < 2; ++a)
#pragma unroll
            for (int b = 0; b < 2; ++b)
#pragma unroll
                for (int m = 0; m < 4; ++m)
#pragma unroll
                    for (int n = 0; n < 2; ++n) acc[a][b][m][n] = (acc_t){0, 0, 0, 0};
        cur = nxt; cA = nA; cB = nB; ++ui;
        if constexpr (ALIGN_EPI) { if (wr == 1) PG8_BAR; }
    }
    PG8_WAIT_V(0);
    if constexpr (!ALIGN_EPI) { if (wr == 0) PG8_BAR; }
    PG8_BAR;
    if constexpr (Epi::AFTER_DRAIN) { E.fused(acc, cur, wr, wc, fr, fq, lds, wid, lane); S.done(cur); }
#undef PG8_SA
#undef PG8_SB
#undef PG8_STAGE
#undef PG8_LDA
#undef PG8_LDB
#undef PG8_MMA
#undef PG8_WAIT_V
#undef PG8_WAIT_L
#undef PG8_WAIT_VS
#undef PG8_BAR
#undef PG8_SCHED
}
template <class Epi, class Sched, bool ALIGN_EPI = false, bool SP2 = false>
__device__ __forceinline__ void gemm_phase(PG8_LAS unsigned char* lds, const Gemm g, const Sched& S, const Epi& E) { NoSide ns; gemm_phase<Epi, Sched, ALIGN_EPI, SP2, NoSide>(lds, g, S, E, ns); }
}

#ifndef PG8_SP2
#define PG8_SP2 true
#endif
#ifndef PG8_ALIGN
#define PG8_ALIGN true
#endif
#define GAS __attribute__((address_space(1)))
#define LAS __attribute__((address_space(3)))
typedef unsigned short bf16;
typedef unsigned v4u __attribute__((ext_vector_type(4)));
typedef float f32x4 __attribute__((ext_vector_type(4)));
typedef short bf16x8 __attribute__((ext_vector_type(8)));
typedef GAS unsigned gu32;
typedef GAS unsigned long long gu64;
#define RLX_AGENT __ATOMIC_RELAXED, __HIP_MEMORY_SCOPE_AGENT
#define LDS_WAIT() asm volatile("s_waitcnt lgkmcnt(0)" ::: "memory")
#define VM_WAIT() asm volatile("s_waitcnt vmcnt(0)" ::: "memory")
__device__ __forceinline__ unsigned long long rt() { return __builtin_amdgcn_s_memrealtime(); }
__device__ __forceinline__ unsigned f2bf(float f) { unsigned u = __builtin_bit_cast(unsigned, f); return (u + 0x7fffu + ((u >> 16) & 1u)) >> 16; }
__device__ __forceinline__ unsigned pk2(float lo, float hi) { return f2bf(lo) | (f2bf(hi) << 16); }

#define XB_TMO      128
#define XB_XCNT(j)  (256  + 64 * (j))
#define XB_XSUB(j)  (1280 + 64 * (j))
#define XB_XGEN(j)  (2304 + 64 * (j))
#define XB_TOP      3328
#define XB_TOPGEN   3392
#define XCD_BAR_WORDS 3456
#define XB_SPIN_CAP (1u << 18)

__device__ __forceinline__ unsigned xb_ld(unsigned* p)              { return __hip_atomic_load(p, __ATOMIC_RELAXED, __HIP_MEMORY_SCOPE_AGENT); }
__device__ __forceinline__ unsigned xb_add(unsigned* p, unsigned v) { return __hip_atomic_fetch_add(p, v, __ATOMIC_RELAXED, __HIP_MEMORY_SCOPE_AGENT); }
__device__ __forceinline__ unsigned xb_xcc_id() { return (unsigned)__builtin_amdgcn_s_getreg((3 << 11) | 20) & 0xFu; }
#define XB_SPIN(cond, bar) do { unsigned _sp = 0; while (cond) { __builtin_amdgcn_s_sleep(1); \
    if ((++_sp & 255u) == 0u) { if (xb_ld(&(bar)[XB_TMO])) break; if (_sp > XB_SPIN_CAP) { atomicAdd(&(bar)[XB_TMO], 1u); break; } } } } while (0)

struct XcdBarrier {
    unsigned* bar; unsigned x; unsigned w;
    volatile LAS unsigned* st;
};

__device__ __forceinline__ XcdBarrier xcd_barrier_post(unsigned* bar, volatile LAS unsigned* st) {
    XcdBarrier b; b.bar = bar; b.x = xb_xcc_id(); b.st = st; b.w = (unsigned)__builtin_amdgcn_readfirstlane((int)(threadIdx.x >> 6));
    if (threadIdx.x == 0) (void)xb_add(&bar[XB_XCNT(b.x)], 1u);
    return b;
}
__device__ __forceinline__ void xcd_barrier_complete(unsigned* bar, unsigned x, unsigned& nloc, unsigned& nx) {
    const unsigned G = gridDim.x * gridDim.y * gridDim.z;
    unsigned sum, cnt, mine, sp = 0u;
    for (;;) {
        sum = 0u; cnt = 0u; mine = 0u;
#pragma unroll
        for (unsigned j = 0; j < 16; ++j) { const unsigned c = xb_ld(&bar[XB_XCNT(j)]); sum += c; cnt += (c > 0u) ? 1u : 0u; mine = (j == x) ? c : mine; }
        if (sum == G) break;
        __builtin_amdgcn_s_sleep(1);
        if ((++sp & 255u) == 0u) { if (xb_ld(&bar[XB_TMO])) break; if (sp > XB_SPIN_CAP) { atomicAdd(&bar[XB_TMO], 1u); break; } }
    }
    nloc = mine > 0u ? mine : 1u; nx = cnt > 0u ? cnt : 1u;
}

__device__ __forceinline__ void xcd_barrier(const XcdBarrier& b) {
    asm volatile("s_waitcnt vmcnt(0)" ::: "memory");
    __syncthreads();
    if (b.w == 0u && __builtin_amdgcn_mbcnt_hi(~0u, __builtin_amdgcn_mbcnt_lo(~0u, 0u)) == 0u) {
        unsigned* bar = b.bar;
        __builtin_amdgcn_s_waitcnt(0);
        unsigned nloc = b.st[0], nx = b.st[1];
        if (nloc == 0u) { xcd_barrier_complete(bar, b.x, nloc, nx); b.st[0] = nloc; b.st[1] = nx; }
        const unsigned old = xb_add(&bar[XB_XSUB(b.x)], 1u);
        const unsigned gen = old / nloc;
        if (old + 1u == (gen + 1u) * nloc) {
            __builtin_amdgcn_fence(__ATOMIC_RELEASE, "agent");
            asm volatile("s_waitcnt vmcnt(0)" ::: "memory");
            const unsigned og = xb_add(&bar[XB_TOP], 1u);
            const unsigned tg = og / nx;
            if (og + 1u == (tg + 1u) * nx) xb_add(&bar[XB_TOPGEN], 1u);
            else XB_SPIN(xb_ld(&bar[XB_TOPGEN]) == tg, bar);
            __builtin_amdgcn_fence(__ATOMIC_ACQUIRE, "agent");
            xb_add(&bar[XB_XGEN(b.x)], 1u);
            asm volatile("s_waitcnt vmcnt(0)" ::: "memory");
        } else {
            XB_SPIN(xb_ld(&bar[XB_XGEN(b.x)]) == gen, bar);
            __builtin_amdgcn_fence(__ATOMIC_ACQUIRE, "agent");
            asm volatile("s_waitcnt vmcnt(0)" ::: "memory");
        }
    }
    __syncthreads();
}

constexpr int NWAVES = 8;
constexpr int NCONV_CU = 0;
constexpr int D = 4096, NBATCH = 4, SEQ = 2048, NSAMP = 128, NMETA = 16;
constexpr int MPR = NBATCH * SEQ;
constexpr int ROW_S = MPR;
constexpr int ROW_META = MPR + NSAMP;
constexpr int MROWS = ROW_META + NMETA;
constexpr int MPAD = 8448;
constexpr int NIN = 12544;
constexpr int C_K = 0, C_V = 1024, C_CC = 3072, C_CH = 5120, C_AL = 7168, NBF = 7424, C_Q = 7424, C_G = 8448, C_CB = 10496, NI8X = 5120, NI8 = 9216;
static_assert(NBF + NI8X == 12544, "in-proj width");
constexpr int XROWS = pg8::XROWS;
constexpr int DFF = 11008, NGU = 2 * DFF;
constexpr int NH = 4, DK = 256, DV = 512, DGV = 2048, DCONV = 2048, RANK = 16, DGK = 1024;
constexpr float ALPHA = 1.18920711500272f;
constexpr float LN_EPS = 1e-5f, RMS_EPS = 1e-6f;
constexpr size_t O_YP = 0, O_YS = (size_t)MPR * D, O_GP = O_YS + (size_t)NSAMP * D, O_CP = O_GP + (size_t)NBATCH * NH * DK * DV,
                 O_GS = O_CP + (size_t)NBATCH * 2 * DCONV, O_CS = O_GS + (size_t)NSAMP * NH * DK * DV, O_END = O_CS + (size_t)NSAMP * 2 * DCONV;
constexpr size_t MiB = 1u << 20;
constexpr size_t WS_CTL = 0, CTL_ZERO_BYTES = 1 * MiB;
constexpr size_t WS_WIN = 1 * MiB;
constexpr size_t WS_WOUT = WS_WIN + 98 * MiB;
constexpr size_t WS_WGU = WS_WOUT + 32 * MiB;
constexpr size_t WS_WDN = WS_WGU + 172 * MiB;
constexpr size_t WS_H0 = WS_WDN + 86 * MiB;
constexpr size_t WS_PROJ = WS_H0 + 66 * MiB;
constexpr size_t WS_MIX = WS_PROJ + 203 * MiB;
constexpr size_t WS_OBUF = WS_MIX + 66 * MiB;
constexpr size_t WS_R = WS_OBUF + 33 * MiB;
constexpr size_t WS_SLAB = WS_R + 132 * MiB;
constexpr size_t WS_H1Q = WS_SLAB + 48 * MiB;
constexpr size_t WS_END = WS_H1Q + 34 * MiB;
constexpr size_t CTL_RS0 = 800 * 1024, CTL_CMIN = 840 * 1024;
constexpr size_t CTL_AMAX = 704 * 1024, CTL_CMDN = 768 * 1024;
constexpr size_t CTL_CMAX = 512 * 1024, CTL_RSC = 640 * 1024;
constexpr size_t SLAB_A_OFF = 24 * MiB;
static_assert((size_t)NIN * D * 2 <= 98 * MiB && (size_t)NGU * D * 2 <= 172 * MiB && (size_t)D * DFF * 2 <= 86 * MiB && (size_t)MPAD * D * 2 <= 66 * MiB && (size_t)MPAD * NIN * 2 <= 203 * MiB && (size_t)MPAD * D * 4 <= 132 * MiB, "ws map");
constexpr int CW_BAR = 4096;
constexpr int RING_OFF = 0, RING_BYTES = 131072;
constexpr int LDSCTL_OFF = RING_BYTES, MISC_OFF = LDSCTL_OFF + 320;
constexpr int LDS_BYTES = 147456;
static_assert(MISC_OFF + 128 <= LDS_BYTES, "LDS map");

__device__ __forceinline__ unsigned long long karg(int i) {
    const unsigned long long ka = (unsigned long long)__builtin_amdgcn_kernarg_segment_ptr(); unsigned long long p;
    asm volatile("s_load_dwordx2 %0, %1, %2\n\ts_waitcnt lgkmcnt(0)" : "=s"(p) : "s"(ka), "n"(i * 8) : "memory");
    return p;
}
enum { A_XP = 0, A_XS, A_SGLA, A_SCONV, A_META, A_EMBG, A_EMBB, A_WIN, A_WA2, A_BA, A_GNORM, A_CONVW, A_WOUT, A_LN1G, A_LN1B, A_WGATE, A_WUP, A_WDOWN, A_LN2G, A_LN2B, A_OUT, A_WS };
struct Frame {
    LAS unsigned char* lds;
    volatile LAS unsigned* MISC;
    gu32* ctl;
    int tid, lane, wave;
    int vcu, G;
    __device__ __forceinline__ void refresh() { int l = (int)__builtin_amdgcn_mbcnt_hi(~0u, __builtin_amdgcn_mbcnt_lo(~0u, 0u)); asm volatile("" : "+v"(l)); lane = l; tid = wave * 64 + l;   int g = G; asm volatile("" : "+s"(g)); G = g; }
    unsigned char* ws;
    template <int I> __device__ __forceinline__ const float* in() const { return (const float*)(const GAS float*)karg(I); }
    __device__ __forceinline__ float* out() const { return (float*)(GAS float*)karg(A_OUT); }
    __device__ __forceinline__ bf16* Wt_in() const { return (bf16*)(ws + WS_WIN); }
    __device__ __forceinline__ bf16* Wt_out() const { return (bf16*)(ws + WS_WOUT); }
    __device__ __forceinline__ bf16* Wt_gu() const { return (bf16*)(ws + WS_WGU); }
    __device__ __forceinline__ bf16* Wt_dn() const { return (bf16*)(ws + WS_WDN); }
    __device__ __forceinline__ bf16* h0() const { return (bf16*)(ws + WS_H0); }
    __device__ __forceinline__ bf16* proj() const { return (bf16*)(ws + WS_PROJ); }
    __device__ __forceinline__ bf16* act() const { return (bf16*)(ws + WS_PROJ); }
    __device__ __forceinline__ bf16* mix() const { return (bf16*)(ws + WS_MIX); }
    __device__ __forceinline__ bf16* h1() const { return (bf16*)(ws + WS_MIX); }
    __device__ __forceinline__ bf16* obuf() const { return (bf16*)(ws + WS_OBUF); }
    __device__ __forceinline__ bf16* R() const { return (bf16*)(ws + WS_R); }
    __device__ __forceinline__ unsigned char* gscr() const { return ws + WS_R; }
    __device__ __forceinline__ float* slab() const { return (float*)(ws + WS_SLAB); }
    __device__ __forceinline__ signed char* h1q() const { return (signed char*)(ws + WS_H1Q); }
    __device__ __forceinline__ float* cmax() const { return (float*)(ws + WS_CTL + CTL_CMAX); }
    __device__ __forceinline__ float* rsc() const { return (float*)(ws + WS_CTL + CTL_RSC); }
    __device__ __forceinline__ float* amax() const { return (float*)(ws + WS_CTL + CTL_AMAX); }
    __device__ __forceinline__ float* rs0() const { return (float*)(ws + WS_CTL + CTL_RS0); }
    __device__ __forceinline__ float* cmin() const { return (float*)(ws + WS_CTL + CTL_CMIN); }
    __device__ __forceinline__ signed char* h0q() const { return (signed char*)(ws + WS_WGU); }
    __device__ __forceinline__ signed char* Wq_in() const { return (signed char*)(ws + WS_WDN); }
    __device__ __forceinline__ float* cmdn() const { return (float*)(ws + WS_CTL + CTL_CMDN); }
    __device__ __forceinline__ signed char* actq() const { return (signed char*)(ws + WS_WIN); }
};
typedef unsigned u32x2v __attribute__((ext_vector_type(2)));
__device__ __forceinline__ float wave_sum(float v) {
#pragma unroll
    for (int o = 1; o < 64; o <<= 1) v += __shfl_xor(v, o);
    return v;
}
__device__ __forceinline__ unsigned q4(float a, float b, float c, float d, float inv) {
    int x = __float2int_rn(a * inv), y = __float2int_rn(b * inv), z = __float2int_rn(c * inv), w = __float2int_rn(d * inv);
    x = min(max(x, -127), 127); y = min(max(y, -127), 127); z = min(max(z, -127), 127); w = min(max(w, -127), 127);
    return (unsigned)(x & 0xff) | ((unsigned)(y & 0xff) << 8) | ((unsigned)(z & 0xff) << 16) | ((unsigned)(w & 0xff) << 24);
}
__device__ __forceinline__ float wave_max(float v) {
#pragma unroll
    for (int o = 1; o < 64; o <<= 1) v = fmaxf(v, __shfl_xor(v, o));
    return v;
}
__device__ __forceinline__ float bflo(unsigned w) { return __uint_as_float(w << 16); }
__device__ __forceinline__ float bfhi(unsigned w) { return __uint_as_float(w & 0xffff0000u); }
__device__ __forceinline__ float bf2f(bf16 h) { return __uint_as_float(((unsigned)h) << 16); }
__device__ __forceinline__ float silu(float a) { return a * __builtin_amdgcn_rcpf(1.0f + __builtin_amdgcn_exp2f(-1.44269504089f * a)); }
__device__ __forceinline__ float logsigmoid(float z) { return fminf(z, 0.f) - __logf(1.0f + __expf(-fabsf(z))); }
__device__ __forceinline__ void unpack8(const v4u w, float (&f)[8]) { f[0] = bflo(w.x); f[1] = bfhi(w.x); f[2] = bflo(w.y); f[3] = bfhi(w.y); f[4] = bflo(w.z); f[5] = bfhi(w.z); f[6] = bflo(w.w); f[7] = bfhi(w.w); }
__device__ __forceinline__ v4u pack8(const float (&f)[8]) { v4u w; w.x = pk2(f[0], f[1]); w.y = pk2(f[2], f[3]); w.z = pk2(f[4], f[5]); w.w = pk2(f[6], f[7]); return w; }

__device__ __forceinline__ void p0_transpose_item(const float* W, int ldw, int src_col0, int nvalid, bf16* WT, int K, int dst_row0, int k0, int lane, unsigned* cm = nullptr) {
    const int ng = lane & 7, kg = lane >> 3;
    f32x4 x[8];
    const float* src = W + (size_t)(k0 + 8 * kg) * ldw + src_col0 + 4 * ng;
    if (4 * ng < nvalid) {
#pragma unroll
        for (int i = 0; i < 8; ++i) x[i] = __builtin_nontemporal_load((const f32x4*)(src + (size_t)i * ldw));
    } else {
#pragma unroll
        for (int i = 0; i < 8; ++i) x[i] = (f32x4){0.f, 0.f, 0.f, 0.f};
    }
    if (cm) { f32x4 m = (f32x4){0.f, 0.f, 0.f, 0.f};
#pragma unroll
        for (int i = 0; i < 8; ++i) { m.x = fmaxf(m.x, fabsf(x[i].x)); m.y = fmaxf(m.y, fabsf(x[i].y)); m.z = fmaxf(m.z, fabsf(x[i].z)); m.w = fmaxf(m.w, fabsf(x[i].w)); }
#pragma unroll
        for (int o = 8; o < 64; o <<= 1) { m.x = fmaxf(m.x, __shfl_xor(m.x, o)); m.y = fmaxf(m.y, __shfl_xor(m.y, o)); m.z = fmaxf(m.z, __shfl_xor(m.z, o)); m.w = fmaxf(m.w, __shfl_xor(m.w, o)); }
        if (kg == 0) { unsigned* c = cm + 4 * ng; __hip_atomic_fetch_max(c + 0, __float_as_uint(m.x), __ATOMIC_RELAXED, __HIP_MEMORY_SCOPE_AGENT); __hip_atomic_fetch_max(c + 1, __float_as_uint(m.y), __ATOMIC_RELAXED, __HIP_MEMORY_SCOPE_AGENT);
            __hip_atomic_fetch_max(c + 2, __float_as_uint(m.z), __ATOMIC_RELAXED, __HIP_MEMORY_SCOPE_AGENT); __hip_atomic_fetch_max(c + 3, __float_as_uint(m.w), __ATOMIC_RELAXED, __HIP_MEMORY_SCOPE_AGENT); } }
    bf16* dst = WT + (size_t)(dst_row0 + 4 * ng) * K + k0 + 8 * kg;
    { v4u o; o.x = pk2(x[0].x, x[1].x); o.y = pk2(x[2].x, x[3].x); o.z = pk2(x[4].x, x[5].x); o.w = pk2(x[6].x, x[7].x); *(GAS v4u*)(dst) = o; }
    { v4u o; o.x = pk2(x[0].y, x[1].y); o.y = pk2(x[2].y, x[3].y); o.z = pk2(x[4].y, x[5].y); o.w = pk2(x[6].y, x[7].y); *(GAS v4u*)(dst + (size_t)K) = o; }
    { v4u o; o.x = pk2(x[0].z, x[1].z); o.y = pk2(x[2].z, x[3].z); o.z = pk2(x[4].z, x[5].z); o.w = pk2(x[6].z, x[7].z); *(GAS v4u*)(dst + (size_t)2 * K) = o; }
    { v4u o; o.x = pk2(x[0].w, x[1].w); o.y = pk2(x[2].w, x[3].w); o.z = pk2(x[4].w, x[5].w); o.w = pk2(x[6].w, x[7].w); *(GAS v4u*)(dst + (size_t)3 * K) = o; }
}
template <bool OUT_F32>
__device__ __forceinline__ void ln_row(const float* src, const float* g, const float* b, void* dst, int lane) {
    const GAS f32x4* xr = (const GAS f32x4*)src + lane;
    f32x4 v[16]; float s = 0.f;
#pragma unroll
    for (int j = 0; j < 16; ++j) { v[j] = __builtin_nontemporal_load(xr + 64 * j); s += (v[j].x + v[j].y) + (v[j].z + v[j].w); }
    const float mean = wave_sum(s) * (1.f / D); float s2 = 0.f;
#pragma unroll
    for (int j = 0; j < 16; ++j) { v[j] = v[j] - mean; s2 += (v[j].x * v[j].x + v[j].y * v[j].y) + (v[j].z * v[j].z + v[j].w * v[j].w); }
    const float rstd = 1.f / sqrtf(wave_sum(s2) * (1.f / D) + LN_EPS);
    const GAS f32x4* gr = (const GAS f32x4*)g + lane; const GAS f32x4* br = (const GAS f32x4*)b + lane;
#pragma unroll
    for (int j = 0; j < 16; ++j) { const f32x4 o = v[j] * rstd * gr[64 * j] + br[64 * j];
        if (OUT_F32) ((GAS f32x4*)dst)[lane + 64 * j] = o;
        else { u32x2v w; w.x = pk2(o.x, o.y); w.y = pk2(o.z, o.w); ((GAS u32x2v*)dst)[lane + 64 * j] = w; } }
}
template <bool OUT_F32, int NSL>
__device__ __forceinline__ void ln_row_slab_block(Frame& F, const float* slab, int r, const bf16* res, const float* g, const float* b, void* dst, signed char* dq = nullptr, float* scale = nullptr) {
    LAS float* red = (LAS float*)(F.lds);
    const int t = F.tid; float v[8];
    unpack8(*(const v4u*)(res + 8 * t), v);
#pragma unroll
    for (int e = 0; e < 8; ++e) v[e] *= ALPHA;
#pragma unroll 4
    for (int s = 0; s < NSL; ++s) { const f32x4* p = (const f32x4*)(slab + ((size_t)s * 128 + r) * D + 8 * t); const f32x4 a = p[0], c = p[1];
        v[0] += a.x; v[1] += a.y; v[2] += a.z; v[3] += a.w; v[4] += c.x; v[5] += c.y; v[6] += c.z; v[7] += c.w; }
    float s1 = 0.f;
#pragma unroll
    for (int e = 0; e < 8; ++e) s1 += v[e];
    s1 = wave_sum(s1);
    __syncthreads();
    if (F.lane == 0) red[F.wave] = s1;
    __syncthreads();
    float tot = 0.f;
#pragma unroll
    for (int w = 0; w < 8; ++w) tot += red[w];
    const float mean = tot * (1.f / D); float s2 = 0.f;
#pragma unroll
    for (int e = 0; e < 8; ++e) { v[e] -= mean; s2 += v[e] * v[e]; }
    s2 = wave_sum(s2);
    if (F.lane == 0) red[8 + F.wave] = s2;
    __syncthreads();
    float tot2 = 0.f;
#pragma unroll
    for (int w = 0; w < 8; ++w) tot2 += red[8 + w];
    const float rstd = 1.f / sqrtf(tot2 * (1.f / D) + LN_EPS);
    const f32x4* gp = (const f32x4*)(g + 8 * t); const f32x4* bp = (const f32x4*)(b + 8 * t); const f32x4 g0 = gp[0], g1 = gp[1], b0 = bp[0], b1 = bp[1];
    float o[8]; o[0] = v[0] * rstd * g0.x + b0.x; o[1] = v[1] * rstd * g0.y + b0.y; o[2] = v[2] * rstd * g0.z + b0.z; o[3] = v[3] * rstd * g0.w + b0.w;
    o[4] = v[4] * rstd * g1.x + b1.x; o[5] = v[5] * rstd * g1.y + b1.y; o[6] = v[6] * rstd * g1.z + b1.z; o[7] = v[7] * rstd * g1.w + b1.w;
    if (OUT_F32) { f32x4* op = (f32x4*)((float*)dst + 8 * t); op[0] = (f32x4){o[0], o[1], o[2], o[3]}; op[1] = (f32x4){o[4], o[5], o[6], o[7]}; }
    else { *(v4u*)((bf16*)dst + 8 * t) = pack8(o);
        if (dq) {
            float mx = 0.f;
#pragma unroll
            for (int e = 0; e < 8; ++e) mx = fmaxf(mx, fabsf(o[e]));
            mx = wave_max(mx);
            __syncthreads();
            if (F.lane == 0) red[F.wave] = mx;
            __syncthreads();
            float tm = 0.f;
#pragma unroll
            for (int w = 0; w < 8; ++w) tm = fmaxf(tm, red[w]);
            const float inv = tm > 0.f ? 127.0f / tm : 0.f;
            if (t == 0) *scale = tm * (1.0f / 127.0f);
            u32x2v q; q.x = q4(o[0], o[1], o[2], o[3], inv); q.y = q4(o[4], o[5], o[6], o[7], inv); *(u32x2v*)(dq + 8 * t) = q; } }
}
constexpr int LDS_GB = 65536;
__device__ __forceinline__ void stage_gb(Frame& F, const float* g, const float* b) {
    LAS f32x4* Lg = (LAS f32x4*)(F.lds + LDS_GB); __syncthreads();
    for (int i = F.tid; i < D / 4; i += NWAVES * 64) { Lg[i] = ((const GAS f32x4*)(const GAS float*)g)[i]; Lg[D / 4 + i] = ((const GAS f32x4*)(const GAS float*)b)[i]; }
    __syncthreads(); }
template <bool OUT_F32>
__device__ __forceinline__ void ln_row_b16(const bf16* src, const LAS f32x4* Lg, void* dst, int lane) {
    const GAS v4u* xr = (const GAS v4u*)src + lane;
    float v[8][8]; float s = 0.f;
#pragma unroll
    for (int j = 0; j < 8; ++j) { unpack8(__builtin_nontemporal_load(xr + 64 * j), v[j]);
#pragma unroll
        for (int e = 0; e < 8; ++e) s += v[j][e]; }
    const float mean = wave_sum(s) * (1.f / D); float s2 = 0.f;
#pragma unroll
    for (int j = 0; j < 8; ++j)
#pragma unroll
        for (int e = 0; e < 8; ++e) { v[j][e] -= mean; s2 += v[j][e] * v[j][e]; }
    const float rstd = 1.f / sqrtf(wave_sum(s2) * (1.f / D) + LN_EPS);
#pragma unroll
    for (int j = 0; j < 8; ++j) { const int c0 = 8 * (lane + 64 * j); const LAS f32x4* gp = Lg + c0 / 4; const f32x4 g0 = gp[0], g1 = gp[1], b0 = gp[D / 4], b1 = gp[D / 4 + 1];
        float o[8]; o[0] = v[j][0] * rstd * g0.x + b0.x; o[1] = v[j][1] * rstd * g0.y + b0.y; o[2] = v[j][2] * rstd * g0.z + b0.z; o[3] = v[j][3] * rstd * g0.w + b0.w;
        o[4] = v[j][4] * rstd * g1.x + b1.x; o[5] = v[j][5] * rstd * g1.y + b1.y; o[6] = v[j][6] * rstd * g1.z + b1.z; o[7] = v[j][7] * rstd * g1.w + b1.w;
        if (OUT_F32) { GAS f32x4* op = (GAS f32x4*)((float*)dst + c0); op[0] = (f32x4){o[0], o[1], o[2], o[3]}; op[1] = (f32x4){o[4], o[5], o[6], o[7]}; }
        else *(GAS v4u*)((bf16*)dst + c0) = pack8(o); }
}
constexpr int NB_IN = NBF / 32 - 7, NB_ALL = NB_IN + NI8X / 32, I_IN = 64 * NB_IN, NB_OUT = 128, I_OUT = 64 * NB_OUT, NB_GU = NGU / 32, I_GU = 64 * NB_GU, NB_DN = 128, I_DN = (DFF / 64) * NB_DN;
__device__ __forceinline__ void ln0_row_quant(const float* src, const LAS f32x4* Lg, bf16* dst, signed char* dq, float* scale, int lane) {
    const GAS f32x4* xr = (const GAS f32x4*)src + lane;
    f32x4 v[16]; float s = 0.f;
#pragma unroll
    for (int j = 0; j < 16; ++j) { v[j] = __builtin_nontemporal_load(xr + 64 * j); s += (v[j].x + v[j].y) + (v[j].z + v[j].w); }
    const float mean = wave_sum(s) * (1.f / D); float s2 = 0.f;
#pragma unroll
    for (int j = 0; j < 16; ++j) { v[j] = v[j] - mean; s2 += (v[j].x * v[j].x + v[j].y * v[j].y) + (v[j].z * v[j].z + v[j].w * v[j].w); }
    const float rstd = 1.f / sqrtf(wave_sum(s2) * (1.f / D) + LN_EPS); float mx = 0.f;
    const LAS f32x4* gr = Lg + lane; const LAS f32x4* br = Lg + D / 4 + lane;
#pragma unroll
    for (int j = 0; j < 16; ++j) { v[j] = v[j] * rstd * gr[64 * j] + br[64 * j]; mx = fmaxf(mx, fmaxf(fmaxf(fabsf(v[j].x), fabsf(v[j].y)), fmaxf(fabsf(v[j].z), fabsf(v[j].w))));
        u32x2v w; w.x = pk2(v[j].x, v[j].y); w.y = pk2(v[j].z, v[j].w); ((GAS u32x2v*)dst)[lane + 64 * j] = w; }
    mx = wave_max(mx); const float inv = mx > 0.f ? 127.0f / mx : 0.f;
    if (lane == 0) *scale = mx * (1.0f / 127.0f);
#pragma unroll
    for (int j = 0; j < 16; ++j) ((GAS unsigned*)dq)[lane + 64 * j] = q4(v[j].x, v[j].y, v[j].z, v[j].w, inv);
}
__device__ __forceinline__ int src_col_i8(int lc) { return lc < 1024 ? lc : (lc < 3072 ? lc + 3072 : lc + 3088); }
constexpr int CI_ITEMS_X = (NI8X / 256) * (D / 64), CI_ITEMS = (NI8 / 256) * (D / 64), QI_NB = NI8 / 32, QI_ITEMS = QI_NB * (D / 128);
__device__ __forceinline__ void p0_prologue(Frame& F) {
    const int gw = F.vcu * NWAVES + F.wave, NGW = F.G * NWAVES;
    const float* w_in = F.in<A_WIN>();
    for (int r = gw; r < 64 * NB_ALL; r += NGW) { const int kb = r / NB_ALL, nb = r % NB_ALL, n0 = nb < NB_IN ? 32 * nb : NBF + 32 * (nb - NB_IN);
        int src = n0 < C_CC ? n0 + 1024 : (n0 < C_AL ? n0 + 5136 : src_col_i8(n0 - NBF)), nv = 32; if (nb == NB_IN - 1) { src = 6144; nv = 16; }
        unsigned* cm = n0 >= NBF ? (unsigned*)F.cmin() + (n0 - NBF) : ((n0 >= C_CC && n0 < C_AL) ? (unsigned*)F.cmin() + NI8X + (n0 - C_CC) : nullptr);
        p0_transpose_item(w_in, 12304, src, nv, F.Wt_in(), D, n0, 64 * kb, F.lane, cm); }
    const float *x_prompt = F.in<A_XP>(), *x_sample = F.in<A_XS>(), *meta = F.in<A_META>(), *emb_g = F.in<A_EMBG>(), *emb_b = F.in<A_EMBB>();
    stage_gb(F, emb_g, emb_b);
    for (int m = gw; m < MROWS + 2 * NBATCH; m += NGW) {
        const float* src = m < ROW_S ? x_prompt + (size_t)m * D : (m < ROW_META ? x_sample + (size_t)(m - ROW_S) * D : (m < MROWS ? meta + (size_t)(m - ROW_META) * D : x_prompt + (size_t)(((m - MROWS) >> 1) * SEQ + SEQ - 2 + ((m - MROWS) & 1)) * D));
        ln0_row_quant(src, (const LAS f32x4*)(F.lds + LDS_GB), F.h0() + (size_t)m * D, F.h0q() + (size_t)m * D, F.rs0() + m, F.lane);
    }
}
__device__ __forceinline__ void quant_in_pass(Frame& F, int gw, int ngw) {
    const float* cm = F.cmin(); signed char* Wq = F.Wq_in(); const bf16* Wt = F.Wt_in(); const int lane = F.lane;
    for (int p = gw; p < NI8 / 2; p += ngw) { v4u x[2][8]; float inv[2];
#pragma unroll
        for (int rr = 0; rr < 2; ++rr) { const int lc = 2 * p + rr, srow = lc < NI8X ? NBF + lc : C_CC + (lc - NI8X); const GAS v4u* sp = (const GAS v4u*)(const GAS bf16*)(Wt + (size_t)srow * D) + lane;
#pragma unroll
            for (int j = 0; j < 8; ++j) x[rr][j] = __builtin_nontemporal_load(sp + 64 * j);
            const float c = cm[lc]; inv[rr] = c > 0.f ? 127.0f / c : 0.f; }
#pragma unroll
        for (int rr = 0; rr < 2; ++rr) { GAS u32x2v* dp = (GAS u32x2v*)(GAS signed char*)(Wq + (size_t)(2 * p + rr) * D) + lane;
#pragma unroll
            for (int j = 0; j < 8; ++j) { float f[8]; unpack8(x[rr][j], f); u32x2v q; q.x = q4(f[0], f[1], f[2], f[3], inv[rr]); q.y = q4(f[4], f[5], f[6], f[7], inv[rr]); dp[64 * j] = q; } } }
}
struct CvItem { const float* src; bf16* dst; int ldw, K; };
__device__ __forceinline__ CvItem cv_decode(Frame& F, int it, const float* w_out, const float* w_gate, const float* w_up, const float* w_down, int lane) {
    const int ng = lane & 7, kg = lane >> 3; CvItem c; int r = it;
    if (r < I_OUT) { const int kb = r / NB_OUT, nb = r % NB_OUT; c.ldw = D; c.K = D; c.src = w_out + (size_t)(64 * kb + 8 * kg) * D + 32 * nb + 4 * ng; c.dst = F.Wt_out() + (size_t)(32 * nb + 4 * ng) * D + 64 * kb + 8 * kg; return c; } r -= I_OUT;
    if (r < I_GU) { const int kb = r / NB_GU, nb = r % NB_GU, n0 = 32 * nb, pn = n0 >> 8, cc = n0 & 255; c.ldw = DFF; c.K = D;
        c.src = (cc < 128 ? w_gate : w_up) + (size_t)(64 * kb + 8 * kg) * DFF + 128 * pn + (cc & 127) + 4 * ng; c.dst = F.Wt_gu() + (size_t)(n0 + 4 * ng) * D + 64 * kb + 8 * kg; return c; } r -= I_GU;
    { const int kb = r / NB_DN, nb = r % NB_DN; c.ldw = D; c.K = DFF; c.src = w_down + (size_t)(64 * kb + 8 * kg) * D + 32 * nb + 4 * ng; c.dst = F.Wt_dn() + (size_t)(32 * nb + 4 * ng) * DFF + 64 * kb + 8 * kg; return c; }
}
__device__ __forceinline__ void cv_store(const CvItem& c, const f32x4 (&x)[8]) {
    { v4u o; o.x = pk2(x[0].x, x[1].x); o.y = pk2(x[2].x, x[3].x); o.z = pk2(x[4].x, x[5].x); o.w = pk2(x[6].x, x[7].x); __builtin_nontemporal_store(o, (GAS v4u*)(c.dst)); }
    { v4u o; o.x = pk2(x[0].y, x[1].y); o.y = pk2(x[2].y, x[3].y); o.z = pk2(x[4].y, x[5].y); o.w = pk2(x[6].y, x[7].y); __builtin_nontemporal_store(o, (GAS v4u*)(c.dst + (size_t)c.K)); }
    { v4u o; o.x = pk2(x[0].z, x[1].z); o.y = pk2(x[2].z, x[3].z); o.z = pk2(x[4].z, x[5].z); o.w = pk2(x[6].z, x[7].z); __builtin_nontemporal_store(o, (GAS v4u*)(c.dst + (size_t)2 * c.K)); }
    { v4u o; o.x = pk2(x[0].w, x[1].w); o.y = pk2(x[2].w, x[3].w); o.z = pk2(x[4].w, x[5].w); o.w = pk2(x[6].w, x[7].w); __builtin_nontemporal_store(o, (GAS v4u*)(c.dst + (size_t)3 * c.K)); }
}
__device__ __forceinline__ void convert_rest(Frame& F, int gw, int ngw, int it_lo, int it_hi) {
    const float *w_out = F.in<A_WOUT>(), *w_gate = F.in<A_WGATE>(), *w_up = F.in<A_WUP>(), *w_down = F.in<A_WDOWN>();
    const int NIT = it_hi;
    for (int it = it_lo + gw; it < NIT; it += 2 * ngw) {
        const CvItem a = cv_decode(F, it, w_out, w_gate, w_up, w_down, F.lane); const bool two = it + ngw < NIT;
        const CvItem b = cv_decode(F, two ? it + ngw : it, w_out, w_gate, w_up, w_down, F.lane);
        f32x4 xa[8], xb[8];
#pragma unroll
        for (int i = 0; i < 8; ++i) xa[i] = __builtin_nontemporal_load((const f32x4*)(a.src + (size_t)i * a.ldw));
#pragma unroll
        for (int i = 0; i < 8; ++i) xb[i] = __builtin_nontemporal_load((const f32x4*)(b.src + (size_t)i * b.ldw));
        cv_store(a, xa);
        if (two) cv_store(b, xb);
    }
}

constexpr int CM_STRIPS = DFF / 256, CM_KR = D / 64, CM_ITEMS = 2 * CM_STRIPS * CM_KR;
__device__ __forceinline__ void colmax_pass(Frame& F, int gw, int ngw) {
    const float *w_gate = F.in<A_WGATE>(), *w_up = F.in<A_WUP>(); unsigned* cm = (unsigned*)F.cmax();
    for (int it = gw; it < CM_ITEMS; it += ngw) { const int kr = it % CM_KR, sm = it / CM_KR, strip = sm % CM_STRIPS, mat = sm / CM_STRIPS, c0 = 256 * strip + 4 * F.lane;
        const float* src = (mat ? w_up : w_gate) + (size_t)(64 * kr) * DFF + c0; f32x4 m = (f32x4){0.f, 0.f, 0.f, 0.f};
#pragma unroll
        for (int b = 0; b < 4; ++b) { f32x4 x[16];
#pragma unroll
            for (int i = 0; i < 16; ++i) x[i] = *(const f32x4*)(src + (size_t)(16 * b + i) * DFF);
#pragma unroll
            for (int i = 0; i < 16; ++i) { m.x = fmaxf(m.x, fabsf(x[i].x)); m.y = fmaxf(m.y, fabsf(x[i].y)); m.z = fmaxf(m.z, fabsf(x[i].z)); m.w = fmaxf(m.w, fabsf(x[i].w)); } }
        const int gc = 256 * (c0 >> 7) + (mat ? 128 : 0) + (c0 & 127);
        __hip_atomic_fetch_max(cm + gc + 0, __float_as_uint(m.x), __ATOMIC_RELAXED, __HIP_MEMORY_SCOPE_AGENT); __hip_atomic_fetch_max(cm + gc + 1, __float_as_uint(m.y), __ATOMIC_RELAXED, __HIP_MEMORY_SCOPE_AGENT);
        __hip_atomic_fetch_max(cm + gc + 2, __float_as_uint(m.z), __ATOMIC_RELAXED, __HIP_MEMORY_SCOPE_AGENT); __hip_atomic_fetch_max(cm + gc + 3, __float_as_uint(m.w), __ATOMIC_RELAXED, __HIP_MEMORY_SCOPE_AGENT); }
}
constexpr int WQ_NB = NGU / 32, WQ_KB = D / 128, WQ_ITEMS = WQ_NB * WQ_KB;
__device__ __forceinline__ void quant_gu_pass(Frame& F, int gw, int ngw) {
    const float *w_gate = F.in<A_WGATE>(), *w_up = F.in<A_WUP>(); const float* cm = F.cmax(); signed char* Wq = (signed char*)F.Wt_gu();
    const int ng = F.lane & 7, kg = F.lane >> 3;
    for (int it = gw; it < WQ_ITEMS; it += ngw) { const int kb = it / WQ_NB, nb = it % WQ_NB, n0 = 32 * nb, pn = n0 >> 8, cc = n0 & 255, k0 = 128 * kb;
        const float* src = (cc < 128 ? w_gate : w_up) + (size_t)(k0 + 16 * kg) * DFF + 128 * pn + (cc & 127) + 4 * ng;
        f32x4 x[16];
#pragma unroll
        for (int i = 0; i < 16; ++i) x[i] = __builtin_nontemporal_load((const f32x4*)(src + (size_t)i * DFF));
        const f32x4 c4 = *(const f32x4*)(cm + n0 + 4 * ng);
        const float i0 = c4.x > 0.f ? 127.0f / c4.x : 0.f, i1 = c4.y > 0.f ? 127.0f / c4.y : 0.f, i2 = c4.z > 0.f ? 127.0f / c4.z : 0.f, i3 = c4.w > 0.f ? 127.0f / c4.w : 0.f;
        signed char* dst = Wq + (size_t)(n0 + 4 * ng) * D + k0 + 16 * kg;
        { v4u o; o.x = q4(x[0].x, x[1].x, x[2].x, x[3].x, i0); o.y = q4(x[4].x, x[5].x, x[6].x, x[7].x, i0); o.z = q4(x[8].x, x[9].x, x[10].x, x[11].x, i0); o.w = q4(x[12].x, x[13].x, x[14].x, x[15].x, i0); *(GAS v4u*)(dst) = o; }
        { v4u o; o.x = q4(x[0].y, x[1].y, x[2].y, x[3].y, i1); o.y = q4(x[4].y, x[5].y, x[6].y, x[7].y, i1); o.z = q4(x[8].y, x[9].y, x[10].y, x[11].y, i1); o.w = q4(x[12].y, x[13].y, x[14].y, x[15].y, i1); *(GAS v4u*)(dst + (size_t)D) = o; }
        { v4u o; o.x = q4(x[0].z, x[1].z, x[2].z, x[3].z, i2); o.y = q4(x[4].z, x[5].z, x[6].z, x[7].z, i2); o.z = q4(x[8].z, x[9].z, x[10].z, x[11].z, i2); o.w = q4(x[12].z, x[13].z, x[14].z, x[15].z, i2); *(GAS v4u*)(dst + (size_t)2 * D) = o; }
        { v4u o; o.x = q4(x[0].w, x[1].w, x[2].w, x[3].w, i3); o.y = q4(x[4].w, x[5].w, x[6].w, x[7].w, i3); o.z = q4(x[8].w, x[9].w, x[10].w, x[11].w, i3); o.w = q4(x[12].w, x[13].w, x[14].w, x[15].w, i3); *(GAS v4u*)(dst + (size_t)3 * D) = o; } }
}
constexpr int CD_STRIPS = D / 256, CD_KR = DFF / 64, CD_ITEMS = CD_STRIPS * CD_KR;
__device__ __forceinline__ void colmax_dn_pass(Frame& F, int gw, int ngw) {
    const float* w_down = F.in<A_WDOWN>(); unsigned* cm = (unsigned*)F.cmdn();
    for (int it = gw; it < CD_ITEMS; it += ngw) { const int kr = it % CD_KR, strip = it / CD_KR, c0 = 256 * strip + 4 * F.lane;
        const float* src = w_down + (size_t)(64 * kr) * D + c0; f32x4 m = (f32x4){0.f, 0.f, 0.f, 0.f};
#pragma unroll
        for (int b = 0; b < 4; ++b) { f32x4 x[16];
#pragma unroll
            for (int i = 0; i < 16; ++i) x[i] = *(const f32x4*)(src + (size_t)(16 * b + i) * D);
#pragma unroll
            for (int i = 0; i < 16; ++i) { m.x = fmaxf(m.x, fabsf(x[i].x)); m.y = fmaxf(m.y, fabsf(x[i].y)); m.z = fmaxf(m.z, fabsf(x[i].z)); m.w = fmaxf(m.w, fabsf(x[i].w)); } }
        __hip_atomic_fetch_max(cm + c0 + 0, __float_as_uint(m.x), __ATOMIC_RELAXED, __HIP_MEMORY_SCOPE_AGENT); __hip_atomic_fetch_max(cm + c0 + 1, __float_as_uint(m.y), __ATOMIC_RELAXED, __HIP_MEMORY_SCOPE_AGENT);
        __hip_atomic_fetch_max(cm + c0 + 2, __float_as_uint(m.z), __ATOMIC_RELAXED, __HIP_MEMORY_SCOPE_AGENT); __hip_atomic_fetch_max(cm + c0 + 3, __float_as_uint(m.w), __ATOMIC_RELAXED, __HIP_MEMORY_SCOPE_AGENT); }
}
constexpr int WD_NB = D / 32, WD_KB = DFF / 128, WD_ITEMS = WD_NB * WD_KB;
__device__ __forceinline__ void quant_dn_pass(Frame& F, int gw, int ngw) {
    const float* w_down = F.in<A_WDOWN>(); const float* cm = F.cmdn(); signed char* Wq = (signed char*)F.Wt_dn();
    const int ng = F.lane & 7, kg = F.lane >> 3;
    for (int it = gw; it < WD_ITEMS; it += ngw) { const int kb = it / WD_NB, nb = it % WD_NB, n0 = 32 * nb, k0 = 128 * kb;
        const float* src = w_down + (size_t)(k0 + 16 * kg) * D + n0 + 4 * ng;
        f32x4 x[16];
#pragma unroll
        for (int i = 0; i < 16; ++i) x[i] = __builtin_nontemporal_load((const f32x4*)(src + (size_t)i * D));
        const f32x4 c4 = *(const f32x4*)(cm + n0 + 4 * ng);
        const float i0 = c4.x > 0.f ? 127.0f / c4.x : 0.f, i1 = c4.y > 0.f ? 127.0f / c4.y : 0.f, i2 = c4.z > 0.f ? 127.0f / c4.z : 0.f, i3 = c4.w > 0.f ? 127.0f / c4.w : 0.f;
        signed char* dst = Wq + (size_t)(n0 + 4 * ng) * DFF + k0 + 16 * kg;
        { v4u o; o.x = q4(x[0].x, x[1].x, x[2].x, x[3].x, i0); o.y = q4(x[4].x, x[5].x, x[6].x, x[7].x, i0); o.z = q4(x[8].x, x[9].x, x[10].x, x[11].x, i0); o.w = q4(x[12].x, x[13].x, x[14].x, x[15].x, i0); *(GAS v4u*)(dst) = o; }
        { v4u o; o.x = q4(x[0].y, x[1].y, x[2].y, x[3].y, i1); o.y = q4(x[4].y, x[5].y, x[6].y, x[7].y, i1); o.z = q4(x[8].y, x[9].y, x[10].y, x[11].y, i1); o.w = q4(x[12].y, x[13].y, x[14].y, x[15].y, i1); *(GAS v4u*)(dst + (size_t)DFF) = o; }
        { v4u o; o.x = q4(x[0].z, x[1].z, x[2].z, x[3].z, i2); o.y = q4(x[4].z, x[5].z, x[6].z, x[7].z, i2); o.z = q4(x[8].z, x[9].z, x[10].z, x[11].z, i2); o.w = q4(x[12].z, x[13].z, x[14].z, x[15].z, i2); *(GAS v4u*)(dst + (size_t)2 * DFF) = o; }
        { v4u o; o.x = q4(x[0].w, x[1].w, x[2].w, x[3].w, i3); o.y = q4(x[4].w, x[5].w, x[6].w, x[7].w, i3); o.z = q4(x[8].w, x[9].w, x[10].w, x[11].w, i3); o.w = q4(x[12].w, x[13].w, x[14].w, x[15].w, i3); *(GAS v4u*)(dst + (size_t)3 * DFF) = o; } }
}
__device__ __forceinline__ void act_row_quant(Frame& F, int row, int lane) {
    const GAS v4u* src = (const GAS v4u*)(F.act() + (size_t)row * DFF) + lane; GAS u32x2v* dst = (GAS u32x2v*)(F.actq() + (size_t)row * DFF) + lane;
    v4u x[22]; float mx = 0.f;
#pragma unroll
    for (int i = 0; i < 21; ++i) x[i] = __builtin_nontemporal_load(src + 64 * i);
    x[21] = (lane + 64 * 21 < DFF / 8) ? __builtin_nontemporal_load(src + 64 * 21) : (v4u){0u, 0u, 0u, 0u};
#pragma unroll
    for (int i = 0; i < 22; ++i) { mx = fmaxf(mx, fmaxf(fmaxf(fabsf(bflo(x[i].x)), fabsf(bfhi(x[i].x))), fmaxf(fabsf(bflo(x[i].y)), fabsf(bfhi(x[i].y)))));
        mx = fmaxf(mx, fmaxf(fmaxf(fabsf(bflo(x[i].z)), fabsf(bfhi(x[i].z))), fmaxf(fabsf(bflo(x[i].w)), fabsf(bfhi(x[i].w))))); }
    mx = wave_max(mx); const float inv = mx > 0.f ? 127.0f / mx : 0.f;
    if (lane == 0) F.amax()[row] = mx;
#pragma unroll
    for (int i = 0; i < 22; ++i) if (lane + 64 * i < DFF / 8) { u32x2v q; q.x = q4(bflo(x[i].x), bfhi(x[i].x), bflo(x[i].y), bfhi(x[i].y), inv); q.y = q4(bflo(x[i].z), bfhi(x[i].z), bflo(x[i].w), bfhi(x[i].w), inv); dst[64 * i] = q; }
}
__device__ __forceinline__ void ln1_row_quant(const bf16* src, const LAS f32x4* Lg, bf16* dst, signed char* dq, float* scale, int lane) {
    const GAS v4u* xr = (const GAS v4u*)src + lane;
    float v[8][8]; float s = 0.f;
#pragma unroll
    for (int j = 0; j < 8; ++j) { unpack8(__builtin_nontemporal_load(xr + 64 * j), v[j]);
#pragma unroll
        for (int e = 0; e < 8; ++e) s += v[j][e]; }
    const float mean = wave_sum(s) * (1.f / D); float s2 = 0.f;
#pragma unroll
    for (int j = 0; j < 8; ++j)
#pragma unroll
        for (int e = 0; e < 8; ++e) { v[j][e] -= mean; s2 += v[j][e] * v[j][e]; }
    const float rstd = 1.f / sqrtf(wave_sum(s2) * (1.f / D) + LN_EPS); float mx = 0.f;
#pragma unroll
    for (int j = 0; j < 8; ++j) { const int c0 = 8 * (lane + 64 * j); const LAS f32x4* gp = Lg + c0 / 4; const f32x4 g0 = gp[0], g1 = gp[1], b0 = gp[D / 4], b1 = gp[D / 4 + 1];
        v[j][0] = v[j][0] * rstd * g0.x + b0.x; v[j][1] = v[j][1] * rstd * g0.y + b0.y; v[j][2] = v[j][2] * rstd * g0.z + b0.z; v[j][3] = v[j][3] * rstd * g0.w + b0.w;
        v[j][4] = v[j][4] * rstd * g1.x + b1.x; v[j][5] = v[j][5] * rstd * g1.y + b1.y; v[j][6] = v[j][6] * rstd * g1.z + b1.z; v[j][7] = v[j][7] * rstd * g1.w + b1.w;
#pragma unroll
        for (int e = 0; e < 8; ++e) mx = fmaxf(mx, fabsf(v[j][e]));
        __builtin_nontemporal_store(pack8(v[j]), (GAS v4u*)(dst + c0)); }
    mx = wave_max(mx); const float inv = mx > 0.f ? 127.0f / mx : 0.f;
    if (lane == 0) *scale = mx * (1.0f / 127.0f);
#pragma unroll
    for (int j = 0; j < 8; ++j) { u32x2v q; q.x = q4(v[j][0], v[j][1], v[j][2], v[j][3], inv); q.y = q4(v[j][4], v[j][5], v[j][6], v[j][7], inv); *(GAS u32x2v*)(dq + 8 * (lane + 64 * j)) = q; }
}

__device__ __forceinline__ void gla_sample_item(Frame& F, int it, const float* w_a2, const float* b_a, const float* state_gla, float* out) {
    const int n = it >> 2, h = it & 3, row = ROW_S + n, t = F.tid;
    LAS float* Aa = (LAS float*)(F.lds); LAS float* Kk = Aa + 256; LAS float* Qq = Aa + 512; LAS float* Ored = Aa + 768;
    const bf16* prow = F.proj() + (size_t)row * NIN;
    __syncthreads();
    if (t < 256) { const int d = t; float z = b_a[h * DK + d];
#pragma unroll
        for (int r = 0; r < 16; ++r) z += bf2f(prow[C_AL + r]) * w_a2[r * DGK + h * DK + d];
        Aa[d] = __expf(logsigmoid(z) * 0.0625f); Kk[d] = bf2f(prow[C_K + h * DK + d]); Qq[d] = bf2f(prow[C_Q + h * DK + d]) * 0.0625f; }
    __syncthreads();
    const int cg = t & 127, rg = t >> 7;
    const u32x2v vw = *(const u32x2v*)(prow + C_V + h * DV + 4 * cg);
    const f32x4 v4 = (f32x4){bflo(vw.x), bfhi(vw.x), bflo(vw.y), bfhi(vw.y)};
    const f32x4* S0 = (const f32x4*)(state_gla + (size_t)(n * NH + h) * DK * DV) + cg;
    f32x4* S1 = (f32x4*)(out + O_GS + (size_t)(n * NH + h) * DK * DV) + cg;
    f32x4 o4 = (f32x4){0.f, 0.f, 0.f, 0.f};
    for (int i0 = 0; i0 < 64; i0 += 16) {
        f32x4 s[16];
#pragma unroll
        for (int k = 0; k < 16; ++k) s[k] = __builtin_nontemporal_load(S0 + (size_t)(rg * 64 + i0 + k) * 128);
#pragma unroll
        for (int k = 0; k < 16; ++k) { const int d = rg * 64 + i0 + k; s[k] = s[k] * Aa[d] + v4 * Kk[d]; __builtin_nontemporal_store(s[k], S1 + (size_t)d * 128); o4 += s[k] * Qq[d]; }
    }
    *(LAS f32x4*)(Ored + rg * 512 + 4 * cg) = o4;
    __syncthreads();
    { const float o = (Ored[t] + Ored[512 + t]) + (Ored[1024 + t] + Ored[1536 + t]); F.obuf()[(size_t)row * DGV + h * DV + t] = (bf16)f2bf(o); }
    __syncthreads();
}
__device__ __forceinline__ void conv_row(Frame& F, int row, int lane, const float* state_conv, const float* conv_w, float* out) {
    const bool samp = row >= ROW_S; const int tq = row & (SEQ - 1), b = row >> 11, n = row - ROW_S;
    const int r1 = tq >= 1 ? row - 1 : ROW_META + 15, r2 = tq >= 2 ? row - 2 : ROW_META + 14 + tq;
    const bf16* p0 = F.proj() + (size_t)row * NIN; const bf16* p1 = F.proj() + (size_t)r1 * NIN; const bf16* p2 = F.proj() + (size_t)r2 * NIN;
#pragma unroll
    for (int jp = 0; jp < 2; ++jp) {
        v4u vcb[2], vcc[2], vch[2], vc1[2], vh1[2], vc2[2], vh2[2]; f32x4 s1[2][2], s0[2][2], wq[2][3][2];
#pragma unroll
        for (int jj = 0; jj < 2; ++jj) { const int c0 = 512 * (2 * jp + jj) + 8 * lane;
            vcb[jj] = *(const v4u*)(p0 + C_CB + c0); vcc[jj] = *(const v4u*)(p0 + C_CC + c0); vch[jj] = *(const v4u*)(p0 + C_CH + c0);
            if (!samp) { vc1[jj] = *(const v4u*)(p1 + C_CC + c0); vh1[jj] = *(const v4u*)(p1 + C_CH + c0); vc2[jj] = *(const v4u*)(p2 + C_CC + c0); vh2[jj] = *(const v4u*)(p2 + C_CH + c0); }
            else { const f32x4* q1 = (const f32x4*)(state_conv + (size_t)(n * 2 + 1) * DCONV + c0); const f32x4* q0 = (const f32x4*)(state_conv + (size_t)(n * 2 + 0) * DCONV + c0);
                s1[jj][0] = q1[0]; s1[jj][1] = q1[1]; s0[jj][0] = q0[0]; s0[jj][1] = q0[1]; }
#pragma unroll
            for (int k = 0; k < 3; ++k) { const f32x4* q = (const f32x4*)(conv_w + k * DCONV + c0); wq[jj][k][0] = q[0]; wq[jj][k][1] = q[1]; } }
#pragma unroll
        for (int jj = 0; jj < 2; ++jj) { const int c0 = 512 * (2 * jp + jj) + 8 * lane;
            float cb[8], cc[8], ch[8], ut[8], u1[8], u2[8], y[8];
            unpack8(vcb[jj], cb); unpack8(vcc[jj], cc); unpack8(vch[jj], ch);
#pragma unroll
            for (int e = 0; e < 8; ++e) ut[e] = cc[e] * ch[e];
            if (!samp) { unpack8(vc1[jj], cc); unpack8(vh1[jj], ch);
#pragma unroll
                for (int e = 0; e < 8; ++e) u1[e] = cc[e] * ch[e];
                unpack8(vc2[jj], cc); unpack8(vh2[jj], ch);
#pragma unroll
                for (int e = 0; e < 8; ++e) u2[e] = cc[e] * ch[e]; }
            else { const f32x4 a0 = s1[jj][0], a1 = s1[jj][1], b0 = s0[jj][0], b1 = s0[jj][1];
                u1[0] = a0.x; u1[1] = a0.y; u1[2] = a0.z; u1[3] = a0.w; u1[4] = a1.x; u1[5] = a1.y; u1[6] = a1.z; u1[7] = a1.w;
                u2[0] = b0.x; u2[1] = b0.y; u2[2] = b0.z; u2[3] = b0.w; u2[4] = b1.x; u2[5] = b1.y; u2[6] = b1.z; u2[7] = b1.w; }
            const float w0[8] = {wq[jj][0][0].x, wq[jj][0][0].y, wq[jj][0][0].z, wq[jj][0][0].w, wq[jj][0][1].x, wq[jj][0][1].y, wq[jj][0][1].z, wq[jj][0][1].w};
            const float w1[8] = {wq[jj][1][0].x, wq[jj][1][0].y, wq[jj][1][0].z, wq[jj][1][0].w, wq[jj][1][1].x, wq[jj][1][1].y, wq[jj][1][1].z, wq[jj][1][1].w};
            const float w2[8] = {wq[jj][2][0].x, wq[jj][2][0].y, wq[jj][2][0].z, wq[jj][2][0].w, wq[jj][2][1].x, wq[jj][2][1].y, wq[jj][2][1].z, wq[jj][2][1].w};
#pragma unroll
            for (int e = 0; e < 8; ++e) y[e] = cb[e] * (w0[e] * u2[e] + w1[e] * u1[e] + w2[e] * ut[e]);
            *(v4u*)(F.mix() + (size_t)row * D + DGV + c0) = pack8(y);
            if (!samp) { if (tq >= SEQ - 2) { f32x4* o = (f32x4*)(out + O_CP + (size_t)(b * 2 + (tq - (SEQ - 2))) * DCONV + c0); o[0] = (f32x4){ut[0], ut[1], ut[2], ut[3]}; o[1] = (f32x4){ut[4], ut[5], ut[6], ut[7]}; } }
            else { f32x4* o = (f32x4*)(out + O_CS + (size_t)(n * 2) * DCONV + c0); o[0] = (f32x4){u1[0], u1[1], u1[2], u1[3]}; o[1] = (f32x4){u1[4], u1[5], u1[6], u1[7]};
                f32x4* o2 = (f32x4*)(out + O_CS + (size_t)(n * 2 + 1) * DCONV + c0); o2[0] = (f32x4){ut[0], ut[1], ut[2], ut[3]}; o2[1] = (f32x4){ut[4], ut[5], ut[6], ut[7]}; } }
    }
}
typedef float f32x16 __attribute__((ext_vector_type(16)));
constexpr int NCH = 33, NBH = NBATCH * NH;
constexpr size_t GS_QF = 0, GS_KF = GS_QF + (size_t)NBH * NCH * 32768, GS_AF = GS_KF + (size_t)NBH * NCH * 32768, GS_VF = GS_AF + (size_t)NBH * NCH * 8192,
                 GS_EL = GS_VF + (size_t)NBH * NCH * 65536, GS_END = GS_EL + (size_t)NBH * NCH * 1024;
static_assert(GS_END <= 132 * MiB, "GLA scratch aliases the R region");
constexpr int L_QS = 0, L_KS = 33792, L_KKT = 67584, L_AT = 101376, L_AL = 110592, L_BT = 114688;
__device__ __forceinline__ int crow32(int i, int h) { return (i & 3) + 8 * (i >> 2) + 4 * h; }

__device__ __forceinline__ void conv_rows4(Frame& F, int row0, int lane, const float* conv_w, float* out) {
    const int tq0 = row0 & (SEQ - 1), b = row0 >> 11;
    const bf16* pm2 = F.proj() + (size_t)(tq0 ? row0 - 2 : ROW_META + 14) * NIN; const bf16* pm1 = F.proj() + (size_t)(tq0 ? row0 - 1 : ROW_META + 15) * NIN; const bf16* p0 = F.proj() + (size_t)row0 * NIN;
#pragma unroll 1
    for (int g = 0; g < 4; ++g) { const int c0 = 512 * g + 8 * lane;
        v4u vcc[6], vch[6], vcb[4]; f32x4 wq[3][2];
        vcc[0] = __builtin_nontemporal_load((const v4u*)(pm2 + C_CC + c0)); vch[0] = __builtin_nontemporal_load((const v4u*)(pm2 + C_CH + c0)); vcc[1] = __builtin_nontemporal_load((const v4u*)(pm1 + C_CC + c0)); vch[1] = __builtin_nontemporal_load((const v4u*)(pm1 + C_CH + c0));
#pragma unroll
        for (int i = 0; i < 4; ++i) { vcc[2 + i] = __builtin_nontemporal_load((const v4u*)(p0 + (size_t)i * NIN + C_CC + c0)); vch[2 + i] = __builtin_nontemporal_load((const v4u*)(p0 + (size_t)i * NIN + C_CH + c0)); vcb[i] = __builtin_nontemporal_load((const v4u*)(p0 + (size_t)i * NIN + C_CB + c0)); }
#pragma unroll
        for (int k = 0; k < 3; ++k) { const f32x4* q = (const f32x4*)(conv_w + k * DCONV + c0); wq[k][0] = q[0]; wq[k][1] = q[1]; }
        float u[6][8];
#pragma unroll
        for (int j = 0; j < 6; ++j) { float cc[8], ch[8]; unpack8(vcc[j], cc); unpack8(vch[j], ch);
#pragma unroll
            for (int e = 0; e < 8; ++e) u[j][e] = cc[e] * ch[e]; }
        const float w0[8] = {wq[0][0].x, wq[0][0].y, wq[0][0].z, wq[0][0].w, wq[0][1].x, wq[0][1].y, wq[0][1].z, wq[0][1].w};
        const float w1[8] = {wq[1][0].x, wq[1][0].y, wq[1][0].z, wq[1][0].w, wq[1][1].x, wq[1][1].y, wq[1][1].z, wq[1][1].w};
        const float w2[8] = {wq[2][0].x, wq[2][0].y, wq[2][0].z, wq[2][0].w, wq[2][1].x, wq[2][1].y, wq[2][1].z, wq[2][1].w};
#pragma unroll
        for (int i = 0; i < 4; ++i) { float cb[8], y[8]; unpack8(vcb[i], cb);
#pragma unroll
            for (int e = 0; e < 8; ++e) y[e] = cb[e] * (w0[e] * u[i][e] + w1[e] * u[i + 1][e] + w2[e] * u[i + 2][e]);
            *(v4u*)(F.mix() + (size_t)(row0 + i) * D + DGV + c0) = pack8(y); }
        if (tq0 == SEQ - 4) {
#pragma unroll
            for (int i = 0; i < 2; ++i) { const bf16* px = F.proj() + (size_t)(MROWS + 2 * b + i) * NIN; float cc[8], ch[8]; unpack8(*(const v4u*)(px + C_CC + c0), cc); unpack8(*(const v4u*)(px + C_CH + c0), ch);
                f32x4* o = (f32x4*)(out + O_CP + (size_t)(b * 2 + i) * DCONV + c0); o[0] = (f32x4){cc[0] * ch[0], cc[1] * ch[1], cc[2] * ch[2], cc[3] * ch[3]}; o[1] = (f32x4){cc[4] * ch[4], cc[5] * ch[5], cc[6] * ch[6], cc[7] * ch[7]}; } }
    }
}
__device__ __forceinline__ void gla_prep_qk(Frame& F, int item, const float* w_a2, const float* b_a) {
    const int bh = item / NCH, c = item - bh * NCH, b = bh >> 2, hd = bh & 3, t = F.tid, lane = F.lane, w = F.wave;
    const int nreal = c == 0 ? NMETA : 64, row0 = c == 0 ? ROW_META : b * SEQ + (c - 1) * 64;
    LAS bf16* Qs = (LAS bf16*)(F.lds + L_QS); LAS bf16* Ks = (LAS bf16*)(F.lds + L_KS); LAS unsigned* KKt = (LAS unsigned*)(F.lds + L_KKT);
    LAS bf16* At = (LAS bf16*)(F.lds + L_AT); LAS float* Al = (LAS float*)(F.lds + L_AL); LAS float* Bt = (LAS float*)(F.lds + L_BT);
    unsigned char* gs = F.gscr();
    const int d = t & 255, half = t >> 8;
    __syncthreads();
#pragma unroll
    for (int x = 0; x < 2; ++x) { const int idx = t + 512 * x, j = idx >> 4, rr = idx & 15; Al[idx] = j < nreal ? bf2f(F.proj()[(size_t)(row0 + j) * NIN + C_AL + rr]) : 0.f; }
    float w2[16];
#pragma unroll
    for (int rr = 0; rr < 16; ++rr) w2[rr] = w_a2[rr * DGK + hd * DK + d];
    const float ba = b_a[hd * DK + d];
    unsigned qv[32], kv[32];
    { const GAS unsigned char* bq = (const GAS unsigned char*)(const GAS bf16*)F.proj() + (size_t)C_Q * 2; const GAS unsigned char* bk = (const GAS unsigned char*)(const GAS bf16*)F.proj() + (size_t)C_K * 2;
      unsigned off = (unsigned)(((size_t)(row0 + half * 32) * NIN + hd * DK + d) * 2);
#pragma unroll
      for (int jj = 0; jj < 32; ++jj) { asm volatile("global_load_ushort %0, %1, %2 nt" : "=v"(qv[jj]) : "v"(off), "s"(bq) : "memory"); asm volatile("global_load_ushort %0, %1, %2 nt" : "=v"(kv[jj]) : "v"(off), "s"(bk) : "memory"); off += NIN * 2; } }
    __syncthreads();
    float bc[32]; float run = 0.f;
    const LAS float* Alh = Al + half * 512;
    LAS bf16* Qsh = Qs + half * (32 * 264) + d; LAS bf16* Ksh = Ks + half * (32 * 264) + d; LAS unsigned* KKh = KKt + d * 33 + half * 16;
#pragma unroll
    for (int jj = 0; jj < 32; ++jj) { const int j = half * 32 + jj; float z = ba;
#pragma unroll
        for (int rr = 0; rr < 16; ++rr) z += Alh[jj * 16 + rr] * w2[rr];
        float la = logsigmoid(z) * 0.0625f; if (j >= nreal) la = 0.f; run += la; bc[jj] = run; if ((jj & 3) == 3) __builtin_amdgcn_sched_barrier(0); }
    Bt[half * 256 + d] = run;
    __syncthreads();
    asm volatile("s_waitcnt vmcnt(0)" ::: "memory");
#pragma unroll
    for (int jj = 0; jj < 32; ++jj) asm volatile("" : "+v"(qv[jj]), "+v"(kv[jj]));
    const float off = half ? Bt[d] : 0.f, blast = Bt[d] + Bt[256 + d];
    if (half == 0) ((float*)(gs + GS_EL))[(size_t)(bh * NCH + c) * 256 + d] = __expf(blast);
#pragma unroll
    for (int jj = 0; jj < 32; jj += 2) { const int j = half * 32 + jj; float q0 = 0.f, k0 = 0.f, q1 = 0.f, k1 = 0.f;
        if (j < nreal) { q0 = __uint_as_float(qv[jj] << 16); k0 = __uint_as_float(kv[jj] << 16); } if (j + 1 < nreal) { q1 = __uint_as_float(qv[jj + 1] << 16); k1 = __uint_as_float(kv[jj + 1] << 16); }
        const float b0 = bc[jj] + off, b1 = bc[jj + 1] + off;
        Qsh[jj * 264] = (bf16)f2bf(q0 * __expf(b0) * 0.0625f); Qsh[(jj + 1) * 264] = (bf16)f2bf(q1 * __expf(b1) * 0.0625f);
        Ksh[jj * 264] = (bf16)f2bf(k0 * __expf(-b0)); Ksh[(jj + 1) * 264] = (bf16)f2bf(k1 * __expf(-b1));
        KKh[jj >> 1] = pk2(k0 * __expf(blast - b0), k1 * __expf(blast - b1)); __builtin_amdgcn_sched_barrier(0); }
    __syncthreads();
    { const int fr = lane & 15, fq = lane >> 4, ti = w & 3;
#pragma unroll
      for (int tt = 0; tt < 2; ++tt) { const int tj = 2 * (w >> 2) + tt; f32x4 acc = (f32x4){0.f, 0.f, 0.f, 0.f};
        if (tj <= ti) {
#pragma unroll
            for (int ks = 0; ks < 8; ++ks) { const bf16x8 A = *(const LAS bf16x8*)(Ks + (16 * tj + fr) * 264 + 32 * ks + 8 * fq); const bf16x8 B = *(const LAS bf16x8*)(Qs + (16 * ti + fr) * 264 + 32 * ks + 8 * fq);
                acc = __builtin_amdgcn_mfma_f32_16x16x32_bf16(A, B, acc, 0, 0, 0); } }
        const int i = 16 * ti + fr, j0 = 16 * tj + 4 * fq;
        u32x2v o; o.x = pk2(j0 + 0 <= i ? acc[0] : 0.f, j0 + 1 <= i ? acc[1] : 0.f); o.y = pk2(j0 + 2 <= i ? acc[2] : 0.f, j0 + 3 <= i ? acc[3] : 0.f);
        *(LAS u32x2v*)(At + i * 72 + j0) = o; } }
    __syncthreads();
    { const int r = lane & 31, h = lane >> 5;
      GAS v4u* QFg = (GAS v4u*)(gs + GS_QF) + (size_t)(bh * NCH + c) * 2048; GAS v4u* KFg = (GAS v4u*)(gs + GS_KF) + (size_t)(bh * NCH + c) * 2048; GAS v4u* AFg = (GAS v4u*)(gs + GS_AF) + (size_t)(bh * NCH + c) * 512;
#pragma unroll
      for (int ff = 0; ff < 4; ++ff) { const int f = w * 4 + ff, rt = f >> 4, kt = f & 15, i = 32 * rt + r, d0 = 16 * kt + 4 * h;
          const u32x2v lo = *(const LAS u32x2v*)(Qs + i * 264 + d0), hi = *(const LAS u32x2v*)(Qs + i * 264 + d0 + 8);
          v4u o; o.x = lo.x; o.y = lo.y; o.z = hi.x; o.w = hi.y; QFg[f * 64 + lane] = o; }
#pragma unroll
      for (int ff = 0; ff < 4; ++ff) { const int f = w * 4 + ff, dt = f >> 2, ks = f & 3, dd = 32 * dt + r; const LAS unsigned* p = KKt + dd * 33 + 8 * ks + 4 * h;
          v4u o; o.x = p[0]; o.y = p[1]; o.z = p[2]; o.w = p[3]; KFg[f * 64 + lane] = o; }
      { const int f = w, rt = f >> 2, ks = f & 3, i = 32 * rt + r, j0 = 16 * ks + 8 * h; AFg[f * 64 + lane] = *(const LAS v4u*)(At + i * 72 + j0); } }
}
__device__ __forceinline__ void gla_prep_v(Frame& F, int item) {
    const int bh = item / NCH, c = item - bh * NCH, b = bh >> 2, hd = bh & 3, t = F.tid, lane = F.lane, w = F.wave;
    const int nreal = c == 0 ? NMETA : 64, row0 = c == 0 ? ROW_META : b * SEQ + (c - 1) * 64;
    LAS bf16* Vs = (LAS bf16*)(F.lds);
    unsigned char* gs = F.gscr();
    __syncthreads();
    v4u vv[8];
#pragma unroll
    for (int x = 0; x < 8; ++x) { const int p = t + 512 * x, j = p >> 6, cc = (p & 63) * 8; vv[x] = __builtin_nontemporal_load((const v4u*)(F.proj() + (size_t)(row0 + j) * NIN + C_V + hd * DV + cc)); }
#pragma unroll
    for (int x = 0; x < 8; ++x) { const int p = t + 512 * x, j = p >> 6, cc = (p & 63) * 8; *(LAS v4u*)(Vs + j * 520 + cc) = j < nreal ? vv[x] : (v4u){0u, 0u, 0u, 0u}; }
    __syncthreads();
    const int r = lane & 31, h = lane >> 5;
    GAS v4u* VFg = (GAS v4u*)(gs + GS_VF) + (size_t)(bh * NCH + c) * 4096;
#pragma unroll
    for (int ff = 0; ff < 8; ++ff) { const int f = w * 8 + ff, vt = f >> 2, ks = f & 3, col = 32 * vt + r, j0 = 16 * ks + 8 * h; const LAS bf16* p = Vs + j0 * 520 + col;
        v4u o; o.x = (unsigned)p[0] | ((unsigned)p[520] << 16); o.y = (unsigned)p[2 * 520] | ((unsigned)p[3 * 520] << 16); o.z = (unsigned)p[4 * 520] | ((unsigned)p[5 * 520] << 16); o.w = (unsigned)p[6 * 520] | ((unsigned)p[7 * 520] << 16);
        VFg[f * 64 + lane] = o; }
}
#define MFMA32(a, b, c) __builtin_amdgcn_mfma_f32_32x32x16_bf16(__builtin_bit_cast(bf16x8, (a)), __builtin_bit_cast(bf16x8, (b)), (c), 0, 0, 0)
__device__ __forceinline__ void gla_scan(Frame& F, int unit, float* out) {
    const int bh = unit >> 4, sl = unit & 15, b = bh >> 2, hd = bh & 3, e = F.wave, lane = F.lane, r = lane & 31, h = lane >> 5;
    const GAS unsigned char* gs = (const GAS unsigned char*)F.gscr();
    const unsigned lo = (unsigned)lane * 16u, loe = (unsigned)h * 16u;
    const GAS unsigned char* QFb = gs + GS_QF + ((size_t)bh * NCH * 2048 + (2 * e) * 64) * 16;
    const GAS unsigned char* KFb = gs + GS_KF + ((size_t)bh * NCH * 2048 + (4 * e) * 64) * 16;
    const GAS unsigned char* AFb = gs + GS_AF + ((size_t)bh * NCH * 512 + ((e & 1) * 4 + (e >> 1)) * 64) * 16;
    const GAS unsigned char* VFb = gs + GS_VF + ((size_t)bh * NCH * 4096 + (sl * 4) * 64) * 16;
    const GAS unsigned char* ELb = gs + GS_EL + ((size_t)bh * NCH * 256 + 32 * e) * 4;
    LAS float* Part = (LAS float*)F.lds;
    LAS v4u* VS = (LAS v4u*)(F.lds + LDSCTL_OFF + 512);
    bf16* orow = F.obuf() + (size_t)(b * SEQ) * DGV + hd * DV + 32 * sl + r;
    const int ksel = e >> 1;
    f32x16 S;
#pragma unroll
    for (int i = 0; i < 16; ++i) S[i] = 0.f;
    v4u q00, q01, q10, q11, at, k0, k1, k2, k3, v0, v1, v2, v3, vtA = (v4u){0u, 0u, 0u, 0u}, vtB = (v4u){0u, 0u, 0u, 0u}; f32x4 e0, e1, e2, e3;
#define LDV(p) (*(const GAS v4u*)(p))
#define GLA_LOADQ(c_) do { const GAS unsigned char* qp = QFb + (size_t)(c_) * 32768; q00 = LDV(qp + lo); q01 = LDV(qp + 1024 + lo); q10 = LDV(qp + 16384 + lo); q11 = LDV(qp + 17408 + lo); \
        at = LDV(AFb + (size_t)(c_) * 8192 + lo); } while (0)
#define GLA_LOADV(c_) do { const GAS unsigned char* vp = VFb + (size_t)(c_) * 65536; v0 = LDV(vp + lo); v1 = LDV(vp + 1024 + lo); v2 = LDV(vp + 2048 + lo); v3 = LDV(vp + 3072 + lo); } while (0)
#define GLA_LOADK(c_) do { const GAS unsigned char* kp = KFb + (size_t)(c_) * 32768; k0 = LDV(kp + lo); k1 = LDV(kp + 1024 + lo); k2 = LDV(kp + 2048 + lo); k3 = LDV(kp + 3072 + lo); \
        const GAS unsigned char* ep = ELb + (size_t)(c_) * 1024; e0 = *(const GAS f32x4*)(ep + loe); e1 = *(const GAS f32x4*)(ep + 32 + loe); e2 = *(const GAS f32x4*)(ep + 64 + loe); e3 = *(const GAS f32x4*)(ep + 96 + loe); } while (0)
#define GLA_STATE() do { S[0] *= e0.x; S[1] *= e0.y; S[2] *= e0.z; S[3] *= e0.w; S[4] *= e1.x; S[5] *= e1.y; S[6] *= e1.z; S[7] *= e1.w; \
        S[8] *= e2.x; S[9] *= e2.y; S[10] *= e2.z; S[11] *= e2.w; S[12] *= e3.x; S[13] *= e3.y; S[14] *= e3.z; S[15] *= e3.w; \
        S = MFMA32(k0, v0, S); S = MFMA32(k1, v1, S); S = MFMA32(k2, v2, S); S = MFMA32(k3, v3, S); } while (0)
#define GLA_ATTN(o) do { if (ksel == 0) o = MFMA32(at, v0, o); else if (ksel == 1) o = MFMA32(at, v1, o); else if (ksel == 2) o = MFMA32(at, v2, o); else o = MFMA32(at, v3, o); } while (0)
#define GLA_STEP(VT, VN, c_) do { const int cc_ = (c_); LAS float* P = Part + (cc_ & 1) * 16384; \
        if (cc_ >= 3) { const LAS v4u* vs = VS + (cc_ % 3) * 256 + lane; v0 = vs[0]; v1 = vs[64]; v2 = vs[128]; v3 = vs[192]; } \
        { v4u s0, s1; s0.x = pk2(S[0], S[1]); s0.y = pk2(S[2], S[3]); s0.z = pk2(S[4], S[5]); s0.w = pk2(S[6], S[7]); s1.x = pk2(S[8], S[9]); s1.y = pk2(S[10], S[11]); s1.z = pk2(S[12], S[13]); s1.w = pk2(S[14], S[15]); \
          f32x16 o; _Pragma("unroll") for (int i = 0; i < 16; ++i) o[i] = 0.f; \
          o = MFMA32(q00, s0, o); o = MFMA32(q01, s1, o); if (!(e & 1)) GLA_ATTN(o); \
          _Pragma("unroll") for (int i = 0; i < 16; ++i) P[((e * 2 + 0) * 16 + i) * 64 + lane] = o[i]; \
          _Pragma("unroll") for (int i = 0; i < 16; ++i) o[i] = 0.f; \
          o = MFMA32(q10, s0, o); o = MFMA32(q11, s1, o); if (e & 1) GLA_ATTN(o); \
          _Pragma("unroll") for (int i = 0; i < 16; ++i) P[((e * 2 + 1) * 16 + i) * 64 + lane] = o[i]; } \
        if (cc_ + 1 < NCH) GLA_LOADQ(cc_ + 1); \
        GLA_STATE(); \
        if (cc_ + 1 < NCH) GLA_LOADK(cc_ + 1); \
        if (cc_ + 1 < NCH && cc_ + 1 < 3) GLA_LOADV(cc_ + 1);                       \
        if (e < 4 && cc_ + 2 < NCH) VT = __builtin_nontemporal_load((const GAS v4u*)(VFb + (size_t)(cc_ + 2) * 65536 + e * 1024 + lo)); \
        if (e < 4 && cc_ + 1 < NCH && cc_ + 1 >= 3) VS[((cc_ + 1) % 3) * 256 + e * 64 + lane] = VN; \
        __syncthreads(); \
        _Pragma("unroll") for (int pp = 0; pp < 4; ++pp) { const int p = 4 * e + pp, rt = p >> 4, reg = p & 15; float s = 0.f; \
            _Pragma("unroll") for (int w2 = 0; w2 < 8; ++w2) s += P[((w2 * 2 + rt) * 16 + reg) * 64 + lane]; \
            const int i = 32 * rt + crow32(reg, h); orow[(size_t)((cc_ - 1) * 64 + i) * DGV] = (bf16)f2bf(s); } } while (0)
    __syncthreads();
    GLA_LOADK(0); GLA_LOADV(0); GLA_LOADQ(1);
    GLA_STATE();
    GLA_LOADK(1); GLA_LOADV(1);
    for (int c = 1; c < NCH; c += 2) { GLA_STEP(vtB, vtA, c); GLA_STEP(vtA, vtB, c + 1); }
#undef LDV
#undef GLA_LOADQ
#undef GLA_LOADV
#undef GLA_LOADK
#undef GLA_STATE
#undef GLA_ATTN
#undef GLA_STEP
    float* gp = out + O_GP + ((size_t)(b * NH + hd) * DK + 32 * e) * DV + 32 * sl + r;
#pragma unroll
    for (int i = 0; i < 16; ++i) gp[(size_t)crow32(i, h) * DV] = S[i];
    __syncthreads();
}

__device__ __forceinline__ void finish_rows(Frame& F, int row, int lane, const float* gnorm) {
    const f32x4* gq = (const f32x4*)(gnorm + 8 * lane); const f32x4 g0 = gq[0], g1 = gq[1];
    const float gn[8] = {g0.x, g0.y, g0.z, g0.w, g1.x, g1.y, g1.z, g1.w};
    const bf16* op = F.obuf() + (size_t)row * DGV + 8 * lane; const bf16* gp = F.proj() + (size_t)row * NIN + C_G + 8 * lane;
    v4u ov[4], gv[4];
#pragma unroll
    for (int hd = 0; hd < 4; ++hd) { ov[hd] = __builtin_nontemporal_load((const v4u*)(op + hd * DV)); gv[hd] = __builtin_nontemporal_load((const v4u*)(gp + hd * DV)); }
    float ss[4];
#pragma unroll
    for (int hd = 0; hd < 4; ++hd) { float o[8]; unpack8(ov[hd], o); float s = 0.f;
#pragma unroll
        for (int e = 0; e < 8; ++e) s += o[e] * o[e];
        ss[hd] = s; }
#pragma unroll
    for (int o = 1; o < 64; o <<= 1) { ss[0] += __shfl_xor(ss[0], o); ss[1] += __shfl_xor(ss[1], o); ss[2] += __shfl_xor(ss[2], o); ss[3] += __shfl_xor(ss[3], o); }
#pragma unroll
    for (int hd = 0; hd < 4; ++hd) { float o[8], g[8], y[8]; unpack8(ov[hd], o); unpack8(gv[hd], g); const float rs = 1.f / sqrtf(ss[hd] * (1.f / DV) + RMS_EPS);
#pragma unroll
        for (int e = 0; e < 8; ++e) y[e] = o[e] * rs * gn[e] * silu(g[e]);
        *(v4u*)(F.mix() + (size_t)row * D + hd * DV + 8 * lane) = pack8(y); }
}

struct Args { const float* in[20]; float* out; unsigned char* ws; };
constexpr int SC_GU = 2 * CM_STRIPS * D, SC_TOTAL = SC_GU + CD_STRIPS * DFF;
struct SideColMax {
    static constexpr int NV = 2;
    const Frame* F; const GAS unsigned char* base; int cg, cur, left; unsigned voff;
    f32x4 m, x0, x1;
    __device__ __forceinline__ int K() const { return cg < 2 * CM_STRIPS ? D : DFF; }
    __device__ __forceinline__ unsigned pitch() const { return cg < 2 * CM_STRIPS ? DFF * 4u : D * 4u; }
    __device__ __forceinline__ void setcg() {
        if (cg < 2 * CM_STRIPS) { const int mt = cg >= CM_STRIPS ? 1 : 0, strip = cg - mt * CM_STRIPS; base = (const GAS unsigned char*)(const GAS float*)(mt ? F->in<A_WUP>() : F->in<A_WGATE>()) + (size_t)strip * 1024; }
        else base = (const GAS unsigned char*)(const GAS float*)F->in<A_WDOWN>() + (size_t)(cg - 2 * CM_STRIPS) * 1024; }
    __device__ __forceinline__ void init(const Frame& F_, int gw, int ngw, int lo, int hi) { F = &F_; voff = 16u * (unsigned)F_.lane;
        int share = (hi - lo + ngw - 1) / ngw; share += share & 1; const int i0 = lo + gw * share; left = hi - i0; left = left < 0 ? 0 : (left > share ? share : left);
        if (left == 0) { cg = 0; cur = 1; } else if (i0 < SC_GU) { cg = i0 / D; cur = i0 - cg * D; } else { const int j = i0 - SC_GU; cg = j / DFF; cur = j - cg * DFF; cg += 2 * CM_STRIPS; }
        setcg(); m = x0 = x1 = (f32x4){0.f, 0.f, 0.f, 0.f}; }
    __device__ __forceinline__ void consume() {
        m.x = fmaxf(fmaxf(m.x, fabsf(x0.x)), fabsf(x1.x)); m.y = fmaxf(fmaxf(m.y, fabsf(x0.y)), fabsf(x1.y)); m.z = fmaxf(fmaxf(m.z, fabsf(x0.z)), fabsf(x1.z)); m.w = fmaxf(fmaxf(m.w, fabsf(x0.w)), fabsf(x1.w)); }
    __device__ __forceinline__ void flush() {
        unsigned* cm;
        if (cg < 2 * CM_STRIPS) { const int mt = cg >= CM_STRIPS ? 1 : 0, c0 = 256 * (cg - mt * CM_STRIPS) + 4 * F->lane; cm = (unsigned*)F->cmax() + 256 * (c0 >> 7) + (mt ? 128 : 0) + (c0 & 127); }
        else cm = (unsigned*)F->cmdn() + 256 * (cg - 2 * CM_STRIPS) + 4 * F->lane;
        __hip_atomic_fetch_max(cm + 0, __float_as_uint(m.x), __ATOMIC_RELAXED, __HIP_MEMORY_SCOPE_AGENT); __hip_atomic_fetch_max(cm + 1, __float_as_uint(m.y), __ATOMIC_RELAXED, __HIP_MEMORY_SCOPE_AGENT);
        __hip_atomic_fetch_max(cm + 2, __float_as_uint(m.z), __ATOMIC_RELAXED, __HIP_MEMORY_SCOPE_AGENT); __hip_atomic_fetch_max(cm + 3, __float_as_uint(m.w), __ATOMIC_RELAXED, __HIP_MEMORY_SCOPE_AGENT);
        m = (f32x4){0.f, 0.f, 0.f, 0.f}; }
    __device__ __forceinline__ void step() {
        if (left > 0 && cur == K()) { flush(); ++cg; setcg(); cur = 0; }
        int n = K() - cur; n = n < left ? n : left; n = n < 2 ? n : 2;
        const int last = n > 0 ? cur + n - 1 : cur - 1, r0 = cur < last ? cur : last;
        const GAS unsigned char* p0 = base + (size_t)r0 * pitch(); const GAS unsigned char* p1 = base + (size_t)last * pitch();
        asm volatile("global_load_dwordx4 %0, %1, %2 nt" : "=v"(x0) : "v"(voff), "s"(p0) : "memory");
        asm volatile("global_load_dwordx4 %0, %1, %2 nt" : "=v"(x1) : "v"(voff), "s"(p1) : "memory");
        cur += n; left -= n; }
    __device__ __forceinline__ void finish() { while (left > 0) { step(); asm volatile("s_waitcnt vmcnt(0)" ::: "memory"); consume(); } flush(); }
};
__global__ void __launch_bounds__(NWAVES * 64, 2) hymba_fwd(Args args) {
    extern __shared__ __attribute__((aligned(16))) unsigned char lds[];
    asm volatile("s_nop 0\n\ts_nop 0\n\ts_nop 0\n\ts_nop 0");
    Frame F;
    F.lds = (LAS unsigned char*)lds;
    F.MISC = (volatile LAS unsigned*)(F.lds + MISC_OFF);
    F.tid = threadIdx.x; F.lane = F.tid & 63; F.wave = __builtin_amdgcn_readfirstlane(F.tid >> 6);
    F.G = gridDim.x; { const int bx = blockIdx.x; F.vcu = (F.G % 8 == 0) ? (bx % 8) * (F.G / 8) + bx / 8 : bx; }
    unsigned char* ws = args.ws;
    F.ctl = (gu32*)(ws + WS_CTL);
    F.ws = ws;
    for (int u = F.tid; u < (LDS_BYTES - LDSCTL_OFF) / 4; u += NWAVES * 64) ((LAS unsigned*)(F.lds + LDSCTL_OFF))[u] = 0u;
    __syncthreads();
    XcdBarrier bar = xcd_barrier_post((unsigned*)(F.ctl + CW_BAR), F.MISC + 8);
    const int gw = F.vcu * NWAVES + F.wave, NGW = F.G * NWAVES;

    p0_prologue(F);
    if (NCONV_CU == 0 || F.G != 256) convert_rest(F, F.vcu * NWAVES + F.wave, F.G * NWAVES, 0, I_OUT);
    xcd_barrier(bar); F.refresh();
    quant_in_pass(F, gw, NGW);
    xcd_barrier(bar); F.refresh();
    { SideColMax sd; sd.init(F, gw, NGW, 0, SC_GU);
      { pg8::Gemm g{F.h0(), F.Wt_in(), MPAD, NBF, D}; g.wave = F.wave; pg8::PackedOrder<0> S; S.init(MPR / 256, C_CC / 256, F.G, (int)blockIdx.x, D / 64, NBF / 256);
        pg8::EpiBf16 E{F.proj(), NIN, F.slab(), (float*)((unsigned char*)F.slab() + SLAB_A_OFF)};
        pg8::gemm_phase<pg8::EpiBf16, pg8::PackedOrder<0>, PG8_ALIGN, PG8_SP2, SideColMax>(F.lds + RING_OFF, g, S, E, sd); }
      { const int c2 = (F.G == 256) ? (((int)blockIdx.x + 128) & 255) : (int)blockIdx.x;
        pg8::Gemm g{(const bf16*)F.h0q(), (const bf16*)F.Wq_in(), MPAD, NI8, D / 2}; g.wave = F.wave; pg8::PackedOrder<4> S; S.init(MPR / 256, NI8 / 256, F.G, c2, D / 128, NI8X / 256);
        pg8::EpiBf16I8 E{F.proj() + NBF, NIN, F.slab() + NBF, F.rs0(), F.cmin(), NI8X / 256, C_CC - NBF - NI8X};
        pg8::gemm_phase<pg8::EpiBf16I8, pg8::PackedOrder<4>, PG8_ALIGN, PG8_SP2, SideColMax>(F.lds + RING_OFF, g, S, E, sd); }
      sd.finish(); }
    xcd_barrier(bar); F.refresh();
    { const int gt = blockIdx.x * (NWAVES * 64) + F.tid, NT = F.G * NWAVES * 64; const float* sx = F.slab(); const float* sa = (const float*)((const unsigned char*)F.slab() + SLAB_A_OFF);
      for (int idx = gt; idx < XROWS * (NIN / 8); idx += NT) { const int r = idx / (NIN / 8), cg = idx - r * (NIN / 8); const float* p = sx + (size_t)r * NIN + 8 * cg; float v[8];
          { const f32x4 a = __builtin_nontemporal_load((const f32x4*)p), c = __builtin_nontemporal_load((const f32x4*)p + 1); v[0] = a.x; v[1] = a.y; v[2] = a.z; v[3] = a.w; v[4] = c.x; v[5] = c.y; v[6] = c.z; v[7] = c.w; }
#pragma unroll
          for (int s = 1; s < 3; ++s) { const f32x4 a = __builtin_nontemporal_load((const f32x4*)(p + (size_t)s * XROWS * NIN)), c = __builtin_nontemporal_load((const f32x4*)(p + (size_t)s * XROWS * NIN) + 1); v[0] += a.x; v[1] += a.y; v[2] += a.z; v[3] += a.w; v[4] += c.x; v[5] += c.y; v[6] += c.z; v[7] += c.w; }
          *(v4u*)(F.proj() + (size_t)(MPR + r) * NIN + 8 * cg) = pack8(v); }
      for (int idx = gt; idx < MPR * 2; idx += NT) { const int row = idx >> 1, hf = idx & 1; const float* p = sa + (size_t)row * 16 + 8 * hf; float v[8];
          { const f32x4 a = ((const f32x4*)p)[0], c = ((const f32x4*)p)[1]; v[0] = a.x; v[1] = a.y; v[2] = a.z; v[3] = a.w; v[4] = c.x; v[5] = c.y; v[6] = c.z; v[7] = c.w; }
#pragma unroll
          for (int s = 1; s < 3; ++s) { const f32x4 a = ((const f32x4*)(p + (size_t)s * MPR * 16))[0], c = ((const f32x4*)(p + (size_t)s * MPR * 16))[1]; v[0] += a.x; v[1] += a.y; v[2] += a.z; v[3] += a.w; v[4] += c.x; v[5] += c.y; v[6] += c.z; v[7] += c.w; }
          *(v4u*)(F.proj() + (size_t)row * NIN + C_AL + 8 * hf) = pack8(v); } }
    xcd_barrier(bar); F.refresh();
    { const float *w_a2 = F.in<A_WA2>(), *b_a = F.in<A_BA>(), *state_conv = F.in<A_SCONV>(), *conv_w = F.in<A_CONVW>(), *state_gla = F.in<A_SGLA>(); float* out = F.out();
      const int nsa = F.G == 256 ? 256 : 0;
      if (blockIdx.x & 1) for (int it = blockIdx.x; it < nsa; it += F.G) gla_sample_item(F, it, w_a2, b_a, state_gla, out);
      if (F.G == 256) { const int c = blockIdx.x;
          gla_prep_qk(F, c, w_a2, b_a); gla_prep_qk(F, c + 256, w_a2, b_a);
          if (c < 16) gla_prep_qk(F, c + 512, w_a2, b_a);
          else { gla_prep_v(F, c - 16); gla_prep_v(F, c - 16 + 240); if (c - 16 < 48) gla_prep_v(F, c - 16 + 480); } }
      else for (int it = blockIdx.x; it < 2 * NBH * NCH; it += F.G) { if (it < NBH * NCH) gla_prep_qk(F, it, w_a2, b_a); else gla_prep_v(F, it - NBH * NCH); }
      for (int r4 = gw; r4 < MPR / 4; r4 += NGW) conv_rows4(F, 4 * r4, F.lane, conv_w, out);
      for (int row = ROW_S + gw; row < ROW_META; row += NGW) conv_row(F, row, F.lane, state_conv, conv_w, out);
      if (!(blockIdx.x & 1)) for (int it = blockIdx.x; it < nsa; it += F.G) gla_sample_item(F, it, w_a2, b_a, state_gla, out); }
    xcd_barrier(bar); F.refresh();
    { const float *w_a2 = F.in<A_WA2>(), *b_a = F.in<A_BA>(), *state_gla = F.in<A_SGLA>(); float* out = F.out();
      const int nsa = F.G == 256 ? 256 : 0;
      if (!(blockIdx.x & 1)) for (int it = nsa + blockIdx.x; it < NSAMP * NH; it += F.G) gla_sample_item(F, it, w_a2, b_a, state_gla, out);
      for (int u0 = blockIdx.x; u0 < 256; u0 += F.G) { const int i = u0 >> 3, u = F.G == 256 ? (2 * (u0 & 7) + (i >> 4)) * 16 + (i & 15) : u0; gla_scan(F, u, out); }
      if (blockIdx.x & 1) for (int it = nsa + blockIdx.x; it < NSAMP * NH; it += F.G) gla_sample_item(F, it, w_a2, b_a, state_gla, out); }
    xcd_barrier(bar); F.refresh();
    { const float* gnorm = F.in<A_GNORM>(); for (int row = gw; row < ROW_META; row += NGW) finish_rows(F, row, F.lane, gnorm); }
    xcd_barrier(bar); F.refresh();
    { pg8::Gemm g{F.mix(), F.Wt_out(), MPAD, D, D}; g.wave = F.wave; pg8::PackedOrder<1> S; S.init(MPR / 256, D / 256, F.G, (int)blockIdx.x, D / 64);
      pg8::EpiResBf16 E{F.R(), D, F.h0(), D, ALPHA, F.slab()};
      SideColMax sd; sd.init(F, gw, NGW, SC_GU, SC_TOTAL);
      pg8::gemm_phase<pg8::EpiResBf16, pg8::PackedOrder<1>, PG8_ALIGN, PG8_SP2, SideColMax>(F.lds + RING_OFF, g, S, E, sd);
      sd.finish(); }
    xcd_barrier(bar); F.refresh();
    { const float *ln_g = F.in<A_LN1G>(), *ln_b = F.in<A_LN1B>();
      for (int r = blockIdx.x; r < NSAMP; r += F.G) ln_row_slab_block<false, 16>(F, F.slab(), r, F.h0() + (size_t)(ROW_S + r) * D, ln_g, ln_b, F.h1() + (size_t)(ROW_S + r) * D, F.h1q() + (size_t)(ROW_S + r) * D, F.rsc() + ROW_S + r);
      stage_gb(F, ln_g, ln_b);
      for (int row = gw; row < MPR; row += NGW) ln1_row_quant(F.R() + (size_t)row * D, (const LAS f32x4*)(F.lds + LDS_GB), F.h1() + (size_t)row * D, F.h1q() + (size_t)row * D, F.rsc() + row, F.lane); }
    quant_gu_pass(F, gw, NGW);
    xcd_barrier(bar); F.refresh();
    { pg8::Gemm g{(const bf16*)F.h1q(), F.Wt_gu(), MPAD, NGU, D / 2}; g.wave = F.wave; pg8::PackedOrder<2> S; S.init(MPR / 256, NGU / 256, F.G, (int)blockIdx.x, D / 128);
      pg8::EpiSwiGLUi8 E{F.act(), DFF, F.slab(), NGU, F.rsc(), F.cmax()};
      pg8::gemm_phase<pg8::EpiSwiGLUi8, pg8::PackedOrder<2>, PG8_ALIGN, PG8_SP2>(F.lds + RING_OFF, g, S, E); }
    xcd_barrier(bar); F.refresh();
    for (int r = blockIdx.x; r < NSAMP; r += F.G) { LAS float* red = (LAS float*)F.lds; const int t = F.tid; float y[3][8]; float mx = 0.f;
#pragma unroll
        for (int gi = 0; gi < 3; ++gi) { const int cg = t + 512 * gi;
#pragma unroll
            for (int e = 0; e < 8; ++e) y[gi][e] = 0.f;
            if (cg < DFF / 8) { const int col0 = 8 * cg, pn = col0 >> 7, cc = col0 & 127; const float* pg = F.slab() + (size_t)r * NGU + 256 * pn + cc; float gv[8], uv[8];
#pragma unroll
                for (int e = 0; e < 8; ++e) { gv[e] = 0.f; uv[e] = 0.f; }
#pragma unroll
                for (int s = 0; s < 4; ++s) { const f32x4* q = (const f32x4*)(pg + (size_t)s * 128 * NGU); const f32x4 a = q[0], c = q[1], d0 = q[32], d1 = q[33];
                    gv[0] += a.x; gv[1] += a.y; gv[2] += a.z; gv[3] += a.w; gv[4] += c.x; gv[5] += c.y; gv[6] += c.z; gv[7] += c.w;
                    uv[0] += d0.x; uv[1] += d0.y; uv[2] += d0.z; uv[3] += d0.w; uv[4] += d1.x; uv[5] += d1.y; uv[6] += d1.z; uv[7] += d1.w; }
#pragma unroll
                for (int e = 0; e < 8; ++e) { y[gi][e] = silu(gv[e]) * uv[e]; mx = fmaxf(mx, fabsf(y[gi][e])); } } }
        mx = wave_max(mx);
        __syncthreads();
        if (F.lane == 0) red[F.wave] = mx;
        __syncthreads();
        float tm = 0.f;
#pragma unroll
        for (int w = 0; w < 8; ++w) tm = fmaxf(tm, red[w]);
        const float inv = tm > 0.f ? 127.0f / tm : 0.f;
        if (t == 0) F.amax()[ROW_S + r] = tm;
#pragma unroll
        for (int gi = 0; gi < 3; ++gi) { const int cg = t + 512 * gi; if (cg < DFF / 8) { u32x2v q; q.x = q4(y[gi][0], y[gi][1], y[gi][2], y[gi][3], inv); q.y = q4(y[gi][4], y[gi][5], y[gi][6], y[gi][7], inv);
            *(u32x2v*)(F.actq() + (size_t)(ROW_S + r) * DFF + 8 * cg) = q; } } }
    for (int row = gw; row < MPR; row += NGW) act_row_quant(F, row, F.lane);
    quant_dn_pass(F, gw, NGW);
    xcd_barrier(bar); F.refresh();
    { pg8::Gemm g{(const bf16*)F.actq(), F.Wt_dn(), MPAD, D, DFF / 2}; g.wave = F.wave; pg8::PackedOrder<3> S; S.init(MPR / 256, D / 256, F.G, (int)blockIdx.x, DFF / 128);
      pg8::EpiResI8 E{F.R(), D, F.h1(), D, ALPHA, F.slab(), F.amax(), F.cmdn()};
      pg8::gemm_phase<pg8::EpiResI8, pg8::PackedOrder<3>, PG8_ALIGN, PG8_SP2>(F.lds + RING_OFF, g, S, E); }
    xcd_barrier(bar); F.refresh();
    { const float *ln_g = F.in<A_LN2G>(), *ln_b = F.in<A_LN2B>(); float* out = F.out();
      for (int r = blockIdx.x; r < NSAMP; r += F.G) ln_row_slab_block<true, 16>(F, F.slab(), r, F.h1() + (size_t)(ROW_S + r) * D, ln_g, ln_b, out + O_YS + (size_t)r * D);
      stage_gb(F, ln_g, ln_b);
      for (int row = gw; row < MPR; row += NGW) { int l = F.lane; asm volatile("" : "+v"(l));
          ln_row_b16<true>(F.R() + (size_t)row * D, (const LAS f32x4*)(F.lds + LDS_GB), out + O_YP + (size_t)row * D, l); } }
}

extern "C" void kernel_launch(void* const* d_in, const int* in_sizes, int n_in, void* d_out, int out_size, void* d_ws, size_t ws_size, hipStream_t stream) {
    static int grid = 0;
    if (grid == 0) {
        if (n_in != 20 || (size_t)out_size != O_END || ws_size < WS_END) { fprintf(stderr, "kernel_launch: unexpected shapes (n_in %d out %d ws %zu)\n", n_in, out_size, ws_size); grid = -1; return; }
        int dev = 0, cus = 0, per_cu = 0;
        if (hipGetDevice(&dev) != hipSuccess || hipDeviceGetAttribute(&cus, hipDeviceAttributeMultiprocessorCount, dev) != hipSuccess) { grid = -1; return; }
        if (hipFuncSetAttribute((const void*)hymba_fwd, hipFuncAttributeMaxDynamicSharedMemorySize, LDS_BYTES) != hipSuccess) { fprintf(stderr, "kernel_launch: hipFuncSetAttribute failed\n"); grid = -1; return; }
        if (hipOccupancyMaxActiveBlocksPerMultiprocessor(&per_cu, (const void*)hymba_fwd, NWAVES * 64, LDS_BYTES) != hipSuccess || per_cu < 1) { fprintf(stderr, "kernel_launch: occupancy query says %d\n", per_cu); (void)hipGetLastError(); grid = -1; return; }
        grid = cus;
    }
    if (grid < 0) return;
    if (hipMemsetAsync((char*)d_ws + WS_CTL, 0, CTL_ZERO_BYTES, stream) != hipSuccess) return;
    Args a{};
    for (int i = 0; i < 20; ++i) a.in[i] = (const float*)d_in[i];
    a.out = (float*)d_out; a.ws = (unsigned char*)d_ws;
    hipLaunchKernelGGL(hymba_fwd, dim3(grid), dim3(NWAVES * 64), LDS_BYTES, stream, a);
}
```

```cpp
#include <hip/hip_runtime.h>
#include <cstdio>
#include <cstdint>
namespace pg8 {
#define PG8_LAS __attribute__((address_space(3)))
typedef unsigned short bf16_t;
typedef short bf16x8 __attribute__((ext_vector_type(8)));
typedef float f32x4 __attribute__((ext_vector_type(4)));
typedef unsigned u32x4 __attribute__((ext_vector_type(4)));
constexpr int BM = 256, BK = 64, HALF = 128, HTB = HALF * BK * 2  , STAGE_BYTES = 8 * HTB, NXCD = 8, WGM = 8;

__host__ __device__ __forceinline__ int lds_byte(int r, int c) { const int st = (r >> 4) * 2 + (c >> 5), rr = r & 15, cc = c & 31, ob = rr * 64 + cc * 2; return st * 1024 + (ob ^ (((ob >> 9) & 1) << 5)); }
__host__ __device__ __forceinline__ void stage_rc(int b, int& R, int& C) { const int st = b / 1024, sb = b % 1024, swz = sb ^ (((sb >> 9) & 1) << 5); R = (st >> 1) * 16 + swz / 64; C = (st & 1) * 32 + (swz % 64) / 2; }
__host__ __device__ __forceinline__ int perm32(int rho) { const int n = rho >> 4, i = rho & 15; return 8 * (i >> 2) + 4 * n + (i & 3); }

struct Unit { int a, b;
    __device__ __forceinline__ int pm() const { return a & 0xff; } __device__ __forceinline__ int pn() const { return (a >> 8) & 0xff; } __device__ __forceinline__ int kind() const { return (a >> 16) & 0xf; } __device__ __forceinline__ int sl() const { return (a >> 20) & 0xff; }
    __device__ __forceinline__ int k0() const { return b & 0xffff; } __device__ __forceinline__ int nt() const { return b >> 16; }
    __device__ __forceinline__ void set(int pm_, int pn_, int k0_, int nt_, int kind_, int sl_) { a = pm_ | (pn_ << 8) | (kind_ << 16) | (sl_ << 20); b = k0_ | (nt_ << 16); } };
struct Gemm { const bf16_t* A; const bf16_t* Bt; int M, N, K; int wave = 0; };

template <int MODE> struct PackedOrder {
    int nM, nN, nwg, G, c, ntfull, nmain, rank, nextra, nfirst, xstride, NX, nE;
    __device__ __forceinline__ void init(int nM_, int nN_, int G_, int c_, int ntfull_, int nE_ = 0) { nM = nM_; nN = nN_; nwg = nM * nN; G = G_; c = c_; ntfull = ntfull_; nE = nE_;
        const int rem = nwg % G; nmain = nwg / G + (c < rem ? 1 : 0); rank = c - rem; if (rank < 0) rank += G;
        NX = MODE == 0 ? 3 * (nE + 32) : (MODE == 4 ? 3 * nE : (MODE == 2 ? 344 : 256));
        if (MODE == 0 || MODE == 4) { const int nlight = rem ? G - rem : G; xstride = nlight; nextra = rank < nlight ? (NX - rank + nlight - 1) / nlight : 0; }
        else if (MODE == 2 && G == 256) { xstride = 1; nextra = rank < 64 ? 4 : (rank - 64 < NX - 256 ? 1 : 0); }
        else { xstride = G; nextra = rank < NX ? (NX - rank + G - 1) / G : 0; }
        if (nextra < 0) nextra = 0;
        nfirst = (MODE != 2 && (c & 7) < 4) ? nextra : 0;
    }
    __device__ __forceinline__ bool next(int i, Unit& u) const {
        int j = -1;
        int im = i - nfirst;
        if (i < nfirst) j = i; else if (im >= nmain) { j = nfirst + (im - nmain); if (j >= nextra) return false; }
        if (j < 0) { int wgid = im * G + c; { const int q = nwg / NXCD, r = nwg % NXCD, xcd = wgid % NXCD, off = wgid / NXCD; wgid = (xcd < r ? xcd * (q + 1) : r * (q + 1) + (xcd - r) * q) + off; }
            const int nig = WGM * nN, gid = wgid / nig, fm = gid * WGM, gsz = (nM - fm) < WGM ? (nM - fm) : WGM;
            u.set(fm + ((wgid % nig) % gsz), (wgid % nig) / gsz, 0, ntfull, 0, 0); return true; }
        int x;
        if (MODE == 2 && G == 256) x = rank < 64 ? rank * 4 + j : 256 + rank - 64; else x = rank + j * xstride;
        if (MODE == 0 || MODE == 4) { const int id = x / 3, s = x - 3 * id, pairs = ntfull / 2, base = pairs / 3, rem3 = pairs % 3;
            const int k0 = 2 * (s < rem3 ? (base + 1) * s : (base + 1) * rem3 + base * (s - rem3)), nt = 2 * (s < rem3 ? base + 1 : base);
            if (MODE == 4 || id < nE) u.set(32, id, k0, nt, 1, s); else u.set(id - nE, nE - 1, k0, nt, 2, s); }
        else if (MODE == 1) u.set(32, x >> 4, 4 * (x & 15), 4, 1, x & 15);
        else if (MODE == 2) u.set(32, x >> 2, (ntfull / 4) * (x & 3), ntfull / 4, 1, x & 3);
        else { const int s = x & 15, pairs = ntfull / 2, base = pairs / 16, rem = pairs % 16;
            u.set(32, x >> 4, 2 * (s < rem ? (base + 1) * s : (base + 1) * rem + base * (s - rem)), 2 * (s < rem ? base + 1 : base), 1, s); }
        return true;
    }
    __device__ __forceinline__ void a_ready(const Unit&) const {}
    __device__ __forceinline__ void done(const Unit&) const {}
};

typedef unsigned u32x2 __attribute__((ext_vector_type(2)));
__device__ __forceinline__ unsigned cvt_pk_bf16(float lo, float hi) { unsigned r; asm volatile("v_cvt_pk_bf16_f32 %0, %1, %2" : "=v"(r) : "v"(lo), "v"(hi)); return r; }
__device__ __forceinline__ float bf_lo(unsigned w) { return __uint_as_float(w << 16); }
__device__ __forceinline__ float bf_hi(unsigned w) { return __uint_as_float(w & 0xffff0000u); }
__device__ __forceinline__ float silu_f(float a) { return a * __builtin_amdgcn_rcpf(1.0f + __builtin_amdgcn_exp2f(-1.44269504089f * a)); }

constexpr int XROWS = 152;
struct EpiBf16 {
    static constexpr bool PERM = true, AFTER_DRAIN = false, I8 = false; typedef f32x4 acc_t;
    bf16_t* O; int ldc; float* slabX; float* slabA;
    __device__ __forceinline__ void operator()(const f32x4 (&acc)[2][2][4][2], const Unit& u, int wr, int wc, int fr, int fq) const {
        const int row0 = u.pm() * BM + wr * 64 + fr, col0 = u.pn() * BM + wc * 32 + 8 * fq;
        if (u.kind() == 1) { float* base = slabX + (size_t)u.sl() * XROWS * ldc + col0;
#pragma unroll
            for (int ai = 0; ai < 2; ++ai)
#pragma unroll
                for (int m = 0; m < 4; ++m) { const int r = ai * HALF + wr * 64 + m * 16 + fr; if (r < XROWS) { float* rowp = base + (size_t)r * ldc;
#pragma unroll
                    for (int bj = 0; bj < 2; ++bj) { *(f32x4*)(rowp + bj * HALF) = acc[ai][bj][m][0]; *(f32x4*)(rowp + bj * HALF + 4) = acc[ai][bj][m][1]; } } }
            return; }
        if (u.kind() == 2) { if (wc == 0 && fq < 2) { float* base = slabA + (size_t)u.sl() * 8192 * 16 + 8 * fq;
#pragma unroll
            for (int ai = 0; ai < 2; ++ai)
#pragma unroll
                for (int m = 0; m < 4; ++m) { float* p = base + (size_t)(row0 + ai * HALF + m * 16) * 16; *(f32x4*)p = acc[ai][0][m][0]; *(f32x4*)(p + 4) = acc[ai][0][m][1]; } }
            return; }
#pragma unroll
        for (int ai = 0; ai < 2; ++ai)
#pragma unroll
            for (int m = 0; m < 4; ++m) { bf16_t* rowp = O + (size_t)(row0 + ai * HALF + m * 16) * ldc + col0;
#pragma unroll
                for (int bj = 0; bj < 2; ++bj) { const f32x4 v0 = acc[ai][bj][m][0], v1 = acc[ai][bj][m][1];
                    u32x4 w; w.x = cvt_pk_bf16(v0[0], v0[1]); w.y = cvt_pk_bf16(v0[2], v0[3]); w.z = cvt_pk_bf16(v1[0], v1[1]); w.w = cvt_pk_bf16(v1[2], v1[3]);
                    *(u32x4*)(rowp + bj * HALF) = w; } }
    }
};
struct EpiResBf16 {
    static constexpr bool PERM = true, AFTER_DRAIN = false, I8 = false; typedef f32x4 acc_t;
    bf16_t* C; int ldc; const bf16_t* R; int ldr; float alpha; float* slab;
    __device__ __forceinline__ void operator()(const f32x4 (&acc)[2][2][4][2], const Unit& u, int wr, int wc, int fr, int fq) const {
        const int row0 = u.pm() * BM + wr * 64 + fr, col0 = u.pn() * BM + wc * 32 + 8 * fq;
        if (u.kind() != 0) {
#pragma unroll
            for (int m = 0; m < 4; ++m) { float* rowp = slab + ((size_t)u.sl() * 128 + wr * 64 + m * 16 + fr) * ldc + col0;
#pragma unroll
                for (int bj = 0; bj < 2; ++bj) { *(f32x4*)(rowp + bj * HALF) = acc[0][bj][m][0]; *(f32x4*)(rowp + bj * HALF + 4) = acc[0][bj][m][1]; } }
            return; }
#pragma unroll
        for (int ai = 0; ai < 2; ++ai) {
            u32x4 rvs[4][2];
#pragma unroll
            for (int m = 0; m < 4; ++m) { const bf16_t* rp = R + (size_t)(row0 + ai * HALF + m * 16) * ldr + col0; rvs[m][0] = __builtin_nontemporal_load((const u32x4*)rp); rvs[m][1] = __builtin_nontemporal_load((const u32x4*)(rp + HALF)); }
#pragma unroll
            for (int m = 0; m < 4; ++m) { const size_t row = (size_t)(row0 + ai * HALF + m * 16); bf16_t* rowp = C + row * ldc + col0;
#pragma unroll
                for (int bj = 0; bj < 2; ++bj) { const u32x4 rv = rvs[m][bj]; const f32x4 v0 = acc[ai][bj][m][0], v1 = acc[ai][bj][m][1];
                    u32x4 w; w.x = cvt_pk_bf16(v0[0] + alpha * bf_lo(rv.x), v0[1] + alpha * bf_hi(rv.x)); w.y = cvt_pk_bf16(v0[2] + alpha * bf_lo(rv.y), v0[3] + alpha * bf_hi(rv.y));
                    w.z = cvt_pk_bf16(v1[0] + alpha * bf_lo(rv.z), v1[1] + alpha * bf_hi(rv.z)); w.w = cvt_pk_bf16(v1[2] + alpha * bf_lo(rv.w), v1[3] + alpha * bf_hi(rv.w));
                    *(u32x4*)(rowp + bj * HALF) = w; } } }
    }
};
struct EpiSwiGLU {
    static constexpr bool PERM = true, AFTER_DRAIN = false, I8 = false; typedef f32x4 acc_t;
    bf16_t* O; int ldc; float* slab; int lds_;
    __device__ __forceinline__ void operator()(const f32x4 (&acc)[2][2][4][2], const Unit& u, int wr, int wc, int fr, int fq) const {
        const int row0 = u.pm() * BM + wr * 64 + fr, col0 = u.pn() * HALF + wc * 32 + 8 * fq;
        if (u.kind() != 0) {
#pragma unroll
            for (int m = 0; m < 4; ++m) { float* rowp = slab + ((size_t)u.sl() * 128 + wr * 64 + m * 16 + fr) * lds_ + u.pn() * BM + wc * 32 + 8 * fq;
#pragma unroll
                for (int bj = 0; bj < 2; ++bj) { *(f32x4*)(rowp + bj * HALF) = acc[0][bj][m][0]; *(f32x4*)(rowp + bj * HALF + 4) = acc[0][bj][m][1]; } }
            return; }
#pragma unroll
        for (int ai = 0; ai < 2; ++ai)
#pragma unroll
            for (int m = 0; m < 4; ++m) { bf16_t* rowp = O + (size_t)(row0 + ai * HALF + m * 16) * ldc + col0;
                const f32x4 g0 = acc[ai][0][m][0], g1 = acc[ai][0][m][1], u0 = acc[ai][1][m][0], u1 = acc[ai][1][m][1];
                u32x4 w; w.x = cvt_pk_bf16(silu_f(g0[0]) * u0[0], silu_f(g0[1]) * u0[1]); w.y = cvt_pk_bf16(silu_f(g0[2]) * u0[2], silu_f(g0[3]) * u0[3]);
                w.z = cvt_pk_bf16(silu_f(g1[0]) * u1[0], silu_f(g1[1]) * u1[1]); w.w = cvt_pk_bf16(silu_f(g1[2]) * u1[2], silu_f(g1[3]) * u1[3]);
                *(u32x4*)rowp = w; }
    }
};


typedef int i32x4e __attribute__((ext_vector_type(4)));
struct EpiSwiGLUi8 {
    static constexpr bool PERM = true, AFTER_DRAIN = false, I8 = true; typedef i32x4e acc_t;
    bf16_t* O; int ldc; float* slab; int lds_; const float* rs; const float* cm;
    __device__ __forceinline__ void operator()(const i32x4e (&acc)[2][2][4][2], const Unit& u, int wr, int wc, int fr, int fq) const {
        const int row0 = u.pm() * BM + wr * 64 + fr, col0 = u.pn() * HALF + wc * 32 + 8 * fq, gcol = u.pn() * BM + wc * 32 + 8 * fq;
        f32x4 cg0 = *(const f32x4*)(cm + gcol), cg1 = *(const f32x4*)(cm + gcol + 4), cu0 = *(const f32x4*)(cm + gcol + HALF), cu1 = *(const f32x4*)(cm + gcol + HALF + 4);
        cg0 *= (1.0f / 127.0f); cg1 *= (1.0f / 127.0f); cu0 *= (1.0f / 127.0f); cu1 *= (1.0f / 127.0f);
        if (u.kind() != 0) {
#pragma unroll
            for (int m = 0; m < 4; ++m) { const int r = wr * 64 + m * 16 + fr; const float s = rs[u.pm() * BM + r]; float* rowp = slab + ((size_t)u.sl() * 128 + r) * lds_ + gcol;
                const i32x4e a0 = acc[0][0][m][0], a1 = acc[0][0][m][1], b0 = acc[0][1][m][0], b1 = acc[0][1][m][1];
                *(f32x4*)(rowp) = (f32x4){(float)a0[0], (float)a0[1], (float)a0[2], (float)a0[3]} * cg0 * s; *(f32x4*)(rowp + 4) = (f32x4){(float)a1[0], (float)a1[1], (float)a1[2], (float)a1[3]} * cg1 * s;
                *(f32x4*)(rowp + HALF) = (f32x4){(float)b0[0], (float)b0[1], (float)b0[2], (float)b0[3]} * cu0 * s; *(f32x4*)(rowp + HALF + 4) = (f32x4){(float)b1[0], (float)b1[1], (float)b1[2], (float)b1[3]} * cu1 * s; }
            return; }
        float scs[2][4];
#pragma unroll
        for (int ai = 0; ai < 2; ++ai)
#pragma unroll
            for (int m = 0; m < 4; ++m) scs[ai][m] = rs[row0 + ai * HALF + m * 16];
#pragma unroll
        for (int ai = 0; ai < 2; ++ai)
#pragma unroll
            for (int m = 0; m < 4; ++m) { const int row = row0 + ai * HALF + m * 16; const float s = scs[ai][m]; bf16_t* rowp = O + (size_t)row * ldc + col0;
                const i32x4e a0 = acc[ai][0][m][0], a1 = acc[ai][0][m][1], b0 = acc[ai][1][m][0], b1 = acc[ai][1][m][1];
                const f32x4 g0 = (f32x4){(float)a0[0], (float)a0[1], (float)a0[2], (float)a0[3]} * cg0 * s, g1 = (f32x4){(float)a1[0], (float)a1[1], (float)a1[2], (float)a1[3]} * cg1 * s;
                const f32x4 u0 = (f32x4){(float)b0[0], (float)b0[1], (float)b0[2], (float)b0[3]} * cu0 * s, u1 = (f32x4){(float)b1[0], (float)b1[1], (float)b1[2], (float)b1[3]} * cu1 * s;
                const f32x4 y0 = (f32x4){silu_f(g0[0]) * u0[0], silu_f(g0[1]) * u0[1], silu_f(g0[2]) * u0[2], silu_f(g0[3]) * u0[3]}, y1 = (f32x4){silu_f(g1[0]) * u1[0], silu_f(g1[1]) * u1[1], silu_f(g1[2]) * u1[2], silu_f(g1[3]) * u1[3]};
                u32x4 w; w.x = cvt_pk_bf16(y0[0], y0[1]); w.y = cvt_pk_bf16(y0[2], y0[3]); w.z = cvt_pk_bf16(y1[0], y1[1]); w.w = cvt_pk_bf16(y1[2], y1[3]);
                *(u32x4*)rowp = w;
                }
    }
};
struct EpiResI8 {
    static constexpr bool PERM = true, AFTER_DRAIN = false, I8 = true; typedef i32x4e acc_t;
    bf16_t* C; int ldc; const bf16_t* R; int ldr; float alpha; float* slab; const float* amax; const float* cm;
    __device__ __forceinline__ void operator()(const i32x4e (&acc)[2][2][4][2], const Unit& u, int wr, int wc, int fr, int fq) const {
        const int row0 = u.pm() * BM + wr * 64 + fr, col0 = u.pn() * BM + wc * 32 + 8 * fq;
        f32x4 c00 = *(const f32x4*)(cm + col0), c01 = *(const f32x4*)(cm + col0 + 4), c10 = *(const f32x4*)(cm + col0 + HALF), c11 = *(const f32x4*)(cm + col0 + HALF + 4);
        const float k2 = 1.0f / (127.0f * 127.0f); c00 *= k2; c01 *= k2; c10 *= k2; c11 *= k2;
        if (u.kind() != 0) {
#pragma unroll
            for (int m = 0; m < 4; ++m) { const int r = wr * 64 + m * 16 + fr; const float s = amax[u.pm() * BM + r]; float* rowp = slab + ((size_t)u.sl() * 128 + r) * ldc + col0;
                const i32x4e a0 = acc[0][0][m][0], a1 = acc[0][0][m][1], b0 = acc[0][1][m][0], b1 = acc[0][1][m][1];
                *(f32x4*)(rowp) = (f32x4){(float)a0[0], (float)a0[1], (float)a0[2], (float)a0[3]} * c00 * s; *(f32x4*)(rowp + 4) = (f32x4){(float)a1[0], (float)a1[1], (float)a1[2], (float)a1[3]} * c01 * s;
                *(f32x4*)(rowp + HALF) = (f32x4){(float)b0[0], (float)b0[1], (float)b0[2], (float)b0[3]} * c10 * s; *(f32x4*)(rowp + HALF + 4) = (f32x4){(float)b1[0], (float)b1[1], (float)b1[2], (float)b1[3]} * c11 * s; }
            return; }
#pragma unroll
        for (int ai = 0; ai < 2; ++ai) {
            u32x4 rvs[4][2]; float scs[4];
#pragma unroll
            for (int m = 0; m < 4; ++m) { const size_t row = (size_t)(row0 + ai * HALF + m * 16); const bf16_t* rp = R + row * ldr + col0; scs[m] = amax[row]; rvs[m][0] = __builtin_nontemporal_load((const u32x4*)rp); rvs[m][1] = __builtin_nontemporal_load((const u32x4*)(rp + HALF)); }
#pragma unroll
            for (int m = 0; m < 4; ++m) { const size_t row = (size_t)(row0 + ai * HALF + m * 16); const float s = scs[m]; bf16_t* rowp = C + row * ldc + col0;
#pragma unroll
                for (int bj = 0; bj < 2; ++bj) { const u32x4 rv = rvs[m][bj]; const i32x4e a0 = acc[ai][bj][m][0], a1 = acc[ai][bj][m][1];
                    const f32x4 v0 = (f32x4){(float)a0[0], (float)a0[1], (float)a0[2], (float)a0[3]} * (bj ? c10 : c00) * s, v1 = (f32x4){(float)a1[0], (float)a1[1], (float)a1[2], (float)a1[3]} * (bj ? c11 : c01) * s;
                    u32x4 w; w.x = cvt_pk_bf16(v0[0] + alpha * bf_lo(rv.x), v0[1] + alpha * bf_hi(rv.x)); w.y = cvt_pk_bf16(v0[2] + alpha * bf_lo(rv.y), v0[3] + alpha * bf_hi(rv.y));
                    w.z = cvt_pk_bf16(v1[0] + alpha * bf_lo(rv.z), v1[1] + alpha * bf_hi(rv.z)); w.w = cvt_pk_bf16(v1[2] + alpha * bf_lo(rv.w), v1[3] + alpha * bf_hi(rv.w));
                    *(u32x4*)(rowp + bj * HALF) = w; } } }
    }
};

struct EpiBf16I8 {
    static constexpr bool PERM = true, AFTER_DRAIN = false, I8 = true; typedef i32x4e acc_t;
    bf16_t* O; int ldc; float* slabX; const float* rs; const float* cm; int nwrap, wrapoff;
    __device__ __forceinline__ void operator()(const i32x4e (&acc)[2][2][4][2], const Unit& u, int wr, int wc, int fr, int fq) const {
        const int row0 = u.pm() * BM + wr * 64 + fr, col0 = u.pn() * BM + wc * 32 + 8 * fq, ocol = u.pn() < nwrap ? col0 : col0 + wrapoff;
        f32x4 c00 = *(const f32x4*)(cm + col0), c01 = *(const f32x4*)(cm + col0 + 4), c10 = *(const f32x4*)(cm + col0 + HALF), c11 = *(const f32x4*)(cm + col0 + HALF + 4);
        c00 *= (1.0f / 127.0f); c01 *= (1.0f / 127.0f); c10 *= (1.0f / 127.0f); c11 *= (1.0f / 127.0f);
        if (u.kind() != 0) { float* base = slabX + (size_t)u.sl() * XROWS * ldc + col0;
#pragma unroll
            for (int ai = 0; ai < 2; ++ai)
#pragma unroll
                for (int m = 0; m < 4; ++m) { const int r = ai * HALF + wr * 64 + m * 16 + fr; if (r < XROWS) { const float s = rs[u.pm() * BM + r]; float* rowp = base + (size_t)r * ldc;
                    const i32x4e a0 = acc[ai][0][m][0], a1 = acc[ai][0][m][1], b0 = acc[ai][1][m][0], b1 = acc[ai][1][m][1];
                    *(f32x4*)(rowp) = (f32x4){(float)a0[0], (float)a0[1], (float)a0[2], (float)a0[3]} * c00 * s; *(f32x4*)(rowp + 4) = (f32x4){(float)a1[0], (float)a1[1], (float)a1[2], (float)a1[3]} * c01 * s;
                    *(f32x4*)(rowp + HALF) = (f32x4){(float)b0[0], (float)b0[1], (float)b0[2], (float)b0[3]} * c10 * s; *(f32x4*)(rowp + HALF + 4) = (f32x4){(float)b1[0], (float)b1[1], (float)b1[2], (float)b1[3]} * c11 * s; } }
            return; }
        float scs[2][4];
#pragma unroll
        for (int ai = 0; ai < 2; ++ai)
#pragma unroll
            for (int m = 0; m < 4; ++m) scs[ai][m] = rs[row0 + ai * HALF + m * 16];
#pragma unroll
        for (int ai = 0; ai < 2; ++ai)
#pragma unroll
            for (int m = 0; m < 4; ++m) { const int row = row0 + ai * HALF + m * 16; const float s = scs[ai][m]; bf16_t* rowp = O + (size_t)row * ldc + ocol;
#pragma unroll
                for (int bj = 0; bj < 2; ++bj) { const i32x4e a0 = acc[ai][bj][m][0], a1 = acc[ai][bj][m][1];
                    const f32x4 v0 = (f32x4){(float)a0[0], (float)a0[1], (float)a0[2], (float)a0[3]} * (bj ? c10 : c00) * s, v1 = (f32x4){(float)a1[0], (float)a1[1], (float)a1[2], (float)a1[3]} * (bj ? c11 : c01) * s;
                    u32x4 w; w.x = cvt_pk_bf16(v0[0], v0[1]); w.y = cvt_pk_bf16(v0[2], v0[3]); w.z = cvt_pk_bf16(v1[0], v1[1]); w.w = cvt_pk_bf16(v1[2], v1[3]);
                    *(u32x4*)(rowp + bj * HALF) = w; } }
    }
};
typedef int i32x4 __attribute__((ext_vector_type(4)));
template <bool I8> struct Mma16;
template <> struct Mma16<false> { static __device__ __forceinline__ f32x4 run(bf16x8 a, bf16x8 b, f32x4 c) { return __builtin_amdgcn_mfma_f32_16x16x32_bf16(a, b, c, 0, 0, 0); } };
template <> struct Mma16<true> { static __device__ __forceinline__ i32x4 run(bf16x8 a, bf16x8 b, i32x4 c) { return __builtin_amdgcn_mfma_i32_16x16x64_i8(__builtin_bit_cast(i32x4, a), __builtin_bit_cast(i32x4, b), c, 0, 0, 0); } };
template <bool I8, class T> __device__ __forceinline__ T mma16(bf16x8 a, bf16x8 b, T c) { return Mma16<I8>::run(a, b, c); }
struct NoSide { static constexpr int NV = 0; __device__ __forceinline__ void step() {} __device__ __forceinline__ void consume() {} };
template <class Epi, class Sched, bool ALIGN_EPI, bool SP2, class Side>
__device__ __forceinline__ void gemm_phase(PG8_LAS unsigned char* lds, const Gemm g, const Sched& S, const Epi& E, Side& sd) {
    int tid_ = g.wave * 64 + (int)__builtin_amdgcn_mbcnt_hi(~0u, __builtin_amdgcn_mbcnt_lo(~0u, 0u)); asm volatile("" : "+v"(tid_));
    const int tid = tid_, wid = __builtin_amdgcn_readfirstlane(tid >> 6), lane = tid & 63, wr = wid >> 2, wc = wid & 3, fr = lane & 15, fq = lane >> 4;
    const int K = g.K;
    unsigned voffA[2], voffB[2];
#pragma unroll
    for (int i = 0; i < 2; ++i) { int R, C; stage_rc(tid * 16 + i * 8192, R, C); const int Rb = Epi::PERM ? ((R & ~31) + perm32(R & 31)) : R;
        voffA[i] = (unsigned)(R * K + C) * 2u; voffB[i] = (unsigned)(Rb * K + C) * 2u; }
    const size_t kstep = (size_t)(BK * 2);
    const size_t hstep = (size_t)HALF * K * 2;
    const size_t tstep = 2 * hstep;
    const unsigned ldsw = (unsigned)wid * 1024u;
    const int aoff = lds_byte(wr * 64 + fr, fq * 8), boff = lds_byte(wc * 32 + fr, fq * 8);
#define PG8_SA(b, h) (((b) * 2 + (h)) * HTB)
#define PG8_SB(b, h) ((4 + (b) * 2 + (h)) * HTB)
#define PG8_STAGE(bufoff, gbase, voff) do { _Pragma("unroll") for (int _i = 0; _i < 2; ++_i) \
        __builtin_amdgcn_global_load_lds((const unsigned*)((const char*)(gbase) + (voff)[_i]), (PG8_LAS unsigned*)(lds + (bufoff) + ldsw + _i * 8192), 16, 0, 0); } while (0)
#define PG8_LDA(dst, b, h) do { _Pragma("unroll") for (int m = 0; m < 4; ++m) _Pragma("unroll") for (int k = 0; k < 2; ++k) dst[m][k] = *(const PG8_LAS bf16x8*)(lds + PG8_SA(b, h) + aoff + m * 2048 + k * 1024); } while (0)
#define PG8_LDB(dst, b, h) do { _Pragma("unroll") for (int n = 0; n < 2; ++n) _Pragma("unroll") for (int k = 0; k < 2; ++k) dst[n][k] = *(const PG8_LAS bf16x8*)(lds + PG8_SB(b, h) + boff + n * 2048 + k * 1024); } while (0)
#define PG8_MMA(ai, bj, At, Bt) do { __builtin_amdgcn_s_setprio(1); _Pragma("unroll") for (int m = 0; m < 4; ++m) _Pragma("unroll") for (int n = 0; n < 2; ++n) _Pragma("unroll") for (int k = 0; k < 2; ++k) \
        acc[ai][bj][m][n] = mma16<Epi::I8>(Bt[n][k], At[m][k], acc[ai][bj][m][n]); __builtin_amdgcn_s_setprio(0); } while (0)
#define PG8_WAIT_V(n) asm volatile("s_waitcnt vmcnt(" #n ")" ::: "memory")
#define PG8_WAIT_VS() asm volatile("s_waitcnt vmcnt(%0)" :: "n"(8 + Side::NV) : "memory")
#define PG8_WAIT_L(n) asm volatile("s_waitcnt lgkmcnt(" #n ")" ::: "memory")
#define PG8_BAR __builtin_amdgcn_s_barrier()
#define PG8_SCHED __builtin_amdgcn_sched_barrier(0)
    Unit cur, nxt; int ui = 0;
    if (!S.next(0, cur)) return;
    typedef typename Epi::acc_t acc_t;
    acc_t acc[2][2][4][2];
#pragma unroll
    for (int a = 0; a < 2; ++a)
#pragma unroll
        for (int b = 0; b < 2; ++b)
#pragma unroll
            for (int m = 0; m < 4; ++m)
#pragma unroll
                for (int n = 0; n < 2; ++n) acc[a][b][m][n] = (acc_t){0, 0, 0, 0};
    bf16x8 At[4][2], B0[2][2], B1[2][2];
    const char* cA = (const char*)g.A + (size_t)cur.pm() * tstep + (size_t)cur.k0() * kstep; const char* cB = (const char*)g.Bt + (size_t)cur.pn() * tstep + (size_t)cur.k0() * kstep;
    S.a_ready(cur);
    if constexpr (SP2) {
        PG8_STAGE(PG8_SB(0, 0), cB, voffB); PG8_STAGE(PG8_SB(0, 1), cB + hstep, voffB); PG8_STAGE(PG8_SA(0, 0), cA, voffA); PG8_STAGE(PG8_SA(0, 1), cA + hstep, voffA);
        if (wr == 1) PG8_BAR;
        PG8_WAIT_V(2); PG8_BAR;
        PG8_STAGE(PG8_SB(1, 0), cB + kstep, voffB); PG8_STAGE(PG8_SA(1, 0), cA + kstep, voffA); PG8_STAGE(PG8_SB(1, 1), cB + hstep + kstep, voffB);
        PG8_WAIT_V(6); PG8_BAR;
    } else {
        PG8_STAGE(PG8_SB(0, 0), cB, voffB); PG8_STAGE(PG8_SA(0, 0), cA, voffA); PG8_STAGE(PG8_SB(0, 1), cB + hstep, voffB); PG8_STAGE(PG8_SA(0, 1), cA + hstep, voffA);
        if (wr == 1) PG8_BAR;
        PG8_WAIT_V(4); PG8_BAR;
        PG8_STAGE(PG8_SB(1, 0), cB + kstep, voffB); PG8_STAGE(PG8_SA(1, 0), cA + kstep, voffA); PG8_STAGE(PG8_SB(1, 1), cB + hstep + kstep, voffB);
        PG8_WAIT_V(6); PG8_BAR;
    }
    for (;;) {
        const bool has_next = S.next(ui + 1, nxt);
        const char* nA = has_next ? (const char*)g.A + (size_t)nxt.pm() * tstep + (size_t)nxt.k0() * kstep : cA; const char* nB = has_next ? (const char*)g.Bt + (size_t)nxt.pn() * tstep + (size_t)nxt.k0() * kstep : cB;
        const int nt = cur.nt();
        for (int t = 0; t < nt; t += 2) {
            const bool last = (t == nt - 2);
            const char* a1 = cA + (size_t)(t + 1) * kstep;
            const char* a2 = last ? nA : cA + (size_t)(t + 2) * kstep; const char* b2 = last ? nB : cB + (size_t)(t + 2) * kstep;
            const char* a3 = a2 + kstep; const char* b3 = b2 + kstep;
            if (last && has_next) S.a_ready(nxt);
            if constexpr (SP2) {
            sd.step(); PG8_SCHED;
            PG8_LDB(B0, 0, 0); PG8_LDB(B1, 0, 1); PG8_SCHED; PG8_LDA(At, 0, 0); PG8_STAGE(PG8_SA(1, 1), a1 + hstep, voffA);
            PG8_WAIT_VS(); PG8_WAIT_L(0); PG8_BAR; PG8_MMA(0, 0, At, B0); PG8_MMA(0, 1, At, B1); PG8_BAR; PG8_SCHED;
            PG8_LDA(At, 0, 1); PG8_STAGE(PG8_SB(0, 0), b2, voffB); PG8_STAGE(PG8_SB(0, 1), b2 + hstep, voffB); PG8_STAGE(PG8_SA(0, 0), a2, voffA);
            PG8_WAIT_VS(); PG8_WAIT_L(0); PG8_BAR; PG8_MMA(1, 0, At, B0); PG8_MMA(1, 1, At, B1); PG8_BAR; PG8_SCHED;
            PG8_LDB(B0, 1, 0); PG8_LDB(B1, 1, 1); PG8_SCHED; PG8_LDA(At, 1, 0); PG8_STAGE(PG8_SA(0, 1), a2 + hstep, voffA);
            PG8_WAIT_V(8); PG8_WAIT_L(0); PG8_BAR; if constexpr (Side::NV > 0) { PG8_SCHED; sd.consume(); PG8_SCHED; }
            PG8_MMA(0, 0, At, B0); PG8_MMA(0, 1, At, B1); PG8_BAR; PG8_SCHED;
            PG8_LDA(At, 1, 1); PG8_STAGE(PG8_SB(1, 0), b3, voffB); PG8_STAGE(PG8_SB(1, 1), b3 + hstep, voffB); PG8_STAGE(PG8_SA(1, 0), a3, voffA);
            PG8_WAIT_V(8); PG8_WAIT_L(0); PG8_BAR; PG8_MMA(1, 0, At, B0); PG8_MMA(1, 1, At, B1); PG8_BAR; PG8_SCHED;
            } else {
            PG8_LDB(B0, 0, 0); PG8_SCHED; PG8_LDA(At, 0, 0); PG8_STAGE(PG8_SA(1, 1), a1 + hstep, voffA);
            PG8_WAIT_L(8); PG8_BAR; PG8_WAIT_L(0); PG8_MMA(0, 0, At, B0); PG8_BAR; PG8_SCHED;
            PG8_LDB(B1, 0, 1); PG8_STAGE(PG8_SB(0, 0), b2, voffB);
            PG8_BAR; PG8_WAIT_L(0); PG8_MMA(0, 1, At, B1); PG8_BAR;
            PG8_LDA(At, 0, 1); PG8_STAGE(PG8_SA(0, 0), a2, voffA);
            PG8_BAR; PG8_WAIT_L(0); PG8_MMA(1, 0, At, B0); PG8_BAR; PG8_SCHED;
            PG8_STAGE(PG8_SB(0, 1), b2 + hstep, voffB);
            PG8_WAIT_V(6); PG8_BAR; PG8_MMA(1, 1, At, B1); PG8_BAR;
            PG8_LDB(B0, 1, 0); PG8_SCHED; PG8_LDA(At, 1, 0); PG8_STAGE(PG8_SA(0, 1), a2 + hstep, voffA);
            PG8_WAIT_L(8); PG8_BAR; PG8_WAIT_L(0); PG8_MMA(0, 0, At, B0); PG8_BAR; PG8_SCHED;
            PG8_LDB(B1, 1, 1); PG8_STAGE(PG8_SB(1, 0), b3, voffB);
            PG8_BAR; PG8_WAIT_L(0); PG8_MMA(0, 1, At, B1); PG8_BAR;
            PG8_LDA(At, 1, 1); PG8_STAGE(PG8_SA(1, 0), a3, voffA);
            PG8_BAR; PG8_WAIT_L(0); PG8_MMA(1, 0, At, B0); PG8_BAR; PG8_SCHED;
            PG8_STAGE(PG8_SB(1, 1), b3 + hstep, voffB);
            PG8_WAIT_V(6); PG8_BAR; PG8_MMA(1, 1, At, B1); PG8_BAR;
            }
        }
        if constexpr (ALIGN_EPI) { if (wr == 0) PG8_BAR; }
        if constexpr (!Epi::AFTER_DRAIN) { int fr_ = fr, fq_ = fq; asm volatile("" : "+v"(fr_), "+v"(fq_));
            E(acc, cur, wr, wc, fr_, fq_); S.done(cur); }
        if (!has_next) break;
#pragma unroll
        for (int a = 0; a < 2; ++a)
#pragma unroll
            for (int b = 0; b < 2; ++b)
#pragma unroll
                for (int m = 0; m < 4; ++m)
#pragma unroll
                    for (int n = 0; n < 2; ++n) acc[a][b][m][n] = (acc_t){0, 0, 0, 0};
        cur = nxt; cA = nA; cB = nB; ++ui;
        if constexpr (ALIGN_EPI) { if (wr == 1) PG8_BAR; }
    }
    PG8_WAIT_V(0);
    if constexpr (!ALIGN_EPI) { if (wr == 0) PG8_BAR; }
    PG8_BAR;
    if constexpr (Epi::AFTER_DRAIN) { E.fused(acc, cur, wr, wc, fr, fq, lds, wid, lane); S.done(cur); }
#undef PG8_SA
#undef PG8_SB
#undef PG8_STAGE
#undef PG8_LDA
#undef PG8_LDB
#undef PG8_MMA
#undef PG8_WAIT_V
#undef PG8_WAIT_L
#undef PG8_WAIT_VS
#undef PG8_BAR
#undef PG8_SCHED
}
template <class Epi, class Sched, bool ALIGN_EPI = false, bool SP2 = false>
__device__ __forceinline__ void gemm_phase(PG8_LAS unsigned char* lds, const Gemm g, const Sched& S, const Epi& E) { NoSide ns; gemm_phase<Epi, Sched, ALIGN_EPI, SP2, NoSide>(lds, g, S, E, ns); }
}

#ifndef PG8_SP2
#define PG8_SP2 true
#endif
#ifndef PG8_ALIGN
#define PG8_ALIGN true
#endif
#define GAS __attribute__((address_space(1)))
#define LAS __attribute__((address_space(3)))
typedef unsigned short bf16;
typedef unsigned v4u __attribute__((ext_vector_type(4)));
typedef float f32x4 __attribute__((ext_vector_type(4)));
typedef short bf16x8 __attribute__((ext_vector_type(8)));
typedef GAS unsigned gu32;
typedef GAS unsigned long long gu64;
#define RLX_AGENT __ATOMIC_RELAXED, __HIP_MEMORY_SCOPE_AGENT
#define LDS_WAIT() asm volatile("s_waitcnt lgkmcnt(0)" ::: "memory")
#define VM_WAIT() asm volatile("s_waitcnt vmcnt(0)" ::: "memory")
__device__ __forceinline__ unsigned long long rt() { return __builtin_amdgcn_s_memrealtime(); }
__device__ __forceinline__ unsigned f2bf(float f) { unsigned u = __builtin_bit_cast(unsigned, f); return (u + 0x7fffu + ((u >> 16) & 1u)) >> 16; }
__device__ __forceinline__ unsigned pk2(float lo, float hi) { return f2bf(lo) | (f2bf(hi) << 16); }

#define XB_TMO      128
#define XB_XCNT(j)  (256  + 64 * (j))
#define XB_XSUB(j)  (1280 + 64 * (j))
#define XB_XGEN(j)  (2304 + 64 * (j))
#define XB_TOP      3328
#define XB_TOPGEN   3392
#define XCD_BAR_WORDS 3456
#define XB_SPIN_CAP (1u << 18)

__device__ __forceinline__ unsigned xb_ld(unsigned* p)              { return __hip_atomic_load(p, __ATOMIC_RELAXED, __HIP_MEMORY_SCOPE_AGENT); }
__device__ __forceinline__ unsigned xb_add(unsigned* p, unsigned v) { return __hip_atomic_fetch_add(p, v, __ATOMIC_RELAXED, __HIP_MEMORY_SCOPE_AGENT); }
__device__ __forceinline__ unsigned xb_xcc_id() { return (unsigned)__builtin_amdgcn_s_getreg((3 << 11) | 20) & 0xFu; }
#define XB_SPIN(cond, bar) do { unsigned _sp = 0; while (cond) { __builtin_amdgcn_s_sleep(1); \
    if ((++_sp & 255u) == 0u) { if (xb_ld(&(bar)[XB_TMO])) break; if (_sp > XB_SPIN_CAP) { atomicAdd(&(bar)[XB_TMO], 1u); break; } } } } while (0)

struct XcdBarrier {
    unsigned* bar; unsigned x; unsigned w;
    volatile LAS unsigned* st;
};

__device__ __forceinline__ XcdBarrier xcd_barrier_post(unsigned* bar, volatile LAS unsigned* st) {
    XcdBarrier b; b.bar = bar; b.x = xb_xcc_id(); b.st = st; b.w = (unsigned)__builtin_amdgcn_readfirstlane((int)(threadIdx.x >> 6));
    if (threadIdx.x == 0) (void)xb_add(&bar[XB_XCNT(b.x)], 1u);
    return b;
}
__device__ __forceinline__ void xcd_barrier_complete(unsigned* bar, unsigned x, unsigned& nloc, unsigned& nx) {
    const unsigned G = gridDim.x * gridDim.y * gridDim.z;
    unsigned sum, cnt, mine, sp = 0u;
    for (;;) {
        sum = 0u; cnt = 0u; mine = 0u;
#pragma unroll
        for (unsigned j = 0; j < 16; ++j) { const unsigned c = xb_ld(&bar[XB_XCNT(j)]); sum += c; cnt += (c > 0u) ? 1u : 0u; mine = (j == x) ? c : mine; }
        if (sum == G) break;
        __builtin_amdgcn_s_sleep(1);
        if ((++sp & 255u) == 0u) { if (xb_ld(&bar[XB_TMO])) break; if (sp > XB_SPIN_CAP) { atomicAdd(&bar[XB_TMO], 1u); break; } }
    }
    nloc = mine > 0u ? mine : 1u; nx = cnt > 0u ? cnt : 1u;
}

__device__ __forceinline__ void xcd_barrier(const XcdBarrier& b) {
    asm volatile("s_waitcnt vmcnt(0)" ::: "memory");
    __syncthreads();
    if (b.w == 0u && __builtin_amdgcn_mbcnt_hi(~0u, __builtin_amdgcn_mbcnt_lo(~0u, 0u)) == 0u) {
        unsigned* bar = b.bar;
        __builtin_amdgcn_s_waitcnt(0);
        unsigned nloc = b.st[0], nx = b.st[1];
        if (nloc == 0u) { xcd_barrier_complete(bar, b.x, nloc, nx); b.st[0] = nloc; b.st[1] = nx; }
        const unsigned old = xb_add(&bar[XB_XSUB(b.x)], 1u);
        const unsigned gen = old / nloc;
        if (old + 1u == (gen + 1u) * nloc) {
            __builtin_amdgcn_fence(__ATOMIC_RELEASE, "agent");
            asm volatile("s_waitcnt vmcnt(0)" ::: "memory");
            const unsigned og = xb_add(&bar[XB_TOP], 1u);
            const unsigned tg = og / nx;
            if (og + 1u == (tg + 1u) * nx) xb_add(&bar[XB_TOPGEN], 1u);
            else XB_SPIN(xb_ld(&bar[XB_TOPGEN]) == tg, bar);
            __builtin_amdgcn_fence(__ATOMIC_ACQUIRE, "agent");
            xb_add(&bar[XB_XGEN(b.x)], 1u);
            asm volatile("s_waitcnt vmcnt(0)" ::: "memory");
        } else {
            XB_SPIN(xb_ld(&bar[XB_XGEN(b.x)]) == gen, bar);
            __builtin_amdgcn_fence(__ATOMIC_ACQUIRE, "agent");
            asm volatile("s_waitcnt vmcnt(0)" ::: "memory");
        }
    }
    __syncthreads();
}

constexpr int NWAVES = 8;
constexpr int NCONV_CU = 0;
constexpr int D = 4096, NBATCH = 4, SEQ = 2048, NSAMP = 128, NMETA = 16;
constexpr int MPR = NBATCH * SEQ;
constexpr int ROW_S = MPR;
constexpr int ROW_META = MPR + NSAMP;
constexpr int MROWS = ROW_META + NMETA;
constexpr int MPAD = 8448;
constexpr int NIN = 12544;
constexpr int C_K = 0, C_V = 1024, C_CC = 3072, C_CH = 5120, C_AL = 7168, NBF = 7424, C_Q = 7424, C_G = 8448, C_CB = 10496, NI8X = 5120, NI8 = 9216;
static_assert(NBF + NI8X == 12544, "in-proj width");
constexpr int XROWS = pg8::XROWS;
constexpr int DFF = 11008, NGU = 2 * DFF;
constexpr int NH = 4, DK = 256, DV = 512, DGV = 2048, DCONV = 2048, RANK = 16, DGK = 1024;
constexpr float ALPHA = 1.18920711500272f;
constexpr float LN_EPS = 1e-5f, RMS_EPS = 1e-6f;
constexpr size_t O_YP = 0, O_YS = (size_t)MPR * D, O_GP = O_YS + (size_t)NSAMP * D, O_CP = O_GP + (size_t)NBATCH * NH * DK * DV,
                 O_GS = O_CP + (size_t)NBATCH * 2 * DCONV, O_CS = O_GS + (size_t)NSAMP * NH * DK * DV, O_END = O_CS + (size_t)NSAMP * 2 * DCONV;
constexpr size_t MiB = 1u << 20;
constexpr size_t WS_CTL = 0, CTL_ZERO_BYTES = 1 * MiB;
constexpr size_t WS_WIN = 1 * MiB;
constexpr size_t WS_WOUT = WS_WIN + 98 * MiB;
constexpr size_t WS_WGU = WS_WOUT + 32 * MiB;
constexpr size_t WS_WDN = WS_WGU + 172 * MiB;
constexpr size_t WS_H0 = WS_WDN + 86 * MiB;
constexpr size_t WS_PROJ = WS_H0 + 66 * MiB;
constexpr size_t WS_MIX = WS_PROJ + 203 * MiB;
constexpr size_t WS_OBUF = WS_MIX + 66 * MiB;
constexpr size_t WS_R = WS_OBUF + 33 * MiB;
constexpr size_t WS_SLAB = WS_R + 132 * MiB;
constexpr size_t WS_H1Q = WS_SLAB + 48 * MiB;
constexpr size_t WS_END = WS_H1Q + 34 * MiB;
constexpr size_t CTL_RS0 = 800 * 1024, CTL_CMIN = 840 * 1024;
constexpr size_t CTL_AMAX = 704 * 1024, CTL_CMDN = 768 * 1024;
constexpr size_t CTL_CMAX = 512 * 1024, CTL_RSC = 640 * 1024;
constexpr size_t SLAB_A_OFF = 24 * MiB;
static_assert((size_t)NIN * D * 2 <= 98 * MiB && (size_t)NGU * D * 2 <= 172 * MiB && (size_t)D * DFF * 2 <= 86 * MiB && (size_t)MPAD * D * 2 <= 66 * MiB && (size_t)MPAD * NIN * 2 <= 203 * MiB && (size_t)MPAD * D * 4 <= 132 * MiB, "ws map");
constexpr int CW_BAR = 4096;
constexpr int RING_OFF = 0, RING_BYTES = 131072;
constexpr int LDSCTL_OFF = RING_BYTES, MISC_OFF = LDSCTL_OFF + 320;
constexpr int LDS_BYTES = 147456;
static_assert(MISC_OFF + 128 <= LDS_BYTES, "LDS map");

__device__ __forceinline__ unsigned long long karg(int i) {
    const unsigned long long ka = (unsigned long long)__builtin_amdgcn_kernarg_segment_ptr(); unsigned long long p;
    asm volatile("s_load_dwordx2 %0, %1, %2\n\ts_waitcnt lgkmcnt(0)" : "=s"(p) : "s"(ka), "n"(i * 8) : "memory");
    return p;
}
enum { A_XP = 0, A_XS, A_SGLA, A_SCONV, A_META, A_EMBG, A_EMBB, A_WIN, A_WA2, A_BA, A_GNORM, A_CONVW, A_WOUT, A_LN1G, A_LN1B, A_WGATE, A_WUP, A_WDOWN, A_LN2G, A_LN2B, A_OUT, A_WS };
struct Frame {
    LAS unsigned char* lds;
    volatile LAS unsigned* MISC;
    gu32* ctl;
    int tid, lane, wave;
    int vcu, G;
    __device__ __forceinline__ void refresh() { int l = (int)__builtin_amdgcn_mbcnt_hi(~0u, __builtin_amdgcn_mbcnt_lo(~0u, 0u)); asm volatile("" : "+v"(l)); lane = l; tid = wave * 64 + l;   int g = G; asm volatile("" : "+s"(g)); G = g; }
    unsigned char* ws;
    template <int I> __device__ __forceinline__ const float* in() const { return (const float*)(const GAS float*)karg(I); }
    __device__ __forceinline__ float* out() const { return (float*)(GAS float*)karg(A_OUT); }
    __device__ __forceinline__ bf16* Wt_in() const { return (bf16*)(ws + WS_WIN); }
    __device__ __forceinline__ bf16* Wt_out() const { return (bf16*)(ws + WS_WOUT); }
    __device__ __forceinline__ bf16* Wt_gu() const { return (bf16*)(ws + WS_WGU); }
    __device__ __forceinline__ bf16* Wt_dn() const { return (bf16*)(ws + WS_WDN); }
    __device__ __forceinline__ bf16* h0() const { return (bf16*)(ws + WS_H0); }
    __device__ __forceinline__ bf16* proj() const { return (bf16*)(ws + WS_PROJ); }
    __device__ __forceinline__ bf16* act() const { return (bf16*)(ws + WS_PROJ); }
    __device__ __forceinline__ bf16* mix() const { return (bf16*)(ws + WS_MIX); }
    __device__ __forceinline__ bf16* h1() const { return (bf16*)(ws + WS_MIX); }
    __device__ __forceinline__ bf16* obuf() const { return (bf16*)(ws + WS_OBUF); }
    __device__ __forceinline__ bf16* R() const { return (bf16*)(ws + WS_R); }
    __device__ __forceinline__ unsigned char* gscr() const { return ws + WS_R; }
    __device__ __forceinline__ float* slab() const { return (float*)(ws + WS_SLAB); }
    __device__ __forceinline__ signed char* h1q() const { return (signed char*)(ws + WS_H1Q); }
    __device__ __forceinline__ float* cmax() const { return (float*)(ws + WS_CTL + CTL_CMAX); }
    __device__ __forceinline__ float* rsc() const { return (float*)(ws + WS_CTL + CTL_RSC); }
    __device__ __forceinline__ float* amax() const { return (float*)(ws + WS_CTL + CTL_AMAX); }
    __device__ __forceinline__ float* rs0() const { return (float*)(ws + WS_CTL + CTL_RS0); }
    __device__ __forceinline__ float* cmin() const { return (float*)(ws + WS_CTL + CTL_CMIN); }
    __device__ __forceinline__ signed char* h0q() const { return (signed char*)(ws + WS_WGU); }
    __device__ __forceinline__ signed char* Wq_in() const { return (signed char*)(ws + WS_WDN); }
    __device__ __forceinline__ float* cmdn() const { return (float*)(ws + WS_CTL + CTL_CMDN); }
    __device__ __forceinline__ signed char* actq() const { return (signed char*)(ws + WS_WIN); }
};
typedef unsigned u32x2v __attribute__((ext_vector_type(2)));
__device__ __forceinline__ float wave_sum(float v) {
#pragma unroll
    for (int o = 1; o < 64; o <<= 1) v += __shfl_xor(v, o);
    return v;
}
__device__ __forceinline__ unsigned q4(float a, float b, float c, float d, float inv) {
    int x = __float2int_rn(a * inv), y = __float2int_rn(b * inv), z = __float2int_rn(c * inv), w = __float2int_rn(d * inv);
    x = min(max(x, -127), 127); y = min(max(y, -127), 127); z = min(max(z, -127), 127); w = min(max(w, -127), 127);
    return (unsigned)(x & 0xff) | ((unsigned)(y & 0xff) << 8) | ((unsigned)(z & 0xff) << 16) | ((unsigned)(w & 0xff) << 24);
}
__device__ __forceinline__ float wave_max(float v) {
#pragma unroll
    for (int o = 1; o < 64; o <<= 1) v = fmaxf(v, __shfl_xor(v, o));
    return v;
}
__device__ __forceinline__ float bflo(unsigned w) { return __uint_as_float(w << 16); }
__device__ __forceinline__ float bfhi(unsigned w) { return __uint_as_float(w & 0xffff0000u); }
__device__ __forceinline__ float bf2f(bf16 h) { return __uint_as_float(((unsigned)h) << 16); }
__device__ __forceinline__ float silu(float a) { return a * __builtin_amdgcn_rcpf(1.0f + __builtin_amdgcn_exp2f(-1.44269504089f * a)); }
__device__ __forceinline__ float logsigmoid(float z) { return fminf(z, 0.f) - __logf(1.0f + __expf(-fabsf(z))); }
__device__ __forceinline__ void unpack8(const v4u w, float (&f)[8]) { f[0] = bflo(w.x); f[1] = bfhi(w.x); f[2] = bflo(w.y); f[3] = bfhi(w.y); f[4] = bflo(w.z); f[5] = bfhi(w.z); f[6] = bflo(w.w); f[7] = bfhi(w.w); }
__device__ __forceinline__ v4u pack8(const float (&f)[8]) { v4u w; w.x = pk2(f[0], f[1]); w.y = pk2(f[2], f[3]); w.z = pk2(f[4], f[5]); w.w = pk2(f[6], f[7]); return w; }

__device__ __forceinline__ void p0_transpose_item(const float* W, int ldw, int src_col0, int nvalid, bf16* WT, int K, int dst_row0, int k0, int lane, unsigned* cm = nullptr) {
    const int ng = lane & 7, kg = lane >> 3;
    f32x4 x[8];
    const float* src = W + (size_t)(k0 + 8 * kg) * ldw + src_col0 + 4 * ng;
    if (4 * ng < nvalid) {
#pragma unroll
        for (int i = 0; i < 8; ++i) x[i] = __builtin_nontemporal_load((const f32x4*)(src + (size_t)i * ldw));
    } else {
#pragma unroll
        for (int i = 0; i < 8; ++i) x[i] = (f32x4){0.f, 0.f, 0.f, 0.f};
    }
    if (cm) { f32x4 m = (f32x4){0.f, 0.f, 0.f, 0.f};
#pragma unroll
        for (int i = 0; i < 8; ++i) { m.x = fmaxf(m.x, fabsf(x[i].x)); m.y = fmaxf(m.y, fabsf(x[i].y)); m.z = fmaxf(m.z, fabsf(x[i].z)); m.w = fmaxf(m.w, fabsf(x[i].w)); }
#pragma unroll
        for (int o = 8; o < 64; o <<= 1) { m.x = fmaxf(m.x, __shfl_xor(m.x, o)); m.y = fmaxf(m.y, __shfl_xor(m.y, o)); m.z = fmaxf(m.z, __shfl_xor(m.z, o)); m.w = fmaxf(m.w, __shfl_xor(m.w, o)); }
        if (kg == 0) { unsigned* c = cm + 4 * ng; __hip_atomic_fetch_max(c + 0, __float_as_uint(m.x), __ATOMIC_RELAXED, __HIP_MEMORY_SCOPE_AGENT); __hip_atomic_fetch_max(c + 1, __float_as_uint(m.y), __ATOMIC_RELAXED, __HIP_MEMORY_SCOPE_AGENT);
            __hip_atomic_fetch_max(c + 2, __float_as_uint(m.z), __ATOMIC_RELAXED, __HIP_MEMORY_SCOPE_AGENT); __hip_atomic_fetch_max(c + 3, __float_as_uint(m.w), __ATOMIC_RELAXED, __HIP_MEMORY_SCOPE_AGENT); } }
    bf16* dst = WT + (size_t)(dst_row0 + 4 * ng) * K + k0 + 8 * kg;
    { v4u o; o.x = pk2(x[0].x, x[1].x); o.y = pk2(x[2].x, x[3].x); o.z = pk2(x[4].x, x[5].x); o.w = pk2(x[6].x, x[7].x); *(GAS v4u*)(dst) = o; }
    { v4u o; o.x = pk2(x[0].y, x[1].y); o.y = pk2(x[2].y, x[3].y); o.z = pk2(x[4].y, x[5].y); o.w = pk2(x[6].y, x[7].y); *(GAS v4u*)(dst + (size_t)K) = o; }
    { v4u o; o.x = pk2(x[0].z, x[1].z); o.y = pk2(x[2].z, x[3].z); o.z = pk2(x[4].z, x[5].z); o.w = pk2(x[6].z, x[7].z); *(GAS v4u*)(dst + (size_t)2 * K) = o; }
    { v4u o; o.x = pk2(x[0].w, x[1].w); o.y = pk2(x[2].w, x[3].w); o.z = pk2(x[4].w, x[5].w); o.w = pk2(x[6].w, x[7].w); *(GAS v4u*)(dst + (size_t)3 * K) = o; }
}
template <bool OUT_F32>
__device__ __forceinline__ void ln_row(const float* src, const float* g, const float* b, void* dst, int lane) {
    const GAS f32x4* xr = (const GAS f32x4*)src + lane;
    f32x4 v[16]; float s = 0.f;
#pragma unroll
    for (int j = 0; j < 16; ++j) { v[j] = __builtin_nontemporal_load(xr + 64 * j); s += (v[j].x + v[j].y) + (v[j].z + v[j].w); }
    const float mean = wave_sum(s) * (1.f / D); float s2 = 0.f;
#pragma unroll
    for (int j = 0; j < 16; ++j) { v[j] = v[j] - mean; s2 += (v[j].x * v[j].x + v[j].y * v[j].y) + (v[j].z * v[j].z + v[j].w * v[j].w); }
    const float rstd = 1.f / sqrtf(wave_sum(s2) * (1.f / D) + LN_EPS);
    const GAS f32x4* gr = (const GAS f32x4*)g + lane; const GAS f32x4* br = (const GAS f32x4*)b + lane;
#pragma unroll
    for (int j = 0; j < 16; ++j) { const f32x4 o = v[j] * rstd * gr[64 * j] + br[64 * j];
        if (OUT_F32) ((GAS f32x4*)dst)[lane + 64 * j] = o;
        else { u32x2v w; w.x = pk2(o.x, o.y); w.y = pk2(o.z, o.w); ((GAS u32x2v*)dst)[lane + 64 * j] = w; } }
}
template <bool OUT_F32, int NSL>
__device__ __forceinline__ void ln_row_slab_block(Frame& F, const float* slab, int r, const bf16* res, const float* g, const float* b, void* dst, signed char* dq = nullptr, float* scale = nullptr) {
    LAS float* red = (LAS float*)(F.lds);
    const int t = F.tid; float v[8];
    unpack8(*(const v4u*)(res + 8 * t), v);
#pragma unroll
    for (int e = 0; e < 8; ++e) v[e] *= ALPHA;
#pragma unroll 4
    for (int s = 0; s < NSL; ++s) { const f32x4* p = (const f32x4*)(slab + ((size_t)s * 128 + r) * D + 8 * t); const f32x4 a = p[0], c = p[1];
        v[0] += a.x; v[1] += a.y; v[2] += a.z; v[3] += a.w; v[4] += c.x; v[5] += c.y; v[6] += c.z; v[7] += c.w; }
    float s1 = 0.f;
#pragma unroll
    for (int e = 0; e < 8; ++e) s1 += v[e];
    s1 = wave_sum(s1);
    __syncthreads();
    if (F.lane == 0) red[F.wave] = s1;
    __syncthreads();
    float tot = 0.f;
#pragma unroll
    for (int w = 0; w < 8; ++w) tot += red[w];
    const float mean = tot * (1.f / D); float s2 = 0.f;
#pragma unroll
    for (int e = 0; e < 8; ++e) { v[e] -= mean; s2 += v[e] * v[e]; }
    s2 = wave_sum(s2);
    if (F.lane == 0) red[8 + F.wave] = s2;
    __syncthreads();
    float tot2 = 0.f;
#pragma unroll
    for (int w = 0; w < 8; ++w) tot2 += red[8 + w];
    const float rstd = 1.f / sqrtf(tot2 * (1.f / D) + LN_EPS);
    const f32x4* gp = (const f32x4*)(g + 8 * t); const f32x4* bp = (const f32x4*)(b + 8 * t); const f32x4 g0 = gp[0], g1 = gp[1], b0 = bp[0], b1 = bp[1];
    float o[8]; o[0] = v[0] * rstd * g0.x + b0.x; o[1] = v[1] * rstd * g0.y + b0.y; o[2] = v[2] * rstd * g0.z + b0.z; o[3] = v[3] * rstd * g0.w + b0.w;
    o[4] = v[4] * rstd * g1.x + b1.x; o[5] = v[5] * rstd * g1.y + b1.y; o[6] = v[6] * rstd * g1.z + b1.z; o[7] = v[7] * rstd * g1.w + b1.w;
    if (OUT_F32) { f32x4* op = (f32x4*)((float*)dst + 8 * t); op[0] = (f32x4){o[0], o[1], o[2], o[3]}; op[1] = (f32x4){o[4], o[5], o[6], o[7]}; }
    else { *(v4u*)((bf16*)dst + 8 * t) = pack8(o);
        if (dq) {
            float mx = 0.f;
#pragma unroll
            for (int e = 0; e < 8; ++e) mx = fmaxf(mx, fabsf(o[e]));
            mx = wave_max(mx);
            __syncthreads();
            if (F.lane == 0) red[F.wave] = mx;
            __syncthreads();
            float tm = 0.f;
#pragma unroll
            for (int w = 0; w < 8; ++w) tm = fmaxf(tm, red[w]);
            const float inv = tm > 0.f ? 127.0f / tm : 0.f;
            if (t == 0) *scale = tm * (1.0f / 127.0f);
            u32x2v q; q.x = q4(o[0], o[1], o[2], o[3], inv); q.y = q4(o[4], o[5], o[6], o[7], inv); *(u32x2v*)(dq + 8 * t) = q; } }
}
constexpr int LDS_GB = 65536;
__device__ __forceinline__ void stage_gb(Frame& F, const float* g, const float* b) {
    LAS f32x4* Lg = (LAS f32x4*)(F.lds + LDS_GB); __syncthreads();
    for (int i = F.tid; i < D / 4; i += NWAVES * 64) { Lg[i] = ((const GAS f32x4*)(const GAS float*)g)[i]; Lg[D / 4 + i] = ((const GAS f32x4*)(const GAS float*)b)[i]; }
    __syncthreads(); }
template <bool OUT_F32>
__device__ __forceinline__ void ln_row_b16(const bf16* src, const LAS f32x4* Lg, void* dst, int lane) {
    const GAS v4u* xr = (const GAS v4u*)src + lane;
    float v[8][8]; float s = 0.f;
#pragma unroll
    for (int j = 0; j < 8; ++j) { unpack8(__builtin_nontemporal_load(xr + 64 * j), v[j]);
#pragma unroll
        for (int e = 0; e < 8; ++e) s += v[j][e]; }
    const float mean = wave_sum(s) * (1.f / D); float s2 = 0.f;
#pragma unroll
    for (int j = 0; j < 8; ++j)
#pragma unroll
        for (int e = 0; e < 8; ++e) { v[j][e] -= mean; s2 += v[j][e] * v[j][e]; }
    const float rstd = 1.f / sqrtf(wave_sum(s2) * (1.f / D) + LN_EPS);
#pragma unroll
    for (int j = 0; j < 8; ++j) { const int c0 = 8 * (lane + 64 * j); const LAS f32x4* gp = Lg + c0 / 4; const f32x4 g0 = gp[0], g1 = gp[1], b0 = gp[D / 4], b1 = gp[D / 4 + 1];
        float o[8]; o[0] = v[j][0] * rstd * g0.x + b0.x; o[1] = v[j][1] * rstd * g0.y + b0.y; o[2] = v[j][2] * rstd * g0.z + b0.z; o[3] = v[j][3] * rstd * g0.w + b0.w;
        o[4] = v[j][4] * rstd * g1.x + b1.x; o[5] = v[j][5] * rstd * g1.y + b1.y; o[6] = v[j][6] * rstd * g1.z + b1.z; o[7] = v[j][7] * rstd * g1.w + b1.w;
        if (OUT_F32) { GAS f32x4* op = (GAS f32x4*)((float*)dst + c0); op[0] = (f32x4){o[0], o[1], o[2], o[3]}; op[1] = (f32x4){o[4], o[5], o[6], o[7]}; }
        else *(GAS v4u*)((bf16*)dst + c0) = pack8(o); }
}
constexpr int NB_IN = NBF / 32 - 7, NB_ALL = NB_IN + NI8X / 32, I_IN = 64 * NB_IN, NB_OUT = 128, I_OUT = 64 * NB_OUT, NB_GU = NGU / 32, I_GU = 64 * NB_GU, NB_DN = 128, I_DN = (DFF / 64) * NB_DN;
__device__ __forceinline__ void ln0_row_quant(const float* src, const LAS f32x4* Lg, bf16* dst, signed char* dq, float* scale, int lane) {
    const GAS f32x4* xr = (const GAS f32x4*)src + lane;
    f32x4 v[16]; float s = 0.f;
#pragma unroll
    for (int j = 0; j < 16; ++j) { v[j] = __builtin_nontemporal_load(xr + 64 * j); s += (v[j].x + v[j].y) + (v[j].z + v[j].w); }
    const float mean = wave_sum(s) * (1.f / D); float s2 = 0.f;
#pragma unroll
    for (int j = 0; j < 16; ++j) { v[j] = v[j] - mean; s2 += (v[j].x * v[j].x + v[j].y * v[j].y) + (v[j].z * v[j].z + v[j].w * v[j].w); }
    const float rstd = 1.f / sqrtf(wave_sum(s2) * (1.f / D) + LN_EPS); float mx = 0.f;
    const LAS f32x4* gr = Lg + lane; const LAS f32x4* br = Lg + D / 4 + lane;
#pragma unroll
    for (int j = 0; j < 16; ++j) { v[j] = v[j] * rstd * gr[64 * j] + br[64 * j]; mx = fmaxf(mx, fmaxf(fmaxf(fabsf(v[j].x), fabsf(v[j].y)), fmaxf(fabsf(v[j].z), fabsf(v[j].w))));
        u32x2v w; w.x = pk2(v[j].x, v[j].y); w.y = pk2(v[j].z, v[j].w); ((GAS u32x2v*)dst)[lane + 64 * j] = w; }
    mx = wave_max(mx); const float inv = mx > 0.f ? 127.0f / mx : 0.f;
    if (lane == 0) *scale = mx * (1.0f / 127.0f);
#pragma unroll
    for (int j = 0; j < 16; ++j) ((GAS unsigned*)dq)[lane + 64 * j] = q4(v[j].x, v[j].y, v[j].z, v[j].w, inv);
}
__device__ __forceinline__ int src_col_i8(int lc) { return lc < 1024 ? lc : (lc < 3072 ? lc + 3072 : lc + 3088); }
constexpr int CI_ITEMS_X = (NI8X / 256) * (D / 64), CI_ITEMS = (NI8 / 256) * (D / 64), QI_NB = NI8 / 32, QI_ITEMS = QI_NB * (D / 128);
__device__ __forceinline__ void p0_prologue(Frame& F) {
    const int gw = F.vcu * NWAVES + F.wave, NGW = F.G * NWAVES;
    const float* w_in = F.in<A_WIN>();
    for (int r = gw; r < 64 * NB_ALL; r += NGW) { const int kb = r / NB_ALL, nb = r % NB_ALL, n0 = nb < NB_IN ? 32 * nb : NBF + 32 * (nb - NB_IN);
        int src = n0 < C_CC ? n0 + 1024 : (n0 < C_AL ? n0 + 5136 : src_col_i8(n0 - NBF)), nv = 32; if (nb == NB_IN - 1) { src = 6144; nv = 16; }
        unsigned* cm = n0 >= NBF ? (unsigned*)F.cmin() + (n0 - NBF) : ((n0 >= C_CC && n0 < C_AL) ? (unsigned*)F.cmin() + NI8X + (n0 - C_CC) : nullptr);
        p0_transpose_item(w_in, 12304, src, nv, F.Wt_in(), D, n0, 64 * kb, F.lane, cm); }
    const float *x_prompt = F.in<A_XP>(), *x_sample = F.in<A_XS>(), *meta = F.in<A_META>(), *emb_g = F.in<A_EMBG>(), *emb_b = F.in<A_EMBB>();
    stage_gb(F, emb_g, emb_b);
    for (int m = gw; m < MROWS + 2 * NBATCH; m += NGW) {
        const float* src = m < ROW_S ? x_prompt + (size_t)m * D : (m < ROW_META ? x_sample + (size_t)(m - ROW_S) * D : (m < MROWS ? meta + (size_t)(m - ROW_META) * D : x_prompt + (size_t)(((m - MROWS) >> 1) * SEQ + SEQ - 2 + ((m - MROWS) & 1)) * D));
        ln0_row_quant(src, (const LAS f32x4*)(F.lds + LDS_GB), F.h0() + (size_t)m * D, F.h0q() + (size_t)m * D, F.rs0() + m, F.lane);
    }
}
__device__ __forceinline__ void quant_in_pass(Frame& F, int gw, int ngw) {
    const float* cm = F.cmin(); signed char* Wq = F.Wq_in(); const bf16* Wt = F.Wt_in(); const int lane = F.lane;
    for (int p = gw; p < NI8 / 2; p += ngw) { v4u x[2][8]; float inv[2];
#pragma unroll
        for (int rr = 0; rr < 2; ++rr) { const int lc = 2 * p + rr, srow = lc < NI8X ? NBF + lc : C_CC + (lc - NI8X); const GAS v4u* sp = (const GAS v4u*)(const GAS bf16*)(Wt + (size_t)srow * D) + lane;
#pragma unroll
            for (int j = 0; j < 8; ++j) x[rr][j] = __builtin_nontemporal_load(sp + 64 * j);
            const float c = cm[lc]; inv[rr] = c > 0.f ? 127.0f / c : 0.f; }
#pragma unroll
        for (int rr = 0; rr < 2; ++rr) { GAS u32x2v* dp = (GAS u32x2v*)(GAS signed char*)(Wq + (size_t)(2 * p + rr) * D) + lane;
#pragma unroll
            for (int j = 0; j < 8; ++j) { float f[8]; unpack8(x[rr][j], f); u32x2v q; q.x = q4(f[0], f[1], f[2], f[3], inv[rr]); q.y = q4(f[4], f[5], f[6], f[7], inv[rr]); dp[64 * j] = q; } } }
}
struct CvItem { const float* src; bf16* dst; int ldw, K; };
__device__ __forceinline__ CvItem cv_decode(Frame& F, int it, const float* w_out, const float* w_gate, const float* w_up, const float* w_down, int lane) {
    const int ng = lane & 7, kg = lane >> 3; CvItem c; int r = it;
    if (r < I_OUT) { const int kb = r / NB_OUT, nb = r % NB_OUT; c.ldw = D; c.K = D; c.src = w_out + (size_t)(64 * kb + 8 * kg) * D + 32 * nb + 4 * ng; c.dst = F.Wt_out() + (size_t)(32 * nb + 4 * ng) * D + 64 * kb + 8 * kg; return c; } r -= I_OUT;
    if (r < I_GU) { const int kb = r / NB_GU, nb = r % NB_GU, n0 = 32 * nb, pn = n0 >> 8, cc = n0 & 255; c.ldw = DFF; c.K = D;
        c.src = (cc < 128 ? w_gate : w_up) + (size_t)(64 * kb + 8 * kg) * DFF + 128 * pn + (cc & 127) + 4 * ng; c.dst = F.Wt_gu() + (size_t)(n0 + 4 * ng) * D + 64 * kb + 8 * kg; return c; } r -= I_GU;
    { const int kb = r / NB_DN, nb = r % NB_DN; c.ldw = D; c.K = DFF; c.src = w_down + (size_t)(64 * kb + 8 * kg) * D + 32 * nb + 4 * ng; c.dst = F.Wt_dn() + (size_t)(32 * nb + 4 * ng) * DFF + 64 * kb + 8 * kg; return c; }
}
__device__ __forceinline__ void cv_store(const CvItem& c, const f32x4 (&x)[8]) {
    { v4u o; o.x = pk2(x[0].x, x[1].x); o.y = pk2(x[2].x, x[3].x); o.z = pk2(x[4].x, x[5].x); o.w = pk2(x[6].x, x[7].x); __builtin_nontemporal_store(o, (GAS v4u*)(c.dst)); }
    { v4u o; o.x = pk2(x[0].y, x[1].y); o.y = pk2(x[2].y, x[3].y); o.z = pk2(x[4].y, x[5].y); o.w = pk2(x[6].y, x[7].y); __builtin_nontemporal_store(o, (GAS v4u*)(c.dst + (size_t)c.K)); }
    { v4u o; o.x = pk2(x[0].z, x[1].z); o.y = pk2(x[2].z, x[3].z); o.z = pk2(x[4].z, x[5].z); o.w = pk2(x[6].z, x[7].z); __builtin_nontemporal_store(o, (GAS v4u*)(c.dst + (size_t)2 * c.K)); }
    { v4u o; o.x = pk2(x[0].w, x[1].w); o.y = pk2(x[2].w, x[3].w); o.z = pk2(x[4].w, x[5].w); o.w = pk2(x[6].w, x[7].w); __builtin_nontemporal_store(o, (GAS v4u*)(c.dst + (size_t)3 * c.K)); }
}
__device__ __forceinline__ void convert_rest(Frame& F, int gw, int ngw, int it_lo, int it_hi) {
    const float *w_out = F.in<A_WOUT>(), *w_gate = F.in<A_WGATE>(), *w_up = F.in<A_WUP>(), *w_down = F.in<A_WDOWN>();
    const int NIT = it_hi;
    for (int it = it_lo + gw; it < NIT; it += 2 * ngw) {
        const CvItem a = cv_decode(F, it, w_out, w_gate, w_up, w_down, F.lane); const bool two = it + ngw < NIT;
        const CvItem b = cv_decode(F, two ? it + ngw : it, w_out, w_gate, w_up, w_down, F.lane);
        f32x4 xa[8], xb[8];
#pragma unroll
        for (int i = 0; i < 8; ++i) xa[i] = __builtin_nontemporal_load((const f32x4*)(a.src + (size_t)i * a.ldw));
#pragma unroll
        for (int i = 0; i < 8; ++i) xb[i] = __builtin_nontemporal_load((const f32x4*)(b.src + (size_t)i * b.ldw));
        cv_store(a, xa);
        if (two) cv_store(b, xb);
    }
}

constexpr int CM_STRIPS = DFF / 256, CM_KR = D / 64, CM_ITEMS = 2 * CM_STRIPS * CM_KR;
__device__ __forceinline__ void colmax_pass(Frame& F, int gw, int ngw) {
    const float *w_gate = F.in<A_WGATE>(), *w_up = F.in<A_WUP>(); unsigned* cm = (unsigned*)F.cmax();
    for (int it = gw; it < CM_ITEMS; it += ngw) { const int kr = it % CM_KR, sm = it / CM_KR, strip = sm % CM_STRIPS, mat = sm / CM_STRIPS, c0 = 256 * strip + 4 * F.lane;
        const float* src = (mat ? w_up : w_gate) + (size_t)(64 * kr) * DFF + c0; f32x4 m = (f32x4){0.f, 0.f, 0.f, 0.f};
#pragma unroll
        for (int b = 0; b < 4; ++b) { f32x4 x[16];
#pragma unroll
            for (int i = 0; i < 16; ++i) x[i] = *(const f32x4*)(src + (size_t)(16 * b + i) * DFF);
#pragma unroll
            for (int i = 0; i < 16; ++i) { m.x = fmaxf(m.x, fabsf(x[i].x)); m.y = fmaxf(m.y, fabsf(x[i].y)); m.z = fmaxf(m.z, fabsf(x[i].z)); m.w = fmaxf(m.w, fabsf(x[i].w)); } }
        const int gc = 256 * (c0 >> 7) + (mat ? 128 : 0) + (c0 & 127);
        __hip_atomic_fetch_max(cm + gc + 0, __float_as_uint(m.x), __ATOMIC_RELAXED, __HIP_MEMORY_SCOPE_AGENT); __hip_atomic_fetch_max(cm + gc + 1, __float_as_uint(m.y), __ATOMIC_RELAXED, __HIP_MEMORY_SCOPE_AGENT);
        __hip_atomic_fetch_max(cm + gc + 2, __float_as_uint(m.z), __ATOMIC_RELAXED, __HIP_MEMORY_SCOPE_AGENT); __hip_atomic_fetch_max(cm + gc + 3, __float_as_uint(m.w), __ATOMIC_RELAXED, __HIP_MEMORY_SCOPE_AGENT); }
}
constexpr int WQ_NB = NGU / 32, WQ_KB = D / 128, WQ_ITEMS = WQ_NB * WQ_KB;
__device__ __forceinline__ void quant_gu_pass(Frame& F, int gw, int ngw) {
    const float *w_gate = F.in<A_WGATE>(), *w_up = F.in<A_WUP>(); const float* cm = F.cmax(); signed char* Wq = (signed char*)F.Wt_gu();
    const int ng = F.lane & 7, kg = F.lane >> 3;
    for (int it = gw; it < WQ_ITEMS; it += ngw) { const int kb = it / WQ_NB, nb = it % WQ_NB, n0 = 32 * nb, pn = n0 >> 8, cc = n0 & 255, k0 = 128 * kb;
        const float* src = (cc < 128 ? w_gate : w_up) + (size_t)(k0 + 16 * kg) * DFF + 128 * pn + (cc & 127) + 4 * ng;
        f32x4 x[16];
#pragma unroll
        for (int i = 0; i < 16; ++i) x[i] = __builtin_nontemporal_load((const f32x4*)(src + (size_t)i * DFF));
        const f32x4 c4 = *(const f32x4*)(cm + n0 + 4 * ng);
        const float i0 = c4.x > 0.f ? 127.0f / c4.x : 0.f, i1 = c4.y > 0.f ? 127.0f / c4.y : 0.f, i2 = c4.z > 0.f ? 127.0f / c4.z : 0.f, i3 = c4.w > 0.f ? 127.0f / c4.w : 0.f;
        signed char* dst = Wq + (size_t)(n0 + 4 * ng) * D + k0 + 16 * kg;
        { v4u o; o.x = q4(x[0].x, x[1].x, x[2].x, x[3].x, i0); o.y = q4(x[4].x, x[5].x, x[6].x, x[7].x, i0); o.z = q4(x[8].x, x[9].x, x[10].x, x[11].x, i0); o.w = q4(x[12].x, x[13].x, x[14].x, x[15].x, i0); *(GAS v4u*)(dst) = o; }
        { v4u o; o.x = q4(x[0].y, x[1].y, x[2].y, x[3].y, i1); o.y = q4(x[4].y, x[5].y, x[6].y, x[7].y, i1); o.z = q4(x[8].y, x[9].y, x[10].y, x[11].y, i1); o.w = q4(x[12].y, x[13].y, x[14].y, x[15].y, i1); *(GAS v4u*)(dst + (size_t)D) = o; }
        { v4u o; o.x = q4(x[0].z, x[1].z, x[2].z, x[3].z, i2); o.y = q4(x[4].z, x[5].z, x[6].z, x[7].z, i2); o.z = q4(x[8].z, x[9].z, x[10].z, x[11].z, i2); o.w = q4(x[12].z, x[13].z, x[14].z, x[15].z, i2); *(GAS v4u*)(dst + (size_t)2 * D) = o; }
        { v4u o; o.x = q4(x[0].w, x[1].w, x[2].w, x[3].w, i3); o.y = q4(x[4].w, x[5].w, x[6].w, x[7].w, i3); o.z = q4(x[8].w, x[9].w, x[10].w, x[11].w, i3); o.w = q4(x[12].w, x[13].w, x[14].w, x[15].w, i3); *(GAS v4u*)(dst + (size_t)3 * D) = o; } }
}
constexpr int CD_STRIPS = D / 256, CD_KR = DFF / 64, CD_ITEMS = CD_STRIPS * CD_KR;
__device__ __forceinline__ void colmax_dn_pass(Frame& F, int gw, int ngw) {
    const float* w_down = F.in<A_WDOWN>(); unsigned* cm = (unsigned*)F.cmdn();
    for (int it = gw; it < CD_ITEMS; it += ngw) { const int kr = it % CD_KR, strip = it / CD_KR, c0 = 256 * strip + 4 * F.lane;
        const float* src = w_down + (size_t)(64 * kr) * D + c0; f32x4 m = (f32x4){0.f, 0.f, 0.f, 0.f};
#pragma unroll
        for (int b = 0; b < 4; ++b) { f32x4 x[16];
#pragma unroll
            for (int i = 0; i < 16; ++i) x[i] = *(const f32x4*)(src + (size_t)(16 * b + i) * D);
#pragma unroll
            for (int i = 0; i < 16; ++i) { m.x = fmaxf(m.x, fabsf(x[i].x)); m.y = fmaxf(m.y, fabsf(x[i].y)); m.z = fmaxf(m.z, fabsf(x[i].z)); m.w = fmaxf(m.w, fabsf(x[i].w)); } }
        __hip_atomic_fetch_max(cm + c0 + 0, __float_as_uint(m.x), __ATOMIC_RELAXED, __HIP_MEMORY_SCOPE_AGENT); __hip_atomic_fetch_max(cm + c0 + 1, __float_as_uint(m.y), __ATOMIC_RELAXED, __HIP_MEMORY_SCOPE_AGENT);
        __hip_atomic_fetch_max(cm + c0 + 2, __float_as_uint(m.z), __ATOMIC_RELAXED, __HIP_MEMORY_SCOPE_AGENT); __hip_atomic_fetch_max(cm + c0 + 3, __float_as_uint(m.w), __ATOMIC_RELAXED, __HIP_MEMORY_SCOPE_AGENT); }
}
constexpr int WD_NB = D / 32, WD_KB = DFF / 128, WD_ITEMS = WD_NB * WD_KB;
__device__ __forceinline__ void quant_dn_pass(Frame& F, int gw, int ngw) {
    const float* w_down = F.in<A_WDOWN>(); const float* cm = F.cmdn(); signed char* Wq = (signed char*)F.Wt_dn();
    const int ng = F.lane & 7, kg = F.lane >> 3;
    for (int it = gw; it < WD_ITEMS; it += ngw) { const int kb = it / WD_NB, nb = it % WD_NB, n0 = 32 * nb, k0 = 128 * kb;
        const float* src = w_down + (size_t)(k0 + 16 * kg) * D + n0 + 4 * ng;
        f32x4 x[16];
#pragma unroll
        for (int i = 0; i < 16; ++i) x[i] = __builtin_nontemporal_load((const f32x4*)(src + (size_t)i * D));
        const f32x4 c4 = *(const f32x4*)(cm + n0 + 4 * ng);
        const float i0 = c4.x > 0.f ? 127.0f / c4.x : 0.f, i1 = c4.y > 0.f ? 127.0f / c4.y : 0.f, i2 = c4.z > 0.f ? 127.0f / c4.z : 0.f, i3 = c4.w > 0.f ? 127.0f / c4.w : 0.f;
        signed char* dst = Wq + (size_t)(n0 + 4 * ng) * DFF + k0 + 16 * kg;
        { v4u o; o.x = q4(x[0].x, x[1].x, x[2].x, x[3].x, i0); o.y = q4(x[4].x, x[5].x, x[6].x, x[7].x, i0); o.z = q4(x[8].x, x[9].x, x[10].x, x[11].x, i0); o.w = q4(x[12].x, x[13].x, x[14].x, x[15].x, i0); *(GAS v4u*)(dst) = o; }
        { v4u o; o.x = q4(x[0].y, x[1].y, x[2].y, x[3].y, i1); o.y = q4(x[4].y, x[5].y, x[6].y, x[7].y, i1); o.z = q4(x[8].y, x[9].y, x[10].y, x[11].y, i1); o.w = q4(x[12].y, x[13].y, x[14].y, x[15].y, i1); *(GAS v4u*)(dst + (size_t)DFF) = o; }
        { v4u o; o.x = q4(x[0].z, x[1].z, x[2].z, x[3].z, i2); o.y = q4(x[4].z, x[5].z, x[6].z, x[7].z, i2); o.z = q4(x[8].z, x[9].z, x[10].z, x[11].z, i2); o.w = q4(x[12].z, x[13].z, x[14].z, x[15].z, i2); *(GAS v4u*)(dst + (size_t)2 * DFF) = o; }
        { v4u o; o.x = q4(x[0].w, x[1].w, x[2].w, x[3].w, i3); o.y = q4(x[4].w, x[5].w, x[6].w, x[7].w, i3); o.z = q4(x[8].w, x[9].w, x[10].w, x[11].w, i3); o.w = q4(x[12].w, x[13].w, x[14].w, x[15].w, i3); *(GAS v4u*)(dst + (size_t)3 * DFF) = o; } }
}
__device__ __forceinline__ void act_row_quant(Frame& F, int row, int lane) {
    const GAS v4u* src = (const GAS v4u*)(F.act() + (size_t)row * DFF) + lane; GAS u32x2v* dst = (GAS u32x2v*)(F.actq() + (size_t)row * DFF) + lane;
    v4u x[22]; float mx = 0.f;
#pragma unroll
    for (int i = 0; i < 21; ++i) x[i] = __builtin_nontemporal_load(src + 64 * i);
    x[21] = (lane + 64 * 21 < DFF / 8) ? __builtin_nontemporal_load(src + 64 * 21) : (v4u){0u, 0u, 0u, 0u};
#pragma unroll
    for (int i = 0; i < 22; ++i) { mx = fmaxf(mx, fmaxf(fmaxf(fabsf(bflo(x[i].x)), fabsf(bfhi(x[i].x))), fmaxf(fabsf(bflo(x[i].y)), fabsf(bfhi(x[i].y)))));
        mx = fmaxf(mx, fmaxf(fmaxf(fabsf(bflo(x[i].z)), fabsf(bfhi(x[i].z))), fmaxf(fabsf(bflo(x[i].w)), fabsf(bfhi(x[i].w))))); }
    mx = wave_max(mx); const float inv = mx > 0.f ? 127.0f / mx : 0.f;
    if (lane == 0) F.amax()[row] = mx;
#pragma unroll
    for (int i = 0; i < 22; ++i) if (lane + 64 * i < DFF / 8) { u32x2v q; q.x = q4(bflo(x[i].x), bfhi(x[i].x), bflo(x[i].y), bfhi(x[i].y), inv); q.y = q4(bflo(x[i].z), bfhi(x[i].z), bflo(x[i].w), bfhi(x[i].w), inv); dst[64 * i] = q; }
}
__device__ __forceinline__ void ln1_row_quant(const bf16* src, const LAS f32x4* Lg, bf16* dst, signed char* dq, float* scale, int lane) {
    const GAS v4u* xr = (const GAS v4u*)src + lane;
    float v[8][8]; float s = 0.f;
#pragma unroll
    for (int j = 0; j < 8; ++j) { unpack8(__builtin_nontemporal_load(xr + 64 * j), v[j]);
#pragma unroll
        for (int e = 0; e < 8; ++e) s += v[j][e]; }
    const float mean = wave_sum(s) * (1.f / D); float s2 = 0.f;
#pragma unroll
    for (int j = 0; j < 8; ++j)
#pragma unroll
        for (int e = 0; e < 8; ++e) { v[j][e] -= mean; s2 += v[j][e] * v[j][e]; }
    const float rstd = 1.f / sqrtf(wave_sum(s2) * (1.f / D) + LN_EPS); float mx = 0.f;
#pragma unroll
    for (int j = 0; j < 8; ++j) { const int c0 = 8 * (lane + 64 * j); const LAS f32x4* gp = Lg + c0 / 4; const f32x4 g0 = gp[0], g1 = gp[1], b0 = gp[D / 4], b1 = gp[D / 4 + 1];
        v[j][0] = v[j][0] * rstd * g0.x + b0.x; v[j][1] = v[j][1] * rstd * g0.y + b0.y; v[j][2] = v[j][2] * rstd * g0.z + b0.z; v[j][3] = v[j][3] * rstd * g0.w + b0.w;
        v[j][4] = v[j][4] * rstd * g1.x + b1.x; v[j][5] = v[j][5] * rstd * g1.y + b1.y; v[j][6] = v[j][6] * rstd * g1.z + b1.z; v[j][7] = v[j][7] * rstd * g1.w + b1.w;
#pragma unroll
        for (int e = 0; e < 8; ++e) mx = fmaxf(mx, fabsf(v[j][e]));
        __builtin_nontemporal_store(pack8(v[j]), (GAS v4u*)(dst + c0)); }
    mx = wave_max(mx); const float inv = mx > 0.f ? 127.0f / mx : 0.f;
    if (lane == 0) *scale = mx * (1.0f / 127.0f);
#pragma unroll
    for (int j = 0; j < 8; ++j) { u32x2v q; q.x = q4(v[j][0], v[j][1], v[j][2], v[j][3], inv); q.y = q4(v[j][4], v[j][5], v[j][6], v[j][7], inv); *(GAS u32x2v*)(dq + 8 * (lane + 64 * j)) = q; }
}

__device__ __forceinline__ void gla_sample_item(Frame& F, int it, const float* w_a2, const float* b_a, const float* state_gla, float* out) {
    const int n = it >> 2, h = it & 3, row = ROW_S + n, t = F.tid;
    LAS float* Aa = (LAS float*)(F.lds); LAS float* Kk = Aa + 256; LAS float* Qq = Aa + 512; LAS float* Ored = Aa + 768;
    const bf16* prow = F.proj() + (size_t)row * NIN;
    __syncthreads();
    if (t < 256) { const int d = t; float z = b_a[h * DK + d];
#pragma unroll
        for (int r = 0; r < 16; ++r) z += bf2f(prow[C_AL + r]) * w_a2[r * DGK + h * DK + d];
        Aa[d] = __expf(logsigmoid(z) * 0.0625f); Kk[d] = bf2f(prow[C_K + h * DK + d]); Qq[d] = bf2f(prow[C_Q + h * DK + d]) * 0.0625f; }
    __syncthreads();
    const int cg = t & 127, rg = t >> 7;
    const u32x2v vw = *(const u32x2v*)(prow + C_V + h * DV + 4 * cg);
    const f32x4 v4 = (f32x4){bflo(vw.x), bfhi(vw.x), bflo(vw.y), bfhi(vw.y)};
    const f32x4* S0 = (const f32x4*)(state_gla + (size_t)(n * NH + h) * DK * DV) + cg;
    f32x4* S1 = (f32x4*)(out + O_GS + (size_t)(n * NH + h) * DK * DV) + cg;
    f32x4 o4 = (f32x4){0.f, 0.f, 0.f, 0.f};
    for (int i0 = 0; i0 < 64; i0 += 16) {
        f32x4 s[16];
#pragma unroll
        for (int k = 0; k < 16; ++k) s[k] = __builtin_nontemporal_load(S0 + (size_t)(rg * 64 + i0 + k) * 128);
#pragma unroll
        for (int k = 0; k < 16; ++k) { const int d = rg * 64 + i0 + k; s[k] = s[k] * Aa[d] + v4 * Kk[d]; __builtin_nontemporal_store(s[k], S1 + (size_t)d * 128); o4 += s[k] * Qq[d]; }
    }
    *(LAS f32x4*)(Ored + rg * 512 + 4 * cg) = o4;
    __syncthreads();
    { const float o = (Ored[t] + Ored[512 + t]) + (Ored[1024 + t] + Ored[1536 + t]); F.obuf()[(size_t)row * DGV + h * DV + t] = (bf16)f2bf(o); }
    __syncthreads();
}
__device__ __forceinline__ void conv_row(Frame& F, int row, int lane, const float* state_conv, const float* conv_w, float* out) {
    const bool samp = row >= ROW_S; const int tq = row & (SEQ - 1), b = row >> 11, n = row - ROW_S;
    const int r1 = tq >= 1 ? row - 1 : ROW_META + 15, r2 = tq >= 2 ? row - 2 : ROW_META + 14 + tq;
    const bf16* p0 = F.proj() + (size_t)row * NIN; const bf16* p1 = F.proj() + (size_t)r1 * NIN; const bf16* p2 = F.proj() + (size_t)r2 * NIN;
#pragma unroll
    for (int jp = 0; jp < 2; ++jp) {
        v4u vcb[2], vcc[2], vch[2], vc1[2], vh1[2], vc2[2], vh2[2]; f32x4 s1[2][2], s0[2][2], wq[2][3][2];
#pragma unroll
        for (int jj = 0; jj < 2; ++jj) { const int c0 = 512 * (2 * jp + jj) + 8 * lane;
            vcb[jj] = *(const v4u*)(p0 + C_CB + c0); vcc[jj] = *(const v4u*)(p0 + C_CC + c0); vch[jj] = *(const v4u*)(p0 + C_CH + c0);
            if (!samp) { vc1[jj] = *(const v4u*)(p1 + C_CC + c0); vh1[jj] = *(const v4u*)(p1 + C_CH + c0); vc2[jj] = *(const v4u*)(p2 + C_CC + c0); vh2[jj] = *(const v4u*)(p2 + C_CH + c0); }
            else { const f32x4* q1 = (const f32x4*)(state_conv + (size_t)(n * 2 + 1) * DCONV + c0); const f32x4* q0 = (const f32x4*)(state_conv + (size_t)(n * 2 + 0) * DCONV + c0);
                s1[jj][0] = q1[0]; s1[jj][1] = q1[1]; s0[jj][0] = q0[0]; s0[jj][1] = q0[1]; }
#pragma unroll
            for (int k = 0; k < 3; ++k) { const f32x4* q = (const f32x4*)(conv_w + k * DCONV + c0); wq[jj][k][0] = q[0]; wq[jj][k][1] = q[1]; } }
#pragma unroll
        for (int jj = 0; jj < 2; ++jj) { const int c0 = 512 * (2 * jp + jj) + 8 * lane;
            float cb[8], cc[8], ch[8], ut[8], u1[8], u2[8], y[8];
            unpack8(vcb[jj], cb); unpack8(vcc[jj], cc); unpack8(vch[jj], ch);
#pragma unroll
            for (int e = 0; e < 8; ++e) ut[e] = cc[e] * ch[e];
            if (!samp) { unpack8(vc1[jj], cc); unpack8(vh1[jj], ch);
#pragma unroll
                for (int e = 0; e < 8; ++e) u1[e] = cc[e] * ch[e];
                unpack8(vc2[jj], cc); unpack8(vh2[jj], ch);
#pragma unroll
                for (int e = 0; e < 8; ++e) u2[e] = cc[e] * ch[e]; }
            else { const f32x4 a0 = s1[jj][0], a1 = s1[jj][1], b0 = s0[jj][0], b1 = s0[jj][1];
                u1[0] = a0.x; u1[1] = a0.y; u1[2] = a0.z; u1[3] = a0.w; u1[4] = a1.x; u1[5] = a1.y; u1[6] = a1.z; u1[7] = a1.w;
                u2[0] = b0.x; u2[1] = b0.y; u2[2] = b0.z; u2[3] = b0.w; u2[4] = b1.x; u2[5] = b1.y; u2[6] = b1.z; u2[7] = b1.w; }
            const float w0[8] = {wq[jj][0][0].x, wq[jj][0][0].y, wq[jj][0][0].z, wq[jj][0][0].w, wq[jj][0][1].x, wq[jj][0][1].y, wq[jj][0][1].z, wq[jj][0][1].w};
            const float w1[8] = {wq[jj][1][0].x, wq[jj][1][0].y, wq[jj][1][0].z, wq[jj][1][0].w, wq[jj][1][1].x, wq[jj][1][1].y, wq[jj][1][1].z, wq[jj][1][1].w};
            const float w2[8] = {wq[jj][2][0].x, wq[jj][2][0].y, wq[jj][2][0].z, wq[jj][2][0].w, wq[jj][2][1].x, wq[jj][2][1].y, wq[jj][2][1].z, wq[jj][2][1].w};
#pragma unroll
            for (int e = 0; e < 8; ++e) y[e] = cb[e] * (w0[e] * u2[e] + w1[e] * u1[e] + w2[e] * ut[e]);
            *(v4u*)(F.mix() + (size_t)row * D + DGV + c0) = pack8(y);
            if (!samp) { if (tq >= SEQ - 2) { f32x4* o = (f32x4*)(out + O_CP + (size_t)(b * 2 + (tq - (SEQ - 2))) * DCONV + c0); o[0] = (f32x4){ut[0], ut[1], ut[2], ut[3]}; o[1] = (f32x4){ut[4], ut[5], ut[6], ut[7]}; } }
            else { f32x4* o = (f32x4*)(out + O_CS + (size_t)(n * 2) * DCONV + c0); o[0] = (f32x4){u1[0], u1[1], u1[2], u1[3]}; o[1] = (f32x4){u1[4], u1[5], u1[6], u1[7]};
                f32x4* o2 = (f32x4*)(out + O_CS + (size_t)(n * 2 + 1) * DCONV + c0); o2[0] = (f32x4){ut[0], ut[1], ut[2], ut[3]}; o2[1] = (f32x4){ut[4], ut[5], ut[6], ut[7]}; } }
    }
}
typedef float f32x16 __attribute__((ext_vector_type(16)));
constexpr int NCH = 33, NBH = NBATCH * NH;
constexpr size_t GS_QF = 0, GS_KF = GS_QF + (size_t)NBH * NCH * 32768, GS_AF = GS_KF + (size_t)NBH * NCH * 32768, GS_VF = GS_AF + (size_t)NBH * NCH * 8192,
                 GS_EL = GS_VF + (size_t)NBH * NCH * 65536, GS_END = GS_EL + (size_t)NBH * NCH * 1024;
static_assert(GS_END <= 132 * MiB, "GLA scratch aliases the R region");
constexpr int L_QS = 0, L_KS = 33792, L_KKT = 67584, L_AT = 101376, L_AL = 110592, L_BT = 114688;
__device__ __forceinline__ int crow32(int i, int h) { return (i & 3) + 8 * (i >> 2) + 4 * h; }

__device__ __forceinline__ void conv_rows4(Frame& F, int row0, int lane, const float* conv_w, float* out) {
    const int tq0 = row0 & (SEQ - 1), b = row0 >> 11;
    const bf16* pm2 = F.proj() + (size_t)(tq0 ? row0 - 2 : ROW_META + 14) * NIN; const bf16* pm1 = F.proj() + (size_t)(tq0 ? row0 - 1 : ROW_META + 15) * NIN; const bf16* p0 = F.proj() + (size_t)row0 * NIN;
#pragma unroll 1
    for (int g = 0; g < 4; ++g) { const int c0 = 512 * g + 8 * lane;
        v4u vcc[6], vch[6], vcb[4]; f32x4 wq[3][2];
        vcc[0] = __builtin_nontemporal_load((const v4u*)(pm2 + C_CC + c0)); vch[0] = __builtin_nontemporal_load((const v4u*)(pm2 + C_CH + c0)); vcc[1] = __builtin_nontemporal_load((const v4u*)(pm1 + C_CC + c0)); vch[1] = __builtin_nontemporal_load((const v4u*)(pm1 + C_CH + c0));
#pragma unroll
        for (int i = 0; i < 4; ++i) { vcc[2 + i] = __builtin_nontemporal_load((const v4u*)(p0 + (size_t)i * NIN + C_CC + c0)); vch[2 + i] = __builtin_nontemporal_load((const v4u*)(p0 + (size_t)i * NIN + C_CH + c0)); vcb[i] = __builtin_nontemporal_load((const v4u*)(p0 + (size_t)i * NIN + C_CB + c0)); }
#pragma unroll
        for (int k = 0; k < 3; ++k) { const f32x4* q = (const f32x4*)(conv_w + k * DCONV + c0); wq[k][0] = q[0]; wq[k][1] = q[1]; }
        float u[6][8];
#pragma unroll
        for (int j = 0; j < 6; ++j) { float cc[8], ch[8]; unpack8(vcc[j], cc); unpack8(vch[j], ch);
#pragma unroll
            for (int e = 0; e < 8; ++e) u[j][e] = cc[e] * ch[e]; }
        const float w0[8] = {wq[0][0].x, wq[0][0].y, wq[0][0].z, wq[0][0].w, wq[0][1].x, wq[0][1].y, wq[0][1].z, wq[0][1].w};
        const float w1[8] = {wq[1][0].x, wq[1][0].y, wq[1][0].z, wq[1][0].w, wq[1][1].x, wq[1][1].y, wq[1][1].z, wq[1][1].w};
        const float w2[8] = {wq[2][0].x, wq[2][0].y, wq[2][0].z, wq[2][0].w, wq[2][1].x, wq[2][1].y, wq[2][1].z, wq[2][1].w};
#pragma unroll
        for (int i = 0; i < 4; ++i) { float cb[8], y[8]; unpack8(vcb[i], cb);
#pragma unroll
            for (int e = 0; e < 8; ++e) y[e] = cb[e] * (w0[e] * u[i][e] + w1[e] * u[i + 1][e] + w2[e] * u[i + 2][e]);
            *(v4u*)(F.mix() + (size_t)(row0 + i) * D + DGV + c0) = pack8(y); }
        if (tq0 == SEQ - 4) {
#pragma unroll
            for (int i = 0; i < 2; ++i) { const bf16* px = F.proj() + (size_t)(MROWS + 2 * b + i) * NIN; float cc[8], ch[8]; unpack8(*(const v4u*)(px + C_CC + c0), cc); unpack8(*(const v4u*)(px + C_CH + c0), ch);
                f32x4* o = (f32x4*)(out + O_CP + (size_t)(b * 2 + i) * DCONV + c0); o[0] = (f32x4){cc[0] * ch[0], cc[1] * ch[1], cc[2] * ch[2], cc[3] * ch[3]}; o[1] = (f32x4){cc[4] * ch[4], cc[5] * ch[5], cc[6] * ch[6], cc[7] * ch[7]}; } }
    }
}
__device__ __forceinline__ void gla_prep_qk(Frame& F, int item, const float* w_a2, const float* b_a) {
    const int bh = item / NCH, c = item - bh * NCH, b = bh >> 2, hd = bh & 3, t = F.tid, lane = F.lane, w = F.wave;
    const int nreal = c == 0 ? NMETA : 64, row0 = c == 0 ? ROW_META : b * SEQ + (c - 1) * 64;
    LAS bf16* Qs = (LAS bf16*)(F.lds + L_QS); LAS bf16* Ks = (LAS bf16*)(F.lds + L_KS); LAS unsigned* KKt = (LAS unsigned*)(F.lds + L_KKT);
    LAS bf16* At = (LAS bf16*)(F.lds + L_AT); LAS float* Al = (LAS float*)(F.lds + L_AL); LAS float* Bt = (LAS float*)(F.lds + L_BT);
    unsigned char* gs = F.gscr();
    const int d = t & 255, half = t >> 8;
    __syncthreads();
#pragma unroll
    for (int x = 0; x < 2; ++x) { const int idx = t + 512 * x, j = idx >> 4, rr = idx & 15; Al[idx] = j < nreal ? bf2f(F.proj()[(size_t)(row0 + j) * NIN + C_AL + rr]) : 0.f; }
    float w2[16];
#pragma unroll
    for (int rr = 0; rr < 16; ++rr) w2[rr] = w_a2[rr * DGK + hd * DK + d];
    const float ba = b_a[hd * DK + d];
    unsigned qv[32], kv[32];
    { const GAS unsigned char* bq = (const GAS unsigned char*)(const GAS bf16*)F.proj() + (size_t)C_Q * 2; const GAS unsigned char* bk = (const GAS unsigned char*)(const GAS bf16*)F.proj() + (size_t)C_K * 2;
      unsigned off = (unsigned)(((size_t)(row0 + half * 32) * NIN + hd * DK + d) * 2);
#pragma unroll
      for (int jj = 0; jj < 32; ++jj) { asm volatile("global_load_ushort %0, %1, %2 nt" : "=v"(qv[jj]) : "v"(off), "s"(bq) : "memory"); asm volatile("global_load_ushort %0, %1, %2 nt" : "=v"(kv[jj]) : "v"(off), "s"(bk) : "memory"); off += NIN * 2; } }
    __syncthreads();
    float bc[32]; float run = 0.f;
    const LAS float* Alh = Al + half * 512;
    LAS bf16* Qsh = Qs + half * (32 * 264) + d; LAS bf16* Ksh = Ks + half * (32 * 264) + d; LAS unsigned* KKh = KKt + d * 33 + half * 16;
#pragma unroll
    for (int jj = 0; jj < 32; ++jj) { const int j = half * 32 + jj; float z = ba;
#pragma unroll
        for (int rr = 0; rr < 16; ++rr) z += Alh[jj * 16 + rr] * w2[rr];
        float la = logsigmoid(z) * 0.0625f; if (j >= nreal) la = 0.f; run += la; bc[jj] = run; if ((jj & 3) == 3) __builtin_amdgcn_sched_barrier(0); }
    Bt[half * 256 + d] = run;
    __syncthreads();
    asm volatile("s_waitcnt vmcnt(0)" ::: "memory");
#pragma unroll
    for (int jj = 0; jj < 32; ++jj) asm volatile("" : "+v"(qv[jj]), "+v"(kv[jj]));
    const float off = half ? Bt[d] : 0.f, blast = Bt[d] + Bt[256 + d];
    if (half == 0) ((float*)(gs + GS_EL))[(size_t)(bh * NCH + c) * 256 + d] = __expf(blast);
#pragma unroll
    for (int jj = 0; jj < 32; jj += 2) { const int j = half * 32 + jj; float q0 = 0.f, k0 = 0.f, q1 = 0.f, k1 = 0.f;
        if (j < nreal) { q0 = __uint_as_float(qv[jj] << 16); k0 = __uint_as_float(kv[jj] << 16); } if (j + 1 < nreal) { q1 = __uint_as_float(qv[jj + 1] << 16); k1 = __uint_as_float(kv[jj + 1] << 16); }
        const float b0 = bc[jj] + off, b1 = bc[jj + 1] + off;
        Qsh[jj * 264] = (bf16)f2bf(q0 * __expf(b0) * 0.0625f); Qsh[(jj + 1) * 264] = (bf16)f2bf(q1 * __expf(b1) * 0.0625f);
        Ksh[jj * 264] = (bf16)f2bf(k0 * __expf(-b0)); Ksh[(jj + 1) * 264] = (bf16)f2bf(k1 * __expf(-b1));
        KKh[jj >> 1] = pk2(k0 * __expf(blast - b0), k1 * __expf(blast - b1)); __builtin_amdgcn_sched_barrier(0); }
    __syncthreads();
    { const int fr = lane & 15, fq = lane >> 4, ti = w & 3;
#pragma unroll
      for (int tt = 0; tt < 2; ++tt) { const int tj = 2 * (w >> 2) + tt; f32x4 acc = (f32x4){0.f, 0.f, 0.f, 0.f};
        if (tj <= ti) {
#pragma unroll
            for (int ks = 0; ks < 8; ++ks) { const bf16x8 A = *(const LAS bf16x8*)(Ks + (16 * tj + fr) * 264 + 32 * ks + 8 * fq); const bf16x8 B = *(const LAS bf16x8*)(Qs + (16 * ti + fr) * 264 + 32 * ks + 8 * fq);
                acc = __builtin_amdgcn_mfma_f32_16x16x32_bf16(A, B, acc, 0, 0, 0); } }
        const int i = 16 * ti + fr, j0 = 16 * tj + 4 * fq;
        u32x2v o; o.x = pk2(j0 + 0 <= i ? acc[0] : 0.f, j0 + 1 <= i ? acc[1] : 0.f); o.y = pk2(j0 + 2 <= i ? acc[2] : 0.f, j0 + 3 <= i ? acc[3] : 0.f);
        *(LAS u32x2v*)(At + i * 72 + j0) = o; } }
    __syncthreads();
    { const int r = lane & 31, h = lane >> 5;
      GAS v4u* QFg = (GAS v4u*)(gs + GS_QF) + (size_t)(bh * NCH + c) * 2048; GAS v4u* KFg = (GAS v4u*)(gs + GS_KF) + (size_t)(bh * NCH + c) * 2048; GAS v4u* AFg = (GAS v4u*)(gs + GS_AF) + (size_t)(bh * NCH + c) * 512;
#pragma unroll
      for (int ff = 0; ff < 4; ++ff) { const int f = w * 4 + ff, rt = f >> 4, kt = f & 15, i = 32 * rt + r, d0 = 16 * kt + 4 * h;
          const u32x2v lo = *(const LAS u32x2v*)(Qs + i * 264 + d0), hi = *(const LAS u32x2v*)(Qs + i * 264 + d0 + 8);
          v4u o; o.x = lo.x; o.y = lo.y; o.z = hi.x; o.w = hi.y; QFg[f * 64 + lane] = o; }
#pragma unroll
      for (int ff = 0; ff < 4; ++ff) { const int f = w * 4 + ff, dt = f >> 2, ks = f & 3, dd = 32 * dt + r; const LAS unsigned* p = KKt + dd * 33 + 8 * ks + 4 * h;
          v4u o; o.x = p[0]; o.y = p[1]; o.z = p[2]; o.w = p[3]; KFg[f * 64 + lane] = o; }
      { const int f = w, rt = f >> 2, ks = f & 3, i = 32 * rt + r, j0 = 16 * ks + 8 * h; AFg[f * 64 + lane] = *(const LAS v4u*)(At + i * 72 + j0); } }
}
__device__ __forceinline__ void gla_prep_v(Frame& F, int item) {
    const int bh = item / NCH, c = item - bh * NCH, b = bh >> 2, hd = bh & 3, t = F.tid, lane = F.lane, w = F.wave;
    const int nreal = c == 0 ? NMETA : 64, row0 = c == 0 ? ROW_META : b * SEQ + (c - 1) * 64;
    LAS bf16* Vs = (LAS bf16*)(F.lds);
    unsigned char* gs = F.gscr();
    __syncthreads();
    v4u vv[8];
#pragma unroll
    for (int x = 0; x < 8; ++x) { const int p = t + 512 * x, j = p >> 6, cc = (p & 63) * 8; vv[x] = __builtin_nontemporal_load((const v4u*)(F.proj() + (size_t)(row0 + j) * NIN + C_V + hd * DV + cc)); }
#pragma unroll
    for (int x = 0; x < 8; ++x) { const int p = t + 512 * x, j = p >> 6, cc = (p & 63) * 8; *(LAS v4u*)(Vs + j * 520 + cc) = j < nreal ? vv[x] : (v4u){0u, 0u, 0u, 0u}; }
    __syncthreads();
    const int r = lane & 31, h = lane >> 5;
    GAS v4u* VFg = (GAS v4u*)(gs + GS_VF) + (size_t)(bh * NCH + c) * 4096;
#pragma unroll
    for (int ff = 0; ff < 8; ++ff) { const int f = w * 8 + ff, vt = f >> 2, ks = f & 3, col = 32 * vt + r, j0 = 16 * ks + 8 * h; const LAS bf16* p = Vs + j0 * 520 + col;
        v4u o; o.x = (unsigned)p[0] | ((unsigned)p[520] << 16); o.y = (unsigned)p[2 * 520] | ((unsigned)p[3 * 520] << 16); o.z = (unsigned)p[4 * 520] | ((unsigned)p[5 * 520] << 16); o.w = (unsigned)p[6 * 520] | ((unsigned)p[7 * 520] << 16);
        VFg[f * 64 + lane] = o; }
}
#define MFMA32(a, b, c) __builtin_amdgcn_mfma_f32_32x32x16_bf16(__builtin_bit_cast(bf16x8, (a)), __builtin_bit_cast(bf16x8, (b)), (c), 0, 0, 0)
__device__ __forceinline__ void gla_scan(Frame& F, int unit, float* out) {
    const int bh = unit >> 4, sl = unit & 15, b = bh >> 2, hd = bh & 3, e = F.wave, lane = F.lane, r = lane & 31, h = lane >> 5;
    const GAS unsigned char* gs = (const GAS unsigned char*)F.gscr();
    const unsigned lo = (unsigned)lane * 16u, loe = (unsigned)h * 16u;
    const GAS unsigned char* QFb = gs + GS_QF + ((size_t)bh * NCH * 2048 + (2 * e) * 64) * 16;
    const GAS unsigned char* KFb = gs + GS_KF + ((size_t)bh * NCH * 2048 + (4 * e) * 64) * 16;
    const GAS unsigned char* AFb = gs + GS_AF + ((size_t)bh * NCH * 512 + ((e & 1) * 4 + (e >> 1)) * 64) * 16;
    const GAS unsigned char* VFb = gs + GS_VF + ((size_t)bh * NCH * 4096 + (sl * 4) * 64) * 16;
    const GAS unsigned char* ELb = gs + GS_EL + ((size_t)bh * NCH * 256 + 32 * e) * 4;
    LAS float* Part = (LAS float*)F.lds;
    LAS v4u* VS = (LAS v4u*)(F.lds + LDSCTL_OFF + 512);
    bf16* orow = F.obuf() + (size_t)(b * SEQ) * DGV + hd * DV + 32 * sl + r;
    const int ksel = e >> 1;
    f32x16 S;
#pragma unroll
    for (int i = 0; i < 16; ++i) S[i] = 0.f;
    v4u q00, q01, q10, q11, at, k0, k1, k2, k3, v0, v1, v2, v3, vtA = (v4u){0u, 0u, 0u, 0u}, vtB = (v4u){0u, 0u, 0u, 0u}; f32x4 e0, e1, e2, e3;
#define LDV(p) (*(const GAS v4u*)(p))
#define GLA_LOADQ(c_) do { const GAS unsigned char* qp = QFb + (size_t)(c_) * 32768; q00 = LDV(qp + lo); q01 = LDV(qp + 1024 + lo); q10 = LDV(qp + 16384 + lo); q11 = LDV(qp + 17408 + lo); \
        at = LDV(AFb + (size_t)(c_) * 8192 + lo); } while (0)
#define GLA_LOADV(c_) do { const GAS unsigned char* vp = VFb + (size_t)(c_) * 65536; v0 = LDV(vp + lo); v1 = LDV(vp + 1024 + lo); v2 = LDV(vp + 2048 + lo); v3 = LDV(vp + 3072 + lo); } while (0)
#define GLA_LOADK(c_) do { const GAS unsigned char* kp = KFb + (size_t)(c_) * 32768; k0 = LDV(kp + lo); k1 = LDV(kp + 1024 + lo); k2 = LDV(kp + 2048 + lo); k3 = LDV(kp + 3072 + lo); \
        const GAS unsigned char* ep = ELb + (size_t)(c_) * 1024; e0 = *(const GAS f32x4*)(ep + loe); e1 = *(const GAS f32x4*)(ep + 32 + loe); e2 = *(const GAS f32x4*)(ep + 64 + loe); e3 = *(const GAS f32x4*)(ep + 96 + loe); } while (0)
#define GLA_STATE() do { S[0] *= e0.x; S[1] *= e0.y; S[2] *= e0.z; S[3] *= e0.w; S[4] *= e1.x; S[5] *= e1.y; S[6] *= e1.z; S[7] *= e1.w; \
        S[8] *= e2.x; S[9] *= e2.y; S[10] *= e2.z; S[11] *= e2.w; S[12] *= e3.x; S[13] *= e3.y; S[14] *= e3.z; S[15] *= e3.w; \
        S = MFMA32(k0, v0, S); S = MFMA32(k1, v1, S); S = MFMA32(k2, v2, S); S = MFMA32(k3, v3, S); } while (0)
#define GLA_ATTN(o) do { if (ksel == 0) o = MFMA32(at, v0, o); else if (ksel == 1) o = MFMA32(at, v1, o); else if (ksel == 2) o = MFMA32(at, v2, o); else o = MFMA32(at, v3, o); } while (0)
#define GLA_STEP(VT, VN, c_) do { const int cc_ = (c_); LAS float* P = Part + (cc_ & 1) * 16384; \
        if (cc_ >= 3) { const LAS v4u* vs = VS + (cc_ % 3) * 256 + lane; v0 = vs[0]; v1 = vs[64]; v2 = vs[128]; v3 = vs[192]; } \
        { v4u s0, s1; s0.x = pk2(S[0], S[1]); s0.y = pk2(S[2], S[3]); s0.z = pk2(S[4], S[5]); s0.w = pk2(S[6], S[7]); s1.x = pk2(S[8], S[9]); s1.y = pk2(S[10], S[11]); s1.z = pk2(S[12], S[13]); s1.w = pk2(S[14], S[15]); \
          f32x16 o; _Pragma("unroll") for (int i = 0; i < 16; ++i) o[i] = 0.f; \
          o = MFMA32(q00, s0, o); o = MFMA32(q01, s1, o); if (!(e & 1)) GLA_ATTN(o); \
          _Pragma("unroll") for (int i = 0; i < 16; ++i) P[((e * 2 + 0) * 16 + i) * 64 + lane] = o[i]; \
          _Pragma("unroll") for (int i = 0; i < 16; ++i) o[i] = 0.f; \
          o = MFMA32(q10, s0, o); o = MFMA32(q11, s1, o); if (e & 1) GLA_ATTN(o); \
          _Pragma("unroll") for (int i = 0; i < 16; ++i) P[((e * 2 + 1) * 16 + i) * 64 + lane] = o[i]; } \
        if (cc_ + 1 < NCH) GLA_LOADQ(cc_ + 1); \
        GLA_STATE(); \
        if (cc_ + 1 < NCH) GLA_LOADK(cc_ + 1); \
        if (cc_ + 1 < NCH && cc_ + 1 < 3) GLA_LOADV(cc_ + 1);                       \
        if (e < 4 && cc_ + 2 < NCH) VT = __builtin_nontemporal_load((const GAS v4u*)(VFb + (size_t)(cc_ + 2) * 65536 + e * 1024 + lo)); \
        if (e < 4 && cc_ + 1 < NCH && cc_ + 1 >= 3) VS[((cc_ + 1) % 3) * 256 + e * 64 + lane] = VN; \
        __syncthreads(); \
        _Pragma("unroll") for (int pp = 0; pp < 4; ++pp) { const int p = 4 * e + pp, rt = p >> 4, reg = p & 15; float s = 0.f; \
            _Pragma("unroll") for (int w2 = 0; w2 < 8; ++w2) s += P[((w2 * 2 + rt) * 16 + reg) * 64 + lane]; \
            const int i = 32 * rt + crow32(reg, h); orow[(size_t)((cc_ - 1) * 64 + i) * DGV] = (bf16)f2bf(s); } } while (0)
    __syncthreads();
    GLA_LOADK(0); GLA_LOADV(0); GLA_LOADQ(1);
    GLA_STATE();
    GLA_LOADK(1); GLA_LOADV(1);
    for (int c = 1; c < NCH; c += 2) { GLA_STEP(vtB, vtA, c); GLA_STEP(vtA, vtB, c + 1); }
#undef LDV
#undef GLA_LOADQ
#undef GLA_LOADV
#undef GLA_LOADK
#undef GLA_STATE
#undef GLA_ATTN
#undef GLA_STEP
    float* gp = out + O_GP + ((size_t)(b * NH + hd) * DK + 32 * e) * DV + 32 * sl + r;
#pragma unroll
    for (int i = 0; i < 16; ++i) gp[(size_t)crow32(i, h) * DV] = S[i];
    __syncthreads();
}

__device__ __forceinline__ void finish_rows(Frame& F, int row, int lane, const float* gnorm) {
    const f32x4* gq = (const f32x4*)(gnorm + 8 * lane); const f32x4 g0 = gq[0], g1 = gq[1];
    const float gn[8] = {g0.x, g0.y, g0.z, g0.w, g1.x, g1.y, g1.z, g1.w};
    const bf16* op = F.obuf() + (size_t)row * DGV + 8 * lane; const bf16* gp = F.proj() + (size_t)row * NIN + C_G + 8 * lane;
    v4u ov[4], gv[4];
#pragma unroll
    for (int hd = 0; hd < 4; ++hd) { ov[hd] = __builtin_nontemporal_load((const v4u*)(op + hd * DV)); gv[hd] = __builtin_nontemporal_load((const v4u*)(gp + hd * DV)); }
    float ss[4];
#pragma unroll
    for (int hd = 0; hd < 4; ++hd) { float o[8]; unpack8(ov[hd], o); float s = 0.f;
#pragma unroll
        for (int e = 0; e < 8; ++e) s += o[e] * o[e];
        ss[hd] = s; }
#pragma unroll
    for (int o = 1; o < 64; o <<= 1) { ss[0] += __shfl_xor(ss[0], o); ss[1] += __shfl_xor(ss[1], o); ss[2] += __shfl_xor(ss[2], o); ss[3] += __shfl_xor(ss[3], o); }
#pragma unroll
    for (int hd = 0; hd < 4; ++hd) { float o[8], g[8], y[8]; unpack8(ov[hd], o); unpack8(gv[hd], g); const float rs = 1.f / sqrtf(ss[hd] * (1.f / DV) + RMS_EPS);
#pragma unroll
        for (int e = 0; e < 8; ++e) y[e] = o[e] * rs * gn[e] * silu(g[e]);
        *(v4u*)(F.mix() + (size_t)row * D + hd * DV + 8 * lane) = pack8(y); }
}

struct Args { const float* in[20]; float* out; unsigned char* ws; };
constexpr int SC_GU = 2 * CM_STRIPS * D, SC_TOTAL = SC_GU + CD_STRIPS * DFF;
struct SideColMax {
    static constexpr int NV = 2;
    const Frame* F; const GAS unsigned char* base; int cg, cur, left; unsigned voff;
    f32x4 m, x0, x1;
    __device__ __forceinline__ int K() const { return cg < 2 * CM_STRIPS ? D : DFF; }
    __device__ __forceinline__ unsigned pitch() const { return cg < 2 * CM_STRIPS ? DFF * 4u : D * 4u; }
    __device__ __forceinline__ void setcg() {
        if (cg < 2 * CM_STRIPS) { const int mt = cg >= CM_STRIPS ? 1 : 0, strip = cg - mt * CM_STRIPS; base = (const GAS unsigned char*)(const GAS float*)(mt ? F->in<A_WUP>() : F->in<A_WGATE>()) + (size_t)strip * 1024; }
        else base = (const GAS unsigned char*)(const GAS float*)F->in<A_WDOWN>() + (size_t)(cg - 2 * CM_STRIPS) * 1024; }
    __device__ __forceinline__ void init(const Frame& F_, int gw, int ngw, int lo, int hi) { F = &F_; voff = 16u * (unsigned)F_.lane;
        int share = (hi - lo + ngw - 1) / ngw; share += share & 1; const int i0 = lo + gw * share; left = hi - i0; left = left < 0 ? 0 : (left > share ? share : left);
        if (left == 0) { cg = 0; cur = 1; } else if (i0 < SC_GU) { cg = i0 / D; cur = i0 - cg * D; } else { const int j = i0 - SC_GU; cg = j / DFF; cur = j - cg * DFF; cg += 2 * CM_STRIPS; }
        setcg(); m = x0 = x1 = (f32x4){0.f, 0.f, 0.f, 0.f}; }
    __device__ __forceinline__ void consume() {
        m.x = fmaxf(fmaxf(m.x, fabsf(x0.x)), fabsf(x1.x)); m.y = fmaxf(fmaxf(m.y, fabsf(x0.y)), fabsf(x1.y)); m.z = fmaxf(fmaxf(m.z, fabsf(x0.z)), fabsf(x1.z)); m.w = fmaxf(fmaxf(m.w, fabsf(x0.w)), fabsf(x1.w)); }
    __device__ __forceinline__ void flush() {
        unsigned* cm;
        if (cg < 2 * CM_STRIPS) { const int mt = cg >= CM_STRIPS ? 1 : 0, c0 = 256 * (cg - mt * CM_STRIPS) + 4 * F->lane; cm = (unsigned*)F->cmax() + 256 * (c0 >> 7) + (mt ? 128 : 0) + (c0 & 127); }
        else cm = (unsigned*)F->cmdn() + 256 * (cg - 2 * CM_STRIPS) + 4 * F->lane;
        __hip_atomic_fetch_max(cm + 0, __float_as_uint(m.x), __ATOMIC_RELAXED, __HIP_MEMORY_SCOPE_AGENT); __hip_atomic_fetch_max(cm + 1, __float_as_uint(m.y), __ATOMIC_RELAXED, __HIP_MEMORY_SCOPE_AGENT);
        __hip_atomic_fetch_max(cm + 2, __float_as_uint(m.z), __ATOMIC_RELAXED, __HIP_MEMORY_SCOPE_AGENT); __hip_atomic_fetch_max(cm + 3, __float_as_uint(m.w), __ATOMIC_RELAXED, __HIP_MEMORY_SCOPE_AGENT);
        m = (f32x4){0.f, 0.f, 0.f, 0.f}; }
    __device__ __forceinline__ void step() {
        if (left > 0 && cur == K()) { flush(); ++cg; setcg(); cur = 0; }
        int n = K() - cur; n = n < left ? n : left; n = n < 2 ? n : 2;
        const int last = n > 0 ? cur + n - 1 : cur - 1, r0 = cur < last ? cur : last;
        const GAS unsigned char* p0 = base + (size_t)r0 * pitch(); const GAS unsigned char* p1 = base + (size_t)last * pitch();
        asm volatile("global_load_dwordx4 %0, %1, %2 nt" : "=v"(x0) : "v"(voff), "s"(p0) : "memory");
        asm volatile("global_load_dwordx4 %0, %1, %2 nt" : "=v"(x1) : "v"(voff), "s"(p1) : "memory");
        cur += n; left -= n; }
    __device__ __forceinline__ void finish() { while (left > 0) { step(); asm volatile("s_waitcnt vmcnt(0)" ::: "memory"); consume(); } flush(); }
};
__global__ void __launch_bounds__(NWAVES * 64, 2) hymba_fwd(Args args) {
    extern __shared__ __attribute__((aligned(16))) unsigned char lds[];
    asm volatile("s_nop 0\n\ts_nop 0\n\ts_nop 0\n\ts_nop 0\n\ts_nop 0\n\ts_nop 0\n\ts_nop 0\n\ts_nop 0");
    Frame F;
    F.lds = (LAS unsigned char*)lds;
    F.MISC = (volatile LAS unsigned*)(F.lds + MISC_OFF);
    F.tid = threadIdx.x; F.lane = F.tid & 63; F.wave = __builtin_amdgcn_readfirstlane(F.tid >> 6);
    F.G = gridDim.x; { const int bx = blockIdx.x; F.vcu = (F.G % 8 == 0) ? (bx % 8) * (F.G / 8) + bx / 8 : bx; }
    unsigned char* ws = args.ws;
    F.ctl = (gu32*)(ws + WS_CTL);
    F.ws = ws;
    for (int u = F.tid; u < (LDS_BYTES - LDSCTL_OFF) / 4; u += NWAVES * 64) ((LAS unsigned*)(F.lds + LDSCTL_OFF))[u] = 0u;
    __syncthreads();
    XcdBarrier bar = xcd_barrier_post((unsigned*)(F.ctl + CW_BAR), F.MISC + 8);
    const int gw = F.vcu * NWAVES + F.wave, NGW = F.G * NWAVES;

    p0_prologue(F);
    if (NCONV_CU == 0 || F.G != 256) convert_rest(F, F.vcu * NWAVES + F.wave, F.G * NWAVES, 0, I_OUT);
    xcd_barrier(bar); F.refresh();
    quant_in_pass(F, gw, NGW);
    xcd_barrier(bar); F.refresh();
    { SideColMax sd; sd.init(F, gw, NGW, 0, SC_GU);
      { pg8::Gemm g{F.h0(), F.Wt_in(), MPAD, NBF, D}; g.wave = F.wave; pg8::PackedOrder<0> S; S.init(MPR / 256, C_CC / 256, F.G, (int)blockIdx.x, D / 64, NBF / 256);
        pg8::EpiBf16 E{F.proj(), NIN, F.slab(), (float*)((unsigned char*)F.slab() + SLAB_A_OFF)};
        pg8::gemm_phase<pg8::EpiBf16, pg8::PackedOrder<0>, PG8_ALIGN, PG8_SP2, SideColMax>(F.lds + RING_OFF, g, S, E, sd); }
      { const int c2 = (F.G == 256) ? (((int)blockIdx.x + 128) & 255) : (int)blockIdx.x;
        pg8::Gemm g{(const bf16*)F.h0q(), (const bf16*)F.Wq_in(), MPAD, NI8, D / 2}; g.wave = F.wave; pg8::PackedOrder<4> S; S.init(MPR / 256, NI8 / 256, F.G, c2, D / 128, NI8X / 256);
        pg8::EpiBf16I8 E{F.proj() + NBF, NIN, F.slab() + NBF, F.rs0(), F.cmin(), NI8X / 256, C_CC - NBF - NI8X};
        pg8::gemm_phase<pg8::EpiBf16I8, pg8::PackedOrder<4>, PG8_ALIGN, PG8_SP2, SideColMax>(F.lds + RING_OFF, g, S, E, sd); }
      sd.finish(); }
    xcd_barrier(bar); F.refresh();
    { const int gt = blockIdx.x * (NWAVES * 64) + F.tid, NT = F.G * NWAVES * 64; const float* sx = F.slab(); const float* sa = (const float*)((const unsigned char*)F.slab() + SLAB_A_OFF);
      for (int idx = gt; idx < XROWS * (NIN / 8); idx += NT) { const int r = idx / (NIN / 8), cg = idx - r * (NIN / 8); const float* p = sx + (size_t)r * NIN + 8 * cg; float v[8];
          { const f32x4 a = __builtin_nontemporal_load((const f32x4*)p), c = __builtin_nontemporal_load((const f32x4*)p + 1); v[0] = a.x; v[1] = a.y; v[2] = a.z; v[3] = a.w; v[4] = c.x; v[5] = c.y; v[6] = c.z; v[7] = c.w; }
#pragma unroll
          for (int s = 1; s < 3; ++s) { const f32x4 a = __builtin_nontemporal_load((const f32x4*)(p + (size_t)s * XROWS * NIN)), c = __builtin_nontemporal_load((const f32x4*)(p + (size_t)s * XROWS * NIN) + 1); v[0] += a.x; v[1] += a.y; v[2] += a.z; v[3] += a.w; v[4] += c.x; v[5] += c.y; v[6] += c.z; v[7] += c.w; }
          *(v4u*)(F.proj() + (size_t)(MPR + r) * NIN + 8 * cg) = pack8(v); }
      for (int idx = gt; idx < MPR * 2; idx += NT) { const int row = idx >> 1, hf = idx & 1; const float* p = sa + (size_t)row * 16 + 8 * hf; float v[8];
          { const f32x4 a = ((const f32x4*)p)[0], c = ((const f32x4*)p)[1]; v[0] = a.x; v[1] = a.y; v[2] = a.z; v[3] = a.w; v[4] = c.x; v[5] = c.y; v[6] = c.z; v[7] = c.w; }
#pragma unroll
          for (int s = 1; s < 3; ++s) { const f32x4 a = ((const f32x4*)(p + (size_t)s * MPR * 16))[0], c = ((const f32x4*)(p + (size_t)s * MPR * 16))[1]; v[0] += a.x; v[1] += a.y; v[2] += a.z; v[3] += a.w; v[4] += c.x; v[5] += c.y; v[6] += c.z; v[7] += c.w; }
          *(v4u*)(F.proj() + (size_t)row * NIN + C_AL + 8 * hf) = pack8(v); } }
    xcd_barrier(bar); F.refresh();
    { const float *w_a2 = F.in<A_WA2>(), *b_a = F.in<A_BA>(), *state_conv = F.in<A_SCONV>(), *conv_w = F.in<A_CONVW>(), *state_gla = F.in<A_SGLA>(); float* out = F.out();
      const int nsa = F.G == 256 ? 256 : 0;
      if (blockIdx.x & 1) for (int it = blockIdx.x; it < nsa; it += F.G) gla_sample_item(F, it, w_a2, b_a, state_gla, out);
      if (F.G == 256) { const int c = blockIdx.x;
          gla_prep_qk(F, c, w_a2, b_a); gla_prep_qk(F, c + 256, w_a2, b_a);
          if (c < 16) gla_prep_qk(F, c + 512, w_a2, b_a);
          else { gla_prep_v(F, c - 16); gla_prep_v(F, c - 16 + 240); if (c - 16 < 48) gla_prep_v(F, c - 16 + 480); } }
      else for (int it = blockIdx.x; it < 2 * NBH * NCH; it += F.G) { if (it < NBH * NCH) gla_prep_qk(F, it, w_a2, b_a); else gla_prep_v(F, it - NBH * NCH); }
      for (int r4 = gw; r4 < MPR / 4; r4 += NGW) conv_rows4(F, 4 * r4, F.lane, conv_w, out);
      for (int row = ROW_S + gw; row < ROW_META; row += NGW) conv_row(F, row, F.lane, state_conv, conv_w, out);
      if (!(blockIdx.x & 1)) for (int it = blockIdx.x; it < nsa; it += F.G) gla_sample_item(F, it, w_a2, b_a, state_gla, out); }
    xcd_barrier(bar); F.refresh();
    { const float *w_a2 = F.in<A_WA2>(), *b_a = F.in<A_BA>(), *state_gla = F.in<A_SGLA>(); float* out = F.out();
      const int nsa = F.G == 256 ? 256 : 0;
      if (!(blockIdx.x & 1)) for (int it = nsa + blockIdx.x; it < NSAMP * NH; it += F.G) gla_sample_item(F, it, w_a2, b_a, state_gla, out);
      for (int u0 = blockIdx.x; u0 < 256; u0 += F.G) { const int i = u0 >> 3, u = F.G == 256 ? (2 * (u0 & 7) + (i >> 4)) * 16 + (i & 15) : u0; gla_scan(F, u, out); }
      if (blockIdx.x & 1) for (int it = nsa + blockIdx.x; it < NSAMP * NH; it += F.G) gla_sample_item(F, it, w_a2, b_a, state_gla, out); }
    xcd_barrier(bar); F.refresh();
    { const float* gnorm = F.in<A_GNORM>(); for (int row = gw; row < ROW_META; row += NGW) finish_rows(F, row, F.lane, gnorm); }
    xcd_barrier(bar); F.refresh();
    { pg8::Gemm g{F.mix(), F.Wt_out(), MPAD, D, D}; g.wave = F.wave; pg8::PackedOrder<1> S; S.init(MPR / 256, D / 256, F.G, (int)blockIdx.x, D / 64);
      pg8::EpiResBf16 E{F.R(), D, F.h0(), D, ALPHA, F.slab()};
      SideColMax sd; sd.init(F, gw, NGW, SC_GU, SC_TOTAL);
      pg8::gemm_phase<pg8::EpiResBf16, pg8::PackedOrder<1>, PG8_ALIGN, PG8_SP2, SideColMax>(F.lds + RING_OFF, g, S, E, sd);
      sd.finish(); }
    xcd_barrier(bar); F.refresh();
    { const float *ln_g = F.in<A_LN1G>(), *ln_b = F.in<A_LN1B>();
      for (int r = blockIdx.x; r < NSAMP; r += F.G) ln_row_slab_block<false, 16>(F, F.slab(), r, F.h0() + (size_t)(ROW_S + r) * D, ln_g, ln_b, F.h1() + (size_t)(ROW_S + r) * D, F.h1q() + (size_t)(ROW_S + r) * D, F.rsc() + ROW_S + r);
      stage_gb(F, ln_g, ln_b);
      for (int row = gw; row < MPR; row += NGW) ln1_row_quant(F.R() + (size_t)row * D, (const LAS f32x4*)(F.lds + LDS_GB), F.h1() + (size_t)row * D, F.h1q() + (size_t)row * D, F.rsc() + row, F.lane); }
    quant_gu_pass(F, gw, NGW);
    xcd_barrier(bar); F.refresh();
    { pg8::Gemm g{(const bf16*)F.h1q(), F.Wt_gu(), MPAD, NGU, D / 2}; g.wave = F.wave; pg8::PackedOrder<2> S; S.init(MPR / 256, NGU / 256, F.G, (int)blockIdx.x, D / 128);
      pg8::EpiSwiGLUi8 E{F.act(), DFF, F.slab(), NGU, F.rsc(), F.cmax()};
      pg8::gemm_phase<pg8::EpiSwiGLUi8, pg8::PackedOrder<2>, PG8_ALIGN, PG8_SP2>(F.lds + RING_OFF, g, S, E); }
    xcd_barrier(bar); F.refresh();
    for (int r = blockIdx.x; r < NSAMP; r += F.G) { LAS float* red = (LAS float*)F.lds; const int t = F.tid; float y[3][8]; float mx = 0.f;
#pragma unroll
        for (int gi = 0; gi < 3; ++gi) { const int cg = t + 512 * gi;
#pragma unroll
            for (int e = 0; e < 8; ++e) y[gi][e] = 0.f;
            if (cg < DFF / 8) { const int col0 = 8 * cg, pn = col0 >> 7, cc = col0 & 127; const float* pg = F.slab() + (size_t)r * NGU + 256 * pn + cc; float gv[8], uv[8];
#pragma unroll
                for (int e = 0; e < 8; ++e) { gv[e] = 0.f; uv[e] = 0.f; }
#pragma unroll
                for (int s = 0; s < 4; ++s) { const f32x4* q = (const f32x4*)(pg + (size_t)s * 128 * NGU); const f32x4 a = q[0], c = q[1], d0 = q[32], d1 = q[33];
                    gv[0] += a.x; gv[1] += a.y; gv[2] += a.z; gv[3] += a.w; gv[4] += c.x; gv[5] += c.y; gv[6] += c.z; gv[7] += c.w;
                    uv[0] += d0.x; uv[1] += d0.y; uv[2] += d0.z; uv[3] += d0.w; uv[4] += d1.x; uv[5] += d1.y; uv[6] += d1.z; uv[7] += d1.w; }
#pragma unroll
                for (int e = 0; e < 8; ++e) { y[gi][e] = silu(gv[e]) * uv[e]; mx = fmaxf(mx, fabsf(y[gi][e])); } } }
        mx = wave_max(mx);
        __syncthreads();
        if (F.lane == 0) red[F.wave] = mx;
        __syncthreads();
        float tm = 0.f;
#pragma unroll
        for (int w = 0; w < 8; ++w) tm = fmaxf(tm, red[w]);
        const float inv = tm > 0.f ? 127.0f / tm : 0.f;
        if (t == 0) F.amax()[ROW_S + r] = tm;
#pragma unroll
        for (int gi = 0; gi < 3; ++gi) { const int cg = t + 512 * gi; if (cg < DFF / 8) { u32x2v q; q.x = q4(y[gi][0], y[gi][1], y[gi][2], y[gi][3], inv); q.y = q4(y[gi][4], y[gi][5], y[gi][6], y[gi][7], inv);
            *(u32x2v*)(F.actq() + (size_t)(ROW_S + r) * DFF + 8 * cg) = q; } } }
    for (int row = gw; row < MPR; row += NGW) act_row_quant(F, row, F.lane);
    quant_dn_pass(F, gw, NGW);
    xcd_barrier(bar); F.refresh();
    { pg8::Gemm g{(const bf16*)F.actq(), F.Wt_dn(), MPAD, D, DFF / 2}; g.wave = F.wave; pg8::PackedOrder<3> S; S.init(MPR / 256, D / 256, F.G, (int)blockIdx.x, DFF / 128);
      pg8::EpiResI8 E{F.R(), D, F.h1(), D, ALPHA, F.slab(), F.amax(), F.cmdn()};
      pg8::gemm_phase<pg8::EpiResI8, pg8::PackedOrder<3>, PG8_ALIGN, PG8_SP2>(F.lds + RING_OFF, g, S, E); }
    xcd_barrier(bar); F.refresh();
    { const float *ln_g = F.in<A_LN2G>(), *ln_b = F.in<A_LN2B>(); float* out = F.out();
      for (int r = blockIdx.x; r < NSAMP; r += F.G) ln_row_slab_block<true, 16>(F, F.slab(), r, F.h1() + (size_t)(ROW_S + r) * D, ln_g, ln_b, out + O_YS + (size_t)r * D);
      stage_gb(F, ln_g, ln_b);
      for (int row = gw; row < MPR; row += NGW) { int l = F.lane; asm volatile("" : "+v"(l));
          ln_row_b16<true>(F.R() + (size_t)row * D, (const LAS f32x4*)(F.lds + LDS_GB), out + O_YP + (size_t)row * D, l); } }
}

extern "C" void kernel_launch(void* const* d_in, const int* in_sizes, int n_in, void* d_out, int out_size, void* d_ws, size_t ws_size, hipStream_t stream) {
    static int grid = 0;
    if (grid == 0) {
        if (n_in != 20 || (size_t)out_size != O_END || ws_size < WS_END) { fprintf(stderr, "kernel_launch: unexpected shapes (n_in %d out %d ws %zu)\n", n_in, out_size, ws_size); grid = -1; return; }
        int dev = 0, cus = 0, per_cu = 0;
        if (hipGetDevice(&dev) != hipSuccess || hipDeviceGetAttribute(&cus, hipDeviceAttributeMultiprocessorCount, dev) != hipSuccess) { grid = -1; return; }
        if (hipFuncSetAttribute((const void*)hymba_fwd, hipFuncAttributeMaxDynamicSharedMemorySize, LDS_BYTES) != hipSuccess) { fprintf(stderr, "kernel_launch: hipFuncSetAttribute failed\n"); grid = -1; return; }
        if (hipOccupancyMaxActiveBlocksPerMultiprocessor(&per_cu, (const void*)hymba_fwd, NWAVES * 64, LDS_BYTES) != hipSuccess || per_cu < 1) { fprintf(stderr, "kernel_launch: occupancy query says %d\n", per_cu); (void)hipGetLastError(); grid = -1; return; }
        grid = cus;
    }
    if (grid < 0) return;
    if (hipMemsetAsync((char*)d_ws + WS_CTL, 0, CTL_ZERO_BYTES, stream) != hipSuccess) return;
    Args a{};
    for (int i = 0; i < 20; ++i) a.in[i] = (const float*)d_in[i];
    a.out = (float*)d_out; a.ws = (unsigned char*)d_ws;
    hipLaunchKernelGGL(hymba_fwd, dim3(grid), dim3(NWAVES * 64), LDS_BYTES, stream, a);
}
```
